# Optimizing an MI355X kernel written in HIP

```python
import jax, jax.numpy as jnp
from jax import lax
import numpy as np

D_MODEL = 1024
BATCH = 8
SEQ = 8192
DEPTH = 1
DEC_BATCH = 16
DEC_SEQ = 4096
PAST_LEN = 128

GRID_W = 64
N_MEM = 256
F_GROUPS = 4
F_GROUP_DIM = 96
F_WIDTH = F_GROUPS * F_GROUP_DIM
NA_HEADS = 6
NA_HEAD_DIM = 64
NA_WIDTH = NA_HEADS * NA_HEAD_DIM
CA_HEADS = 4
CA_HEAD_DIM = 64
CA_WIDTH = CA_HEADS * CA_HEAD_DIM
NA_KH_MAX = 8
NA_KW = 16
NA_QBLK = 16
NA_KBLK = 32
N_BRANCH = 3
IN_SPLITS = (F_WIDTH, F_WIDTH, 3 * NA_WIDTH, NA_WIDTH, CA_WIDTH, CA_WIDTH, N_BRANCH * D_MODEL)
IN_WIDTH = F_WIDTH * 2 + NA_WIDTH * 4 + CA_WIDTH * 2 + N_BRANCH * D_MODEL
EPS = 1e-6
NEG = -1e30

kernel_name = "hybrid_fnet_natten_memory_encoder"


def rmsnorm(x, g):
    xf = x.astype(jnp.float32)
    y = xf * lax.rsqrt(jnp.mean(xf * xf, axis=-1, keepdims=True) + EPS)
    return (y * g.astype(jnp.float32)).astype(x.dtype)


def fourier_mix(u):
    B, S, _ = u.shape
    ug = u.reshape(B, S, F_GROUPS, F_GROUP_DIM).astype(jnp.float32)
    yr = jnp.fft.fft2(ug, axes=(1, 3), norm="ortho").real
    return yr.reshape(B, S, F_WIDTH).astype(u.dtype)


def na_indices(rows):
    kh = min(NA_KH_MAX, rows)
    r = np.arange(rows)
    rs = np.clip(r - kh // 2, 0, rows - kh)
    row_idx = rs[:, None] + np.arange(kh)[None, :]
    dr = row_idx - r[:, None] + (NA_KH_MAX - 1)
    nj = GRID_W // NA_QBLK
    j = np.arange(nj)
    c0 = np.clip(j * NA_QBLK - NA_KW // 2, 0, GRID_W - NA_KBLK)
    col_idx = c0[:, None] + np.arange(NA_KBLK)[None, :]
    c = j[:, None] * NA_QBLK + np.arange(NA_QBLK)[None, :]
    cs = np.clip(c - NA_KW // 2, 0, GRID_W - NA_KW)
    rel = col_idx[:, None, :] - cs[:, :, None]
    valid = (rel >= 0) & (rel < NA_KW)
    dc = np.clip(col_idx[:, None, :] - c[:, :, None] + (NA_KW - 1), 0, 2 * NA_KW - 2)
    return row_idx, dr, col_idx, valid, dc


def neighborhood_attention(q, k, v, rpb):
    B, S, H, Dh = q.shape
    rows = S // GRID_W
    row_idx, dr, col_idx, valid, dc = na_indices(rows)
    nj = GRID_W // NA_QBLK
    qb = q.reshape(B, rows, nj, NA_QBLK, H, Dh)
    ridx = row_idx[:, None, :, None]
    cidx = col_idx[None, :, None, :]
    kg = k.reshape(B, rows, GRID_W, H, Dh)[:, ridx, cidx]
    vg = v.reshape(B, rows, GRID_W, H, Dh)[:, ridx, cidx]
    s = jnp.einsum('brjqhd,brjkwhd->bhrjqkw', qb, kg).astype(jnp.float32) * (Dh ** -0.5)
    bias = rpb.astype(jnp.float32)[:, dr[:, None, None, :, None], dc[None, :, :, None, :]]
    mask = jnp.asarray(valid)[None, :, :, None, :]
    s = jnp.where(mask, s + bias[None], NEG)
    sh = s.shape
    p = jax.nn.softmax(s.reshape(sh[:5] + (sh[5] * sh[6],)), axis=-1).reshape(sh)
    o = jnp.einsum('bhrjqkw,brjkwhd->brjqhd', p.astype(v.dtype), vg)
    return o.reshape(B, S, H * Dh)


def memory_attention(q, k, v):
    B, S, H, Dh = q.shape
    s = jnp.einsum('bshd,bmhd->bhsm', q, k).astype(jnp.float32) * (Dh ** -0.5)
    p = jax.nn.softmax(s, axis=-1).astype(v.dtype)
    return jnp.einsum('bhsm,bmhd->bshd', p, v).reshape(B, S, H * Dh)


def hybrid_layer(x, mem, g_norm, w_in, rpb, g_mem, w_mem_kv, w_f_out, w_na_out, w_ca_out, w_out):
    B, S, D = x.shape
    h = rmsnorm(x, g_norm)
    z = h @ w_in
    cuts = [int(c) for c in np.cumsum(IN_SPLITS)[:-1]]
    u_f, gate_f, qkv_na, gate_na, q_ca, gate_ca, g_merge = jnp.split(z, cuts, axis=-1)
    y_f = (fourier_mix(u_f) * jax.nn.silu(gate_f)) @ w_f_out
    qkv = qkv_na.reshape(B, S, 3, NA_HEADS, NA_HEAD_DIM)
    o_na = neighborhood_attention(qkv[:, :, 0], qkv[:, :, 1], qkv[:, :, 2], rpb)
    y_na = (o_na * jax.nn.silu(gate_na)) @ w_na_out
    M = mem.shape[1]
    kv = (rmsnorm(mem, g_mem) @ w_mem_kv).reshape(B, M, 2, CA_HEADS, CA_HEAD_DIM)
    o_ca = memory_attention(q_ca.reshape(B, S, CA_HEADS, CA_HEAD_DIM), kv[:, :, 0], kv[:, :, 1])
    y_ca = (o_ca * jax.nn.silu(gate_ca)) @ w_ca_out
    gm = jax.nn.sigmoid(g_merge).reshape(B, S, N_BRANCH, D)
    merged = gm[:, :, 0] * y_f + gm[:, :, 1] * y_na + gm[:, :, 2] * y_ca
    return x + merged @ w_out


def trunk(x, mem, g_norm, w_in, na_rpb, g_mem, w_mem_kv, w_f_out, w_na_out, w_ca_out, w_out, g_final):
    for l in range(DEPTH):
        x = hybrid_layer(x, mem, g_norm[l], w_in[l], na_rpb[l], g_mem[l], w_mem_kv[l],
                         w_f_out[l], w_na_out[l], w_ca_out[l], w_out[l])
    return rmsnorm(x, g_final)


def setup_inputs(seed: int = 0) -> dict:
    key = jax.random.key(seed)
    ks = jax.random.split(key, 16)
    f32 = jnp.float32
    nrm = lambda k, shape, s: jax.random.normal(k, shape, f32) * s
    return {
        "x_prompt": nrm(ks[0], (BATCH, SEQ, D_MODEL), 1.0),
        "x_sample": nrm(ks[1], (DEC_BATCH, DEC_SEQ, D_MODEL), 1.0),
        "mem_prompt": nrm(ks[2], (BATCH, N_MEM, D_MODEL), 1.0),
        "mem_sample": nrm(ks[3], (DEC_BATCH, N_MEM, D_MODEL), 1.0),
        "g_norm": 1.0 + nrm(ks[4], (DEPTH, D_MODEL), 0.02),
        "w_in": nrm(ks[5], (DEPTH, D_MODEL, IN_WIDTH), D_MODEL ** -0.5),
        "na_rpb": nrm(ks[6], (DEPTH, NA_HEADS, 2 * NA_KH_MAX - 1, 2 * NA_KW - 1), 0.1),
        "g_mem": 1.0 + nrm(ks[7], (DEPTH, D_MODEL), 0.02),
        "w_mem_kv": nrm(ks[8], (DEPTH, D_MODEL, 2 * CA_WIDTH), D_MODEL ** -0.5),
        "w_f_out": nrm(ks[9], (DEPTH, F_WIDTH, D_MODEL), F_WIDTH ** -0.5),
        "w_na_out": nrm(ks[10], (DEPTH, NA_WIDTH, D_MODEL), NA_WIDTH ** -0.5),
        "w_ca_out": nrm(ks[11], (DEPTH, CA_WIDTH, D_MODEL), CA_WIDTH ** -0.5),
        "w_out": nrm(ks[12], (DEPTH, D_MODEL, D_MODEL), D_MODEL ** -0.5),
        "g_final": 1.0 + nrm(ks[13], (D_MODEL,), 0.02),
    }


def reference(x_prompt, x_sample, mem_prompt, mem_sample, g_norm, w_in, na_rpb, g_mem, w_mem_kv,
              w_f_out, w_na_out, w_ca_out, w_out, g_final):
    y_prompt = trunk(x_prompt, mem_prompt, g_norm, w_in, na_rpb, g_mem, w_mem_kv,
                     w_f_out, w_na_out, w_ca_out, w_out, g_final)
    y_sample = trunk(x_sample, mem_sample, g_norm, w_in, na_rpb, g_mem, w_mem_kv,
                     w_f_out, w_na_out, w_ca_out, w_out, g_final)
    return (y_prompt, y_sample)
```

```cpp
#include <hip/hip_runtime.h>
#include <hip/hip_cooperative_groups.h>
#include <cstdio>
#include <cstdint>
namespace cg = cooperative_groups;

#ifndef MK_N_LAUNCHES
#define MK_N_LAUNCHES 7
#endif

#define LAS __attribute__((address_space(3)))
#define GAS __attribute__((address_space(1)))
typedef unsigned short bf16_t;
typedef short bf16x8 __attribute__((ext_vector_type(8)));
typedef short s16x4 __attribute__((ext_vector_type(4)));
typedef float f32x4 __attribute__((ext_vector_type(4)));
typedef unsigned u32x4 __attribute__((ext_vector_type(4)));
typedef unsigned u32x2 __attribute__((ext_vector_type(2)));

constexpr int D = 1024, T = 131072, TP = 65536, NZ = 2816, NIN = 5888, NMEMROWS = 6144;
constexpr int C_UF = 0, C_GF = 384, C_Q = 768, C_K = 1152, C_V = 1536, C_GNA = 1920, C_QCA = 2304, C_GCA = 2560;
constexpr float EPS = 1e-6f;
constexpr int NPHASES = 7;
constexpr int LDS_BYTES = 153600;
constexpr int NTHREADS = 512;

constexpr size_t WS_Z1 = 0;
constexpr size_t WS_MERGED = WS_Z1 + (size_t)T * NZ * 2;
constexpr size_t WS_WIN = WS_MERGED + (size_t)T * D * 2;
constexpr size_t WS_WKV = WS_WIN + (size_t)NIN * D * 2;
constexpr size_t WS_WFO = WS_WKV + (size_t)512 * D * 2;
constexpr size_t WS_WNA = WS_WFO + (size_t)D * 384 * 2;
constexpr size_t WS_WCA = WS_WNA + (size_t)D * 384 * 2;
constexpr size_t WS_WOUT = WS_WCA + (size_t)D * 256 * 2;
constexpr size_t WS_KVMEM = WS_WOUT + (size_t)D * D * 2;
constexpr size_t WS_MEMN = WS_KVMEM + (size_t)NMEMROWS * 512 * 2;
constexpr size_t WS_ROWSS = WS_MEMN + (size_t)NMEMROWS * D * 2;
constexpr size_t WS_TAB64 = WS_ROWSS + (size_t)T * 16 * 4;
constexpr size_t WS_TAB128 = WS_TAB64 + 3 * 64 * 64 * 2;
constexpr size_t WS_TABC = WS_TAB128 + 3 * 128 * 128 * 2;
constexpr size_t WS_END = WS_TABC + 2 * 96 * 96 * 2;
constexpr size_t OUT_HB = 0;
constexpr size_t OUT_T2 = (size_t)T * D * 2;
constexpr size_t OUT_END = OUT_T2 + (size_t)T * 768 * 2;
static_assert(OUT_END <= (size_t)T * D * 4, "d_out scratch");

struct Args {
    const float *xp, *xs, *memp, *mems, *g_norm, *w_in, *rpb, *g_mem, *w_kv, *w_fo, *w_na, *w_ca, *w_out, *g_final;
    float* out; unsigned char* ws; int ph_lo, ph_hi;
};

typedef __bf16 bf16v2 __attribute__((ext_vector_type(2)));
typedef float f32x2 __attribute__((ext_vector_type(2)));
__device__ __forceinline__ unsigned cvt_pk_bf16(float lo, float hi) { const f32x2 v = {lo, hi}; return __builtin_bit_cast(unsigned, __builtin_convertvector(v, bf16v2)); }
__device__ __forceinline__ float bf_lo(unsigned w) { return __uint_as_float(w << 16); }
__device__ __forceinline__ float bf_hi(unsigned w) { return __uint_as_float(w & 0xffff0000u); }
__device__ __forceinline__ float wave_sum(float v) {
#pragma unroll
    for (int o = 1; o < 64; o <<= 1) v += __shfl_xor(v, o);
    return v;
}
__device__ __forceinline__ float sigmoidf_(float x) { return __builtin_amdgcn_rcpf(1.0f + __expf(-x)); }
__device__ __forceinline__ float siluf_(float x) { return x * sigmoidf_(x); }
__device__ __forceinline__ int seq_base(int q) { return q < 8 ? q * 8192 : TP + (q - 8) * 4096; }
__device__ __forceinline__ f32x4 mfma16(bf16x8 a, bf16x8 b, f32x4 c) { return __builtin_amdgcn_mfma_f32_16x16x32_bf16(a, b, c, 0, 0, 0); }
__device__ __forceinline__ bf16x8 cat4(s16x4 a, s16x4 b) { return __builtin_shufflevector(a, b, 0, 1, 2, 3, 4, 5, 6, 7); }
__device__ __forceinline__ s16x4 tr_read(LAS unsigned char* p) { return __builtin_amdgcn_ds_read_tr16_b64_v4i16((LAS s16x4*)p); }
__device__ __forceinline__ bf16x8 pack8(f32x4 a, f32x4 b) {
    u32x4 p; p.x = cvt_pk_bf16(a[0], a[1]); p.y = cvt_pk_bf16(a[2], a[3]); p.z = cvt_pk_bf16(b[0], b[1]); p.w = cvt_pk_bf16(b[2], b[3]);
    return __builtin_bit_cast(bf16x8, p);
}

namespace pg8 {
constexpr int BM = 256, BK = 64, HALF = 128, HTB = HALF * BK * 2, STAGE_BYTES = 8 * HTB, NXCD = 8, WGM = 8;
__device__ __forceinline__ int lds_byte(int r, int c) { const int st = (r >> 4) * 2 + (c >> 5), rr = r & 15, cc = c & 31, ob = rr * 64 + cc * 2; return st * 1024 + (ob ^ (((ob >> 9) & 1) << 5)); }
__device__ __forceinline__ void stage_rc(int b, int& R, int& C) { const int st = b / 1024, sb = b % 1024, swz = sb ^ (((sb >> 9) & 1) << 5); R = (st >> 1) * 16 + swz / 64; C = (st & 1) * 32 + (swz % 64) / 2; }
__device__ __forceinline__ int perm32(int rho) { const int n = rho >> 4, i = rho & 15; return 8 * (i >> 2) + 4 * n + (i & 3); }

struct Unit { int pm, pn; };
struct StaticOrder {
    int nM, nN, nwg, G, c;
    __device__ void init(int M, int N, int G_, int c_) { nM = M / BM; nN = N / BM; nwg = nM * nN; G = G_; c = c_; }
    __device__ bool next(int i, Unit& u) const {
        const long L = (long)i * G + c; if (L >= nwg) return false;
        int wgid = (int)L; { const int q = nwg / NXCD, r = nwg % NXCD, xcd = wgid % NXCD, off = wgid / NXCD; wgid = (xcd < r ? xcd * (q + 1) : r * (q + 1) + (xcd - r) * q) + off; }
        const int nig = WGM * nN, gid = wgid / nig, fm = gid * WGM, gsz = (nM - fm) < WGM ? (nM - fm) : WGM;
        u.pm = fm + ((wgid % nig) % gsz); u.pn = (wgid % nig) / gsz; return true;
    }
};
struct Seg { const char* A; const char* B; unsigned lda, ldb; int nt, kind, pm, pn; };

template <int NSEG, class Epi, class Stream>
__device__ __forceinline__ void gemm_stream(LAS unsigned char* lds, const Stream& S, const Epi& E) {
    const int tid = threadIdx.x, wid = __builtin_amdgcn_readfirstlane(tid >> 6), lane = tid & 63, wr = wid >> 2, wc = wid & 3, fr = lane & 15, fq = lane >> 4;
    unsigned Ra0, Rb0, Cc0;
    { int R, C; stage_rc(tid * 16, R, C); Ra0 = (unsigned)R; Rb0 = (unsigned)(Epi::PERM ? ((R & ~31) + perm32(R & 31)) : R); Cc0 = (unsigned)C * 2u; }
    const size_t kstep = (size_t)(BK * 2);
    const unsigned ldsw = (unsigned)wid * 1024u;
    const int aoff = lds_byte(wr * 64 + fr, fq * 8), boff = lds_byte(wc * 32 + fr, fq * 8);
#define PG8_SA(b, h) (((b) * 2 + (h)) * HTB)
#define PG8_SB(b, h) ((4 + (b) * 2 + (h)) * HTB)
#define PG8_STAGE(bufoff, gbase, v0, ld) do { \
        __builtin_amdgcn_global_load_lds((const unsigned*)((const char*)(gbase) + (v0)), (LAS unsigned*)(lds + (bufoff) + ldsw), 16, 0, 0); \
        __builtin_amdgcn_global_load_lds((const unsigned*)((const char*)(gbase) + (size_t)64 * (ld) + (v0)), (LAS unsigned*)(lds + (bufoff) + ldsw + 8192), 16, 0, 0); } while (0)
#define PG8_LDA(dst, b, h) do { _Pragma("unroll") for (int m = 0; m < 4; ++m) _Pragma("unroll") for (int k = 0; k < 2; ++k) dst[m][k] = *(const LAS bf16x8*)(lds + PG8_SA(b, h) + aoff + m * 2048 + k * 1024); } while (0)
#define PG8_LDB(dst, b, h) do { _Pragma("unroll") for (int n = 0; n < 2; ++n) _Pragma("unroll") for (int k = 0; k < 2; ++k) dst[n][k] = *(const LAS bf16x8*)(lds + PG8_SB(b, h) + boff + n * 2048 + k * 1024); } while (0)
#define PG8_MMA(ai, bj, At, Bt) do { __builtin_amdgcn_s_setprio(1); _Pragma("unroll") for (int m = 0; m < 4; ++m) _Pragma("unroll") for (int n = 0; n < 2; ++n) _Pragma("unroll") for (int k = 0; k < 2; ++k) \
        acc[ai][bj][m][n] = __builtin_amdgcn_mfma_f32_16x16x32_bf16(Bt[n][k], At[m][k], acc[ai][bj][m][n], 0, 0, 0); __builtin_amdgcn_s_setprio(0); } while (0)
#define PG8_WAIT_V(n) asm volatile("s_waitcnt vmcnt(" #n ")" ::: "memory")
#define PG8_WAIT_L(n) asm volatile("s_waitcnt lgkmcnt(" #n ")" ::: "memory")
#define PG8_BAR __builtin_amdgcn_s_barrier()
#define PG8_SCHED __builtin_amdgcn_sched_barrier(0)
#define PG8_ZERO() do { _Pragma("unroll") for (int a_ = 0; a_ < 2; ++a_) _Pragma("unroll") for (int b_ = 0; b_ < 2; ++b_) _Pragma("unroll") for (int m_ = 0; m_ < 4; ++m_) _Pragma("unroll") for (int n_ = 0; n_ < 2; ++n_) \
        acc[a_][b_][m_][n_] = (f32x4){0.f, 0.f, 0.f, 0.f}; } while (0)
    Seg cur, nxt; int ui = 0;
    if (!S.template seg<0>(0, cur)) return;
    f32x4 acc[2][2][4][2];
    PG8_ZERO();
    bf16x8 At[4][2], B0[2][2], B1[2][2];
    const char* cA = cur.A; const char* cB = cur.B;
    unsigned vAc0 = Ra0 * cur.lda + Cc0, vBc0 = Rb0 * cur.ldb + Cc0, ldAc = cur.lda, ldBc = cur.ldb;
    size_t hAc = (size_t)HALF * cur.lda, hBc = (size_t)HALF * cur.ldb;
    PG8_STAGE(PG8_SB(0, 0), cB, vBc0, ldBc); PG8_STAGE(PG8_SA(0, 0), cA, vAc0, ldAc); PG8_STAGE(PG8_SB(0, 1), cB + hBc, vBc0, ldBc); PG8_STAGE(PG8_SA(0, 1), cA + hAc, vAc0, ldAc);
    if (wr == 1) PG8_BAR;
    PG8_WAIT_V(4); PG8_BAR;
    PG8_STAGE(PG8_SB(1, 0), cB + kstep, vBc0, ldBc); PG8_STAGE(PG8_SA(1, 0), cA + kstep, vAc0, ldAc); PG8_STAGE(PG8_SB(1, 1), cB + hBc + kstep, vBc0, ldBc);
    PG8_WAIT_V(6); PG8_BAR;
#define PG8_SEG(KK) if constexpr (NSEG > (KK)) { \
        bool has_next; if constexpr ((KK) + 1 < NSEG) { S.template seg<((KK) + 1 < NSEG ? (KK) + 1 : 0)>(ui, nxt); has_next = true; } else has_next = S.template seg<0>(ui + 1, nxt); \
        if (!has_next) nxt = cur;     \
        const char* nA = nxt.A; const char* nB = nxt.B; \
        const unsigned vAn0 = Ra0 * nxt.lda + Cc0, vBn0 = Rb0 * nxt.ldb + Cc0, ldAn = nxt.lda, ldBn = nxt.ldb; \
        const size_t hAn = (size_t)HALF * nxt.lda, hBn = (size_t)HALF * nxt.ldb; \
        const int nt = cur.nt; \
        for (int t = 0; t < nt; t += 2) { \
            const bool last = (t == nt - 2); \
            const char* a1 = cA + (size_t)(t + 1) * kstep; \
            const char* a2 = last ? nA : cA + (size_t)(t + 2) * kstep; const char* b2 = last ? nB : cB + (size_t)(t + 2) * kstep; \
            const char* a3 = a2 + kstep; const char* b3 = b2 + kstep; \
            const unsigned vA0 = last ? vAn0 : vAc0, vB0 = last ? vBn0 : vBc0, lA2 = last ? ldAn : ldAc, lB2 = last ? ldBn : ldBc; \
            const size_t hA2 = last ? hAn : hAc, hB2 = last ? hBn : hBc; \
            PG8_LDB(B0, 0, 0); PG8_SCHED; PG8_LDA(At, 0, 0); PG8_STAGE(PG8_SA(1, 1), a1 + hAc, vAc0, ldAc); \
            PG8_WAIT_L(8); PG8_BAR; PG8_WAIT_L(0); PG8_MMA(0, 0, At, B0); PG8_BAR; PG8_SCHED; \
            PG8_LDB(B1, 0, 1); PG8_STAGE(PG8_SB(0, 0), b2, vB0, lB2); \
            PG8_BAR; PG8_WAIT_L(0); PG8_MMA(0, 1, At, B1); PG8_BAR; \
            PG8_LDA(At, 0, 1); PG8_STAGE(PG8_SA(0, 0), a2, vA0, lA2); \
            PG8_BAR; PG8_WAIT_L(0); PG8_MMA(1, 0, At, B0); PG8_BAR; PG8_SCHED; \
            PG8_STAGE(PG8_SB(0, 1), b2 + hB2, vB0, lB2); \
            PG8_WAIT_V(6); PG8_BAR; PG8_MMA(1, 1, At, B1); PG8_BAR; \
            PG8_LDB(B0, 1, 0); PG8_SCHED; PG8_LDA(At, 1, 0); PG8_STAGE(PG8_SA(0, 1), a2 + hA2, vA0, lA2); \
            PG8_WAIT_L(8); PG8_BAR; PG8_WAIT_L(0); PG8_MMA(0, 0, At, B0); PG8_BAR; PG8_SCHED; \
            PG8_LDB(B1, 1, 1); PG8_STAGE(PG8_SB(1, 0), b3, vB0, lB2); \
            PG8_BAR; PG8_WAIT_L(0); PG8_MMA(0, 1, At, B1); PG8_BAR; \
            PG8_LDA(At, 1, 1); PG8_STAGE(PG8_SA(1, 0), a3, vA0, lA2); \
            PG8_BAR; PG8_WAIT_L(0); PG8_MMA(1, 0, At, B0); PG8_BAR; PG8_SCHED; \
            PG8_STAGE(PG8_SB(1, 1), b3 + hB2, vB0, lB2); \
            PG8_WAIT_V(6); PG8_BAR; PG8_MMA(1, 1, At, B1); PG8_BAR; \
        } \
        E.template run<(KK)>(acc, cur, wr, wc, fr, fq, tid); \
        if (!has_next) break; \
        if constexpr (Epi::template zero_after<(KK)>()) PG8_ZERO(); \
        cur = nxt; cA = nA; cB = nB; vAc0 = vAn0; vBc0 = vBn0; ldAc = ldAn; ldBc = ldBn; hAc = hAn; hBc = hBn; }
    for (;;) {
        PG8_SEG(0) PG8_SEG(1) PG8_SEG(2) PG8_SEG(3) PG8_SEG(4) PG8_SEG(5)
        ++ui;
    }
    PG8_WAIT_V(0);
    if (wr == 0) PG8_BAR;
    PG8_BAR;
#undef PG8_SA
#undef PG8_SB
#undef PG8_STAGE
#undef PG8_LDA
#undef PG8_LDB
#undef PG8_MMA
#undef PG8_WAIT_V
#undef PG8_WAIT_L
#undef PG8_BAR
#undef PG8_SCHED
#undef PG8_ZERO
#undef PG8_SEG
}
}

struct PlainStream {
    pg8::StaticOrder so; const char* A; const char* B; unsigned lda, ldb; int nt;
    template <int KK> __device__ __forceinline__ bool seg(int i, pg8::Seg& s) const { pg8::Unit u; if (!so.next(i, u)) return false;
        s.A = A + (size_t)u.pm * 256 * lda; s.B = B + (size_t)u.pn * 256 * ldb; s.lda = lda; s.ldb = ldb; s.nt = nt; s.kind = 0; s.pm = u.pm; s.pn = u.pn; return true; }
};
struct EpiStoreBf16 {
    static constexpr bool PERM = true;
    bf16_t* O; int ldc;
    template <int KK> static constexpr bool zero_after() { return true; }
    template <int KK> __device__ __forceinline__ void run(f32x4 (&acc)[2][2][4][2], const pg8::Seg& u, int wr, int wc, int fr, int fq, int) const {
        const int row0 = u.pm * 256 + wr * 64 + fr, col0 = u.pn * 256 + wc * 32 + 8 * fq;
#pragma unroll
        for (int ai = 0; ai < 2; ++ai)
#pragma unroll
            for (int m = 0; m < 4; ++m) { bf16_t* rowp = O + (size_t)(row0 + ai * 128 + m * 16) * ldc + col0;
#pragma unroll
                for (int bj = 0; bj < 2; ++bj) { const f32x4 v0 = acc[ai][bj][m][0], v1 = acc[ai][bj][m][1];
                    u32x4 w; w.x = cvt_pk_bf16(v0[0], v0[1]); w.y = cvt_pk_bf16(v0[2], v0[3]); w.z = cvt_pk_bf16(v1[0], v1[1]); w.w = cvt_pk_bf16(v1[2], v1[3]);
                    *(u32x4*)(rowp + bj * 128) = w; } }
    }
};

struct MergeStream {
    pg8::StaticOrder so; const char *hb, *z1, *win, *wfo, *wna, *wca;
    template <int KK> __device__ __forceinline__ bool seg(int ui, pg8::Seg& s) const { pg8::Unit u; constexpr int k = KK; if (!so.next(ui, u)) return false;
        s.kind = k; s.pm = u.pm; s.pn = u.pn;
        if (k < 3) { s.A = hb + (size_t)u.pm * 256 * (D * 2); s.lda = D * 2; s.B = win + (size_t)(NZ + k * D + u.pn * 256) * (D * 2); s.ldb = D * 2; s.nt = 16; }
        else { s.lda = NZ * 2; const char* a = z1 + (size_t)u.pm * 256 * (NZ * 2);
            if (k == 3) { s.A = a + C_GF * 2; s.B = wfo + (size_t)u.pn * 256 * (384 * 2); s.ldb = 384 * 2; s.nt = 6; }
            else if (k == 4) { s.A = a + C_GNA * 2; s.B = wna + (size_t)u.pn * 256 * (384 * 2); s.ldb = 384 * 2; s.nt = 6; }
            else { s.A = a + C_GCA * 2; s.B = wca + (size_t)u.pn * 256 * (256 * 2); s.ldb = 256 * 2; s.nt = 4; } }
        return true; }
};
struct EpiMerge {
    static constexpr bool PERM = true;
    unsigned char* stash; bf16_t* O;
    template <int KK> static constexpr bool zero_after() { return KK < 3 || KK == 5; }
    template <int KK> __device__ __forceinline__ void run(f32x4 (&acc)[2][2][4][2], const pg8::Seg& u, int wr, int wc, int fr, int fq, int tid) const {
        constexpr int k = KK;
        GAS unsigned char* sbase = (GAS unsigned char*)stash + (size_t)tid * 16; asm volatile("" : "+v"(sbase));
        if constexpr (k < 3) {
            GAS u32x4* st = (GAS u32x4*)(sbase + (size_t)k * 16 * 8192);
#pragma unroll
            for (int ai = 0; ai < 2; ++ai)
#pragma unroll
                for (int bj = 0; bj < 2; ++bj)
#pragma unroll
                    for (int m = 0; m < 4; ++m) { const f32x4 v0 = acc[ai][bj][m][0], v1 = acc[ai][bj][m][1]; u32x4 w;
                        w.x = cvt_pk_bf16(sigmoidf_(v0[0]), sigmoidf_(v0[1])); w.y = cvt_pk_bf16(sigmoidf_(v0[2]), sigmoidf_(v0[3]));
                        w.z = cvt_pk_bf16(sigmoidf_(v1[0]), sigmoidf_(v1[1])); w.w = cvt_pk_bf16(sigmoidf_(v1[2]), sigmoidf_(v1[3]));
                        st[((ai * 2 + bj) * 4 + m) * 512] = w; }
        } else if constexpr (k < 5) {
            const GAS u32x4* sa = (const GAS u32x4*)(sbase + (size_t)(k - 3) * 16 * 8192); const GAS u32x4* sb = (const GAS u32x4*)(sbase + (size_t)(k - 2) * 16 * 8192);
#pragma unroll
            for (int ai = 0; ai < 2; ++ai)
#pragma unroll
                for (int bj = 0; bj < 2; ++bj) {
#pragma unroll
                    for (int m = 0; m < 4; ++m) { const int j16 = (ai * 2 + bj) * 4 + m; const u32x4 a = sa[j16 * 512], b = sb[j16 * 512];
                        f32x4& v0 = acc[ai][bj][m][0]; f32x4& v1 = acc[ai][bj][m][1];
                        v0[0] *= bf_lo(a.x) * __builtin_amdgcn_rcpf(bf_lo(b.x)); v0[1] *= bf_hi(a.x) * __builtin_amdgcn_rcpf(bf_hi(b.x));
                        v0[2] *= bf_lo(a.y) * __builtin_amdgcn_rcpf(bf_lo(b.y)); v0[3] *= bf_hi(a.y) * __builtin_amdgcn_rcpf(bf_hi(b.y));
                        v1[0] *= bf_lo(a.z) * __builtin_amdgcn_rcpf(bf_lo(b.z)); v1[1] *= bf_hi(a.z) * __builtin_amdgcn_rcpf(bf_hi(b.z));
                        v1[2] *= bf_lo(a.w) * __builtin_amdgcn_rcpf(bf_lo(b.w)); v1[3] *= bf_hi(a.w) * __builtin_amdgcn_rcpf(bf_hi(b.w));
                        asm volatile("" : "+v"(acc[ai][bj][m][0]), "+v"(acc[ai][bj][m][1]));
                        if (m & 1) asm volatile("" ::: "memory"); } }
        } else {
            const GAS u32x4* sa = (const GAS u32x4*)(sbase + (size_t)2 * 16 * 8192);
            const int row0 = u.pm * 256 + wr * 64 + fr, col0 = u.pn * 256 + wc * 32 + 8 * fq;
#pragma unroll
            for (int ai = 0; ai < 2; ++ai)
#pragma unroll
                for (int m = 0; m < 4; ++m) { bf16_t* rowp = O + (size_t)(row0 + ai * 128 + m * 16) * D + col0;
#pragma unroll
                    for (int bj = 0; bj < 2; ++bj) { const int j16 = (ai * 2 + bj) * 4 + m; const u32x4 a = sa[j16 * 512]; const f32x4 v0 = acc[ai][bj][m][0], v1 = acc[ai][bj][m][1];
                        u32x4 w; w.x = cvt_pk_bf16(v0[0] * bf_lo(a.x), v0[1] * bf_hi(a.x)); w.y = cvt_pk_bf16(v0[2] * bf_lo(a.y), v0[3] * bf_hi(a.y));
                        w.z = cvt_pk_bf16(v1[0] * bf_lo(a.z), v1[1] * bf_hi(a.z)); w.w = cvt_pk_bf16(v1[2] * bf_lo(a.w), v1[3] * bf_hi(a.w));
                        *(u32x4*)(rowp + bj * 128) = w; } }
        }
    }
};
struct EpiResid {
    static constexpr bool PERM = false;
    const float *xp, *xs; float* out; float* rowss;
    template <int KK> static constexpr bool zero_after() { return true; }
    template <int KK> __device__ __forceinline__ void run(f32x4 (&acc)[2][2][4][2], const pg8::Seg& u, int wr, int wc, int fr, int fq, int) const {
        const int row0 = u.pm * 256 + wr * 64 + fr, col0 = u.pn * 256 + wc * 32 + 4 * fq;
#pragma unroll
        for (int ai = 0; ai < 2; ++ai)
#pragma unroll
            for (int m = 0; m < 4; ++m) { const int r = row0 + ai * 128 + m * 16;
                const float* xr = (r < TP ? xp + (size_t)r * D : xs + (size_t)(r - TP) * D) + col0; float* orow = out + (size_t)r * D + col0; float ss = 0.f;
#pragma unroll
                for (int bj = 0; bj < 2; ++bj)
#pragma unroll
                    for (int n = 0; n < 2; ++n) { const f32x4 xv = *(const f32x4*)(xr + bj * 128 + n * 16); const f32x4 y = xv + acc[ai][bj][m][n];
                        ss += (y[0] * y[0] + y[1] * y[1]) + (y[2] * y[2] + y[3] * y[3]); *(f32x4*)(orow + bj * 128 + n * 16) = y; }
                ss += __shfl_xor(ss, 16); ss += __shfl_xor(ss, 32);
                if (fq == 0) rowss[(size_t)r * 16 + u.pn * 4 + wc] = ss;
                asm volatile("" ::: "memory"); }
    }
};

__device__ __forceinline__ void p0_transpose_item(const float* W, int K, int N, bf16_t* WT, LAS float* scr, int item, int lane) {
    const int nblk = N / 32, kb = item / nblk, nb = item % nblk, k0 = 64 * kb, n0 = 32 * nb;
#pragma unroll 8
    for (int i = 0; i < 32; ++i) { const int kk = 2 * i + (lane >> 5); scr[kk * 33 + (lane & 31)] = W[(size_t)(k0 + kk) * N + n0 + (lane & 31)]; }
    asm volatile("s_waitcnt lgkmcnt(0)" ::: "memory");
    const int c = lane & 7;
#pragma unroll
    for (int j = 0; j < 4; ++j) { const int n = (lane >> 3) + 8 * j; const LAS float* s = scr + (8 * c) * 33 + n;
        u32x4 o; o.x = cvt_pk_bf16(s[0 * 33], s[1 * 33]); o.y = cvt_pk_bf16(s[2 * 33], s[3 * 33]); o.z = cvt_pk_bf16(s[4 * 33], s[5 * 33]); o.w = cvt_pk_bf16(s[6 * 33], s[7 * 33]);
        *(u32x4*)(WT + (size_t)(n0 + n) * K + k0 + 8 * c) = o; }
    asm volatile("s_waitcnt lgkmcnt(0)" ::: "memory");
}
__device__ __forceinline__ void rms_row_to_bf16(const float* xrow, const float* g, bf16_t* orow, int lane) {
    const f32x4* xr = (const f32x4*)xrow + lane; const f32x4* gr = (const f32x4*)g + lane;
    f32x4 v[4]; float s = 0.f;
#pragma unroll
    for (int j = 0; j < 4; ++j) { v[j] = xr[64 * j]; s += (v[j][0] * v[j][0] + v[j][1] * v[j][1]) + (v[j][2] * v[j][2] + v[j][3] * v[j][3]); }
    const float rstd = 1.0f / sqrtf(wave_sum(s) * (1.0f / D) + EPS);
    u32x2* o8 = (u32x2*)orow + lane;
#pragma unroll
    for (int j = 0; j < 4; ++j) { const f32x4 gv = gr[64 * j]; u32x2 w; w.x = cvt_pk_bf16(v[j][0] * rstd * gv[0], v[j][1] * rstd * gv[1]); w.y = cvt_pk_bf16(v[j][2] * rstd * gv[2], v[j][3] * rstd * gv[3]); o8[64 * j] = w; }
}
__device__ __forceinline__ unsigned short f2bf(float f) { return (unsigned short)(cvt_pk_bf16(f, 0.f) & 0xffffu); }
__device__ __forceinline__ float cosrev(float x) { return __builtin_amdgcn_cosf(x); }
__device__ __forceinline__ float sinrev(float x) { return __builtin_amdgcn_sinf(x); }

__device__ __forceinline__ unsigned kv_off(int key, int chunk) { return (unsigned)(key * 128 + ((chunk ^ (key & 7)) << 4)); }
template <bool NA>
__device__ __forceinline__ void attn16(LAS unsigned char* Kimg, LAS unsigned char* Vimg, const LAS float* rpbs, int kbase, int kstride, const bf16_t* qrow  ,
                                       bf16_t* gate_out  , int fr, int fq, int lane,
                                       int qcol, int c0, int drbase  ) {
    bf16x8 qf[2];
#pragma unroll
    for (int ks = 0; ks < 2; ++ks) qf[ks] = *(const bf16x8*)(qrow + 32 * ks + 8 * fq);
    f32x4 sacc[16];
#pragma unroll
    for (int kb = 0; kb < 16; ++kb) {
        const int key = kbase + (kb >> 1) * kstride + (kb & 1) * 16 + fr;
        f32x4 a = (f32x4){0.f, 0.f, 0.f, 0.f};
#pragma unroll
        for (int ks = 0; ks < 2; ++ks) { const bf16x8 kf = *(const LAS bf16x8*)(Kimg + kv_off(key, 4 * ks + fq)); a = mfma16(kf, qf[ks], a); }
        sacc[kb] = a;
    }
    const float L2E = 1.4426950408889634f * 0.125f;
    float mx = -3.0e38f;
    const int cs = NA ? min(max(qcol - 8, 0), 48) : 0;
#pragma unroll
    for (int kb = 0; kb < 16; ++kb)
#pragma unroll
        for (int i = 0; i < 4; ++i) {
            float s = sacc[kb][i] * L2E;
            if (NA) { const int keycol = c0 + 16 * (kb & 1) + 4 * fq + i; const int rel = keycol - cs; const int dc = min(max(keycol - qcol + 15, 0), 30);
                s += rpbs[(drbase + (kb >> 1)) * 31 + dc] * 1.4426950408889634f;
                s = (rel >= 0 && rel < 16) ? s : -3.0e38f; }
            sacc[kb][i] = s; mx = fmaxf(mx, s);
        }
    mx = fmaxf(mx, __shfl_xor(mx, 16)); mx = fmaxf(mx, __shfl_xor(mx, 32));
    float sum = 0.f;
#pragma unroll
    for (int kb = 0; kb < 16; ++kb)
#pragma unroll
        for (int i = 0; i < 4; ++i) { const float p = __builtin_amdgcn_exp2f(sacc[kb][i] - mx); sacc[kb][i] = p; sum += p; }
    sum += __shfl_xor(sum, 16); sum += __shfl_xor(sum, 32);
    const float inv = 1.0f / sum;
    bf16x8 pf[8];
#pragma unroll
    for (int s = 0; s < 8; ++s) pf[s] = pack8(sacc[2 * s], sacc[2 * s + 1]);
    const int q4 = (lane & 15) >> 2, p4 = lane & 3;
    f32x4 oacc[4];
#pragma unroll
    for (int db = 0; db < 4; ++db) oacc[db] = (f32x4){0.f, 0.f, 0.f, 0.f};
#pragma unroll
    for (int s = 0; s < 8; ++s) {
        const int key0 = kbase + s * kstride + 4 * fq + q4, key1 = key0 + 16;
#pragma unroll
        for (int db = 0; db < 4; ++db) {
            const s16x4 v0 = tr_read(Vimg + kv_off(key0, 2 * db + (p4 >> 1)) + 8 * (p4 & 1));
            const s16x4 v1 = tr_read(Vimg + kv_off(key1, 2 * db + (p4 >> 1)) + 8 * (p4 & 1));
            oacc[db] = mfma16(cat4(v0, v1), pf[s], oacc[db]);
        }
    }
#pragma unroll
    for (int db = 0; db < 4; ++db) { u32x2* gp = (u32x2*)(gate_out + 16 * db + 4 * fq); const u32x2 gv = *gp; u32x2 w;
        w.x = cvt_pk_bf16(oacc[db][0] * inv * siluf_(bf_lo(gv.x)), oacc[db][1] * inv * siluf_(bf_hi(gv.x)));
        w.y = cvt_pk_bf16(oacc[db][2] * inv * siluf_(bf_lo(gv.y)), oacc[db][3] * inv * siluf_(bf_hi(gv.y)));
        *gp = w; }
}

__global__ void __launch_bounds__(NTHREADS) mk_fwd(Args a) {
    extern __shared__ __attribute__((aligned(16))) unsigned char lds_raw[];
    LAS unsigned char* lds = (LAS unsigned char*)lds_raw;
    cg::grid_group grid = cg::this_grid();
    const int tid = threadIdx.x, lane = tid & 63, wid = __builtin_amdgcn_readfirstlane(tid >> 6), fr = lane & 15, fq = lane >> 4;
    const int G = gridDim.x, blk = blockIdx.x;
    unsigned char* ws = a.ws; unsigned char* ob = (unsigned char*)a.out;
    bf16_t* z1 = (bf16_t*)(ws + WS_Z1); bf16_t* merged = (bf16_t*)(ws + WS_MERGED);
    bf16_t* WinT = (bf16_t*)(ws + WS_WIN); bf16_t* WkvT = (bf16_t*)(ws + WS_WKV); bf16_t* WfoT = (bf16_t*)(ws + WS_WFO); bf16_t* WnaT = (bf16_t*)(ws + WS_WNA);
    bf16_t* WcaT = (bf16_t*)(ws + WS_WCA); bf16_t* WoutT = (bf16_t*)(ws + WS_WOUT); bf16_t* kvmem = (bf16_t*)(ws + WS_KVMEM); bf16_t* memn = (bf16_t*)(ws + WS_MEMN);
    float* rowss = (float*)(ws + WS_ROWSS);
    bf16_t* tab64 = (bf16_t*)(ws + WS_TAB64); bf16_t* tab128 = (bf16_t*)(ws + WS_TAB128); bf16_t* tabC = (bf16_t*)(ws + WS_TABC);
    bf16_t* hb = (bf16_t*)(ob + OUT_HB); bf16_t* T2 = (bf16_t*)(ob + OUT_T2);
    const int lo = a.ph_lo, hi = a.ph_hi;
#ifndef SKIPMASK
#define SKIPMASK 0
#endif
#define IN(k) (!((SKIPMASK >> (k)) & 1) && lo <= (k) && (k) < hi)
#define SEAM(k) do { if (IN(k) && IN((k) + 1)) grid.sync(); } while (0)

    if (IN(0)) {
        LAS float* scr = (LAS float*)(lds + wid * 16384);
        const int gw = blk * 8 + wid, NGW = G * 8;
        constexpr int I_IN = 16 * (NIN / 32), I_KV = 16 * 16, I_FO = 6 * 32, I_NA = 6 * 32, I_CA = 4 * 32, I_OUT = 16 * 32;
        constexpr int NITEMS = I_IN + I_KV + I_FO + I_NA + I_CA + I_OUT;
        for (int it = gw; it < NITEMS; it += NGW) {
            int r = it;
            if (r < I_IN) { p0_transpose_item(a.w_in, D, NIN, WinT, scr, r, lane); continue; } r -= I_IN;
            if (r < I_KV) { p0_transpose_item(a.w_kv, D, 512, WkvT, scr, r, lane); continue; } r -= I_KV;
            if (r < I_FO) { p0_transpose_item(a.w_fo, 384, D, WfoT, scr, r, lane); continue; } r -= I_FO;
            if (r < I_NA) { p0_transpose_item(a.w_na, 384, D, WnaT, scr, r, lane); continue; } r -= I_NA;
            if (r < I_CA) { p0_transpose_item(a.w_ca, 256, D, WcaT, scr, r, lane); continue; } r -= I_CA;
            p0_transpose_item(a.w_out, D, D, WoutT, scr, r, lane);
        }
        for (int m = gw; m < T; m += NGW) rms_row_to_bf16(m < TP ? a.xp + (size_t)m * D : a.xs + (size_t)(m - TP) * D, a.g_norm, hb + (size_t)m * D, lane);
        for (int m = gw; m < NMEMROWS; m += NGW) rms_row_to_bf16(m < 2048 ? a.memp + (size_t)m * D : a.mems + (size_t)(m - 2048) * D, a.g_mem, memn + (size_t)m * D, lane);
        const int gt = blk * NTHREADS + tid, NT = G * NTHREADS;
        for (int i = gt; i < 64 * 64; i += NT) { const int k = i >> 6, n = i & 63; const float f = (float)((k * n) & 63) * (1.0f / 64.0f); const float c = cosrev(f), s = sinrev(f);
            tab64[i] = f2bf(c); tab64[4096 + i] = f2bf(-s); tab64[8192 + i] = f2bf(s); }
        for (int i = gt; i < 128 * 128; i += NT) { const int k = i >> 7, n = i & 127; const float f = (float)((k * n) & 127) * (1.0f / 128.0f); const float c = cosrev(f), s = sinrev(f);
            tab128[i] = f2bf(c); tab128[16384 + i] = f2bf(-s); tab128[32768 + i] = f2bf(s); }
        for (int i = gt; i < 96 * 96; i += NT) { const int l = i / 96, kap = i % 96; const int s = kap >> 5, g = (kap & 31) >> 3, j = kap & 7; const int m = 32 * s + 16 * (j >> 2) + 4 * g + (j & 3);
            const float f = (float)((m * l) % 96) * (1.0f / 96.0f); tabC[i] = f2bf(cosrev(f)); tabC[9216 + i] = f2bf(sinrev(f)); }
    }
    SEAM(0);

    if (IN(1)) {
        { PlainStream S; S.so.init(T, NZ, G, blk); S.A = (const char*)hb; S.B = (const char*)WinT; S.lda = D * 2; S.ldb = D * 2; S.nt = 16;
          EpiStoreBf16 E{z1, NZ}; pg8::gemm_stream<1>(lds, S, E); }
        { PlainStream S; S.so.init(NMEMROWS, 512, G, blk); S.A = (const char*)memn; S.B = (const char*)WkvT; S.lda = D * 2; S.ldb = D * 2; S.nt = 16;
          EpiStoreBf16 E{kvmem, 512}; pg8::gemm_stream<1>(lds, S, E); }
    }
    SEAM(1);

    if (IN(2)) {
        {
            LAS unsigned char* Kimg = lds; LAS unsigned char* Vimg = lds + 576 * 128; LAS float* rpbs = (LAS float*)(lds + 2 * 576 * 128);
            constexpr int NITEMS = 6144;
            for (int it = blk; it < NITEMS; it += G) {
                int q, band, h, R;
                if (it < 3072) { h = it % 6; const int t2 = it / 6; band = t2 & 63; q = t2 >> 6; R = 128; }
                else { const int i2 = it - 3072; h = i2 % 6; const int t2 = i2 / 6; band = t2 & 31; q = 8 + (t2 >> 5); R = 64; }
                const int sb = seq_base(q), r0 = 2 * band, rb = min(max(r0 - 4, 0), R - 8);
                __syncthreads();
                for (int c = tid; c < 576 * 8; c += NTHREADS) { const int key = c >> 3, ch = c & 7, lr = key >> 6, col = key & 63; const int row = min(rb + lr, R - 1);
                    const bf16_t* src = z1 + (size_t)(sb + row * 64 + col) * NZ + h * 64 + ch * 8;
                    *(LAS u32x4*)(Kimg + kv_off(key, ch)) = *(const u32x4*)(src + C_K); *(LAS u32x4*)(Vimg + kv_off(key, ch)) = *(const u32x4*)(src + C_V); }
                for (int c = tid; c < 465; c += NTHREADS) rpbs[c] = a.rpb[h * 465 + c];
                __syncthreads();
                const int r = r0 + (wid >> 2), j = wid & 3, rs = min(max(r - 4, 0), R - 8), c0 = min(max(16 * j - 8, 0), 32);
                bf16_t* trow = z1 + (size_t)(sb + r * 64 + 16 * j + fr) * NZ;
                attn16<true>(Kimg, Vimg, rpbs, (rs - rb) * 64 + c0, 64, trow + C_Q + h * 64, trow + C_GNA + h * 64, fr, fq, lane, 16 * j + fr, c0, rs - r + 7);
            }
        }
        {
            LAS unsigned char* Kimg = lds; LAS unsigned char* Vimg = lds + 256 * 128;
            constexpr int NITEMS = 512;
            for (int it = blk; it < NITEMS; it += G) {
                int q, h, ck;
                if (it < 256) { ck = it & 7; h = (it >> 3) & 3; q = it >> 5; } else { const int i2 = it - 256; ck = i2 & 3; h = (i2 >> 2) & 3; q = 8 + (i2 >> 4); }
                const int tok0 = seq_base(q) + ck * 1024;
                __syncthreads();
                for (int c = tid; c < 256 * 8; c += NTHREADS) { const int key = c >> 3, ch = c & 7; const bf16_t* src = kvmem + (size_t)(q * 256 + key) * 512 + h * 64 + ch * 8;
                    *(LAS u32x4*)(Kimg + kv_off(key, ch)) = *(const u32x4*)(src); *(LAS u32x4*)(Vimg + kv_off(key, ch)) = *(const u32x4*)(src + 256); }
                __syncthreads();
                for (int i = 0; i < 8; ++i) { bf16_t* trow = z1 + (size_t)(tok0 + (wid * 8 + i) * 16 + fr) * NZ;
                    attn16<false>(Kimg, Vimg, nullptr, 0, 32, trow + C_QCA + h * 64, trow + C_GCA + h * 64, fr, fq, lane, 0, 0, 0); }
            }
        }
        {
            constexpr int US = 784;
            constexpr int NITEMS = 2048;
            bf16x8 af[8][2];
#pragma unroll
            for (int mb = 0; mb < 8; ++mb)
#pragma unroll
                for (int ks = 0; ks < 2; ++ks) af[mb][ks] = *(const bf16x8*)(tab64 + (mb >> 2) * 4096 + ((mb & 3) * 16 + fr) * 64 + 32 * ks + 8 * fq);
            const int q4 = (lane & 15) >> 2, p4 = lane & 3;
            for (int it = blk; it < NITEMS; it += G) {
                int q, n2, N2, S;
                if (it < 1024) { q = it >> 7; n2 = it & 127; N2 = 128; S = 8192; } else { const int i2 = it - 1024; q = 8 + (i2 >> 6); n2 = i2 & 63; N2 = 64; S = 4096; }
                const int sb = seq_base(q);
                __syncthreads();
                for (int c = tid; c < 64 * 48; c += NTHREADS) { const int n1 = c / 48, ch = c % 48;
                    *(LAS u32x4*)(lds + n1 * US + ch * 16) = *(const u32x4*)(z1 + (size_t)(sb + N2 * n1 + n2) * NZ + C_UF + ch * 8); }
                __syncthreads();
                const float invS = 1.0f / (float)S;
#pragma unroll 1
                for (int cc = 0; cc < 3; ++cc) {
                    const int c = wid * 3 + cc;
                    bf16x8 bfr[2];
#pragma unroll
                    for (int ks = 0; ks < 2; ++ks) { LAS unsigned char* p = lds + (32 * ks + 8 * fq + q4) * US + (16 * c + 4 * p4) * 2; bfr[ks] = cat4(tr_read(p), tr_read(p + 4 * US)); }
                    f32x4 acc[8];
#pragma unroll
                    for (int mb = 0; mb < 8; ++mb) { f32x4 v = (f32x4){0.f, 0.f, 0.f, 0.f}; v = mfma16(af[mb][0], bfr[0], v); v = mfma16(af[mb][1], bfr[1], v); acc[mb] = v; }
                    const int ch = 16 * c + fr, grp = ch / 96, mm = ch - grp * 96;
#pragma unroll
                    for (int mb = 0; mb < 4; ++mb)
#pragma unroll
                        for (int i = 0; i < 4; ++i) { const int k1 = mb * 16 + 4 * fq + i; const float f = (float)((n2 * k1) & (S - 1)) * invS; const float cs = cosrev(f), sn = sinrev(f);
                            const float tr = acc[mb][i], ti = acc[mb + 4][i]; bf16_t* dst = T2 + (size_t)(sb + k1 * N2 + n2) * 768 + grp * 192 + mm;
                            dst[0] = f2bf(tr * cs + ti * sn); dst[96] = f2bf(ti * cs - tr * sn); }
                }
            }
        }
    }
    SEAM(2);

    if (IN(3)) {
        constexpr int TS = 400;
        constexpr int NITEMS = 4096;
        const int q4 = (lane & 15) >> 2, p4 = lane & 3;
        for (int it = blk; it < NITEMS; it += G) {
            const bool big = it < 2048;
            int q, k1, grp, kb2, N2, S; LAS unsigned char* tile;
            if (big) { grp = it & 3; k1 = (it >> 2) & 63; q = it >> 8; N2 = 128; S = 8192; kb2 = wid; tile = lds; }
            else { const int i2 = it - 2048; const int gp = i2 & 1; k1 = (i2 >> 1) & 63; q = 8 + (i2 >> 7); N2 = 64; S = 4096; kb2 = wid & 3; grp = 2 * gp + (wid >> 2); tile = lds + (wid >> 2) * 64 * TS; }
            const int sb = seq_base(q);
            __syncthreads();
            if (big) { for (int c = tid; c < 128 * 24; c += NTHREADS) { const int n2 = c / 24, ch = c % 24;
                    *(LAS u32x4*)(lds + n2 * TS + ch * 16) = *(const u32x4*)(T2 + (size_t)(sb + k1 * 128 + n2) * 768 + grp * 192 + ch * 8); } }
            else { const int gp = (it - 2048) & 1; for (int c = tid; c < 128 * 24; c += NTHREADS) { const int rr = c / 24, ch = c % 24, tt = rr >> 6, n2 = rr & 63;
                    *(LAS u32x4*)(lds + rr * TS + ch * 16) = *(const u32x4*)(T2 + (size_t)(sb + k1 * 64 + n2) * 768 + (2 * gp + tt) * 192 + ch * 8); } }
            __syncthreads();
            const bf16_t* tab = big ? tab128 : tab64; const int tsz = N2 * N2; const int nks = N2 / 32;
            f32x4 zr[6], zi[6];
#pragma unroll
            for (int cb = 0; cb < 6; ++cb) { zr[cb] = (f32x4){0.f, 0.f, 0.f, 0.f}; zi[cb] = (f32x4){0.f, 0.f, 0.f, 0.f}; }
#pragma unroll 1
            for (int ks = 0; ks < nks; ++ks) {
                const bf16_t* tp = tab + (16 * kb2 + fr) * N2 + 32 * ks + 8 * fq;
                const bf16x8 wre = *(const bf16x8*)(tp), wim = *(const bf16x8*)(tp + tsz), wni = *(const bf16x8*)(tp + 2 * tsz);
                LAS unsigned char* rowp = tile + (32 * ks + 8 * fq + q4) * TS + 8 * p4;
#pragma unroll
                for (int cb = 0; cb < 6; ++cb) {
                    const bf16x8 trf = cat4(tr_read(rowp + 32 * cb), tr_read(rowp + 32 * cb + 4 * TS));
                    const bf16x8 tif = cat4(tr_read(rowp + 192 + 32 * cb), tr_read(rowp + 192 + 32 * cb + 4 * TS));
                    zr[cb] = mfma16(trf, wre, zr[cb]); zr[cb] = mfma16(tif, wni, zr[cb]);
                    zi[cb] = mfma16(tif, wre, zi[cb]); zi[cb] = mfma16(trf, wim, zi[cb]);
                }
            }
            bf16x8 zfr[3], zfi[3];
#pragma unroll
            for (int s = 0; s < 3; ++s) { zfr[s] = pack8(zr[2 * s], zr[2 * s + 1]); zfi[s] = pack8(zi[2 * s], zi[2 * s + 1]); }
            const float scale = 1.0f / sqrtf((float)S * 96.0f);
            bf16_t* trow = z1 + (size_t)(sb + k1 + 64 * (16 * kb2 + fr)) * NZ + C_GF + grp * 96 + 4 * fq;
#pragma unroll
            for (int lb = 0; lb < 6; ++lb) {
                f32x4 y = (f32x4){0.f, 0.f, 0.f, 0.f};
#pragma unroll
                for (int s = 0; s < 3; ++s) { const bf16_t* cp = tabC + (16 * lb + fr) * 96 + 32 * s + 8 * fq;
                    y = mfma16(*(const bf16x8*)cp, zfr[s], y); y = mfma16(*(const bf16x8*)(cp + 9216), zfi[s], y); }
                u32x2* gp2 = (u32x2*)(trow + 16 * lb); const u32x2 gv = *gp2; u32x2 w;
                w.x = cvt_pk_bf16(y[0] * scale * siluf_(bf_lo(gv.x)), y[1] * scale * siluf_(bf_hi(gv.x)));
                w.y = cvt_pk_bf16(y[2] * scale * siluf_(bf_lo(gv.y)), y[3] * scale * siluf_(bf_hi(gv.y)));
                *gp2 = w;
            }
        }
    }
    SEAM(3);

    if (IN(4)) {
        MergeStream S; S.so.init(T, D, G, blk); S.hb = (const char*)hb; S.z1 = (const char*)z1; S.win = (const char*)WinT; S.wfo = (const char*)WfoT; S.wna = (const char*)WnaT; S.wca = (const char*)WcaT;
        EpiMerge E{ob + OUT_T2 + (size_t)blk * (3 * 16 * 8192), merged};
        pg8::gemm_stream<6>(lds, S, E);
    }
    SEAM(4);

    if (IN(5)) {
        PlainStream S; S.so.init(T, D, G, blk); S.A = (const char*)merged; S.B = (const char*)WoutT; S.lda = D * 2; S.ldb = D * 2; S.nt = 16;
        EpiResid E{a.xp, a.xs, a.out, rowss};
        pg8::gemm_stream<1>(lds, S, E);
    }
    SEAM(5);

    if (IN(6)) {
        const int gw = blk * 8 + wid, NGW = G * 8;
        for (int m = gw; m < T; m += NGW) {
            float s = lane < 16 ? rowss[(size_t)m * 16 + lane] : 0.f;
            s = wave_sum(s);
            const float rstd = 1.0f / sqrtf(s * (1.0f / D) + EPS);
            f32x4* yr = (f32x4*)(a.out + (size_t)m * D) + lane; const f32x4* gr = (const f32x4*)a.g_final + lane;
#pragma unroll
            for (int j = 0; j < 4; ++j) { const f32x4 v = yr[64 * j], gv = gr[64 * j]; yr[64 * j] = v * rstd * gv; }
        }
    }
}

extern "C" void kernel_launch(void* const* d_in, const int* in_sizes, int n_in, void* d_out, int out_size, void* d_ws, size_t ws_size, hipStream_t stream) {
    static int grid = 0;
    if (grid == 0) {
        if (n_in != 14 || out_size != T * D || ws_size < WS_END) { fprintf(stderr, "kernel_launch: unexpected sizes (n_in %d out %d ws %zu, need ws >= %zu)\n", n_in, out_size, ws_size, (size_t)WS_END); grid = -1; return; }
        int dev = 0, cus = 0, per_cu = 0;
        if (hipGetDevice(&dev) != hipSuccess || hipDeviceGetAttribute(&cus, hipDeviceAttributeMultiprocessorCount, dev) != hipSuccess) { grid = -1; return; }
        if (hipFuncSetAttribute((const void*)mk_fwd, hipFuncAttributeMaxDynamicSharedMemorySize, LDS_BYTES) != hipSuccess) { fprintf(stderr, "kernel_launch: hipFuncSetAttribute failed\n"); grid = -1; return; }
        if (hipOccupancyMaxActiveBlocksPerMultiprocessor(&per_cu, (const void*)mk_fwd, NTHREADS, LDS_BYTES) != hipSuccess || per_cu < 1) { fprintf(stderr, "kernel_launch: occupancy query says %d blocks per CU\n", per_cu); grid = -1; return; }
        grid = cus;
    }
    if (grid < 0) return;
    Args a{};
    a.xp = (const float*)d_in[0]; a.xs = (const float*)d_in[1]; a.memp = (const float*)d_in[2]; a.mems = (const float*)d_in[3]; a.g_norm = (const float*)d_in[4];
    a.w_in = (const float*)d_in[5]; a.rpb = (const float*)d_in[6]; a.g_mem = (const float*)d_in[7]; a.w_kv = (const float*)d_in[8]; a.w_fo = (const float*)d_in[9];
    a.w_na = (const float*)d_in[10]; a.w_ca = (const float*)d_in[11]; a.w_out = (const float*)d_in[12]; a.g_final = (const float*)d_in[13];
    a.out = (float*)d_out; a.ws = (unsigned char*)d_ws;
#if MK_N_LAUNCHES == 1
    a.ph_lo = 0; a.ph_hi = NPHASES;
    { void* args[] = {&a}; hipError_t e = hipLaunchCooperativeKernel((const void*)mk_fwd, dim3(grid), dim3(NTHREADS), args, LDS_BYTES, stream);
      if (e != hipSuccess) fprintf(stderr, "kernel_launch: cooperative launch failed: %s\n", hipGetErrorString(e)); }
#else
    for (int p = 0; p < NPHASES; ++p) { a.ph_lo = p; a.ph_hi = p + 1; void* args[] = {&a};
        hipError_t e = hipLaunchCooperativeKernel((const void*)mk_fwd, dim3(grid), dim3(NTHREADS), args, LDS_BYTES, stream);
        if (e != hipSuccess) { fprintf(stderr, "kernel_launch: launch %d failed: %s\n", p, hipGetErrorString(e)); break; } }
#endif
}
```

```cpp
#include <hip/hip_runtime.h>
#include <hip/hip_cooperative_groups.h>
#include <cstdio>
#include <cstdint>
namespace cg = cooperative_groups;

#ifndef MK_N_LAUNCHES
#define MK_N_LAUNCHES 1
#endif

#define LAS __attribute__((address_space(3)))
#define GAS __attribute__((address_space(1)))
typedef unsigned short bf16_t;
typedef short bf16x8 __attribute__((ext_vector_type(8)));
typedef short s16x4 __attribute__((ext_vector_type(4)));
typedef float f32x4 __attribute__((ext_vector_type(4)));
typedef unsigned u32x4 __attribute__((ext_vector_type(4)));
typedef unsigned u32x2 __attribute__((ext_vector_type(2)));

constexpr int D = 1024, T = 131072, TP = 65536, NZ = 2816, NIN = 5888, NMEMROWS = 6144;
constexpr int C_UF = 0, C_GF = 384, C_Q = 768, C_K = 1152, C_V = 1536, C_GNA = 1920, C_QCA = 2304, C_GCA = 2560;
constexpr float EPS = 1e-6f;
constexpr int NPHASES = 7;
constexpr int LDS_BYTES = 153600;
constexpr int NTHREADS = 512;

constexpr size_t WS_Z1 = 0;
constexpr size_t WS_MERGED = WS_Z1 + (size_t)T * NZ * 2;
constexpr size_t WS_WIN = WS_MERGED + (size_t)T * D * 2;
constexpr size_t WS_WKV = WS_WIN + (size_t)NIN * D * 2;
constexpr size_t WS_WFO = WS_WKV + (size_t)512 * D * 2;
constexpr size_t WS_WNA = WS_WFO + (size_t)D * 384 * 2;
constexpr size_t WS_WCA = WS_WNA + (size_t)D * 384 * 2;
constexpr size_t WS_WOUT = WS_WCA + (size_t)D * 256 * 2;
constexpr size_t WS_KVMEM = WS_WOUT + (size_t)D * D * 2;
constexpr size_t WS_MEMN = WS_KVMEM + (size_t)NMEMROWS * 512 * 2;
constexpr size_t WS_ROWSS = WS_MEMN + (size_t)NMEMROWS * D * 2;
constexpr size_t WS_TAB64 = WS_ROWSS + (size_t)T * 16 * 4;
constexpr size_t WS_TAB128 = WS_TAB64 + 3 * 64 * 64 * 2;
constexpr size_t WS_TABC = WS_TAB128 + 3 * 128 * 128 * 2;
constexpr size_t WS_END = WS_TABC + 2 * 96 * 96 * 2;
constexpr size_t OUT_HB = 0;
constexpr size_t OUT_T2 = (size_t)T * D * 2;
constexpr size_t OUT_END = OUT_T2 + (size_t)T * 768 * 2;
static_assert(OUT_END <= (size_t)T * D * 4, "d_out scratch");

struct Args {
    const float *xp, *xs, *memp, *mems, *g_norm, *w_in, *rpb, *g_mem, *w_kv, *w_fo, *w_na, *w_ca, *w_out, *g_final;
    float* out; unsigned char* ws; int ph_lo, ph_hi;
};

typedef __bf16 bf16v2 __attribute__((ext_vector_type(2)));
typedef float f32x2 __attribute__((ext_vector_type(2)));
__device__ __forceinline__ unsigned cvt_pk_bf16(float lo, float hi) { const f32x2 v = {lo, hi}; return __builtin_bit_cast(unsigned, __builtin_convertvector(v, bf16v2)); }
__device__ __forceinline__ float bf_lo(unsigned w) { return __uint_as_float(w << 16); }
__device__ __forceinline__ float bf_hi(unsigned w) { return __uint_as_float(w & 0xffff0000u); }
__device__ __forceinline__ float wave_sum(float v) {
#pragma unroll
    for (int o = 1; o < 64; o <<= 1) v += __shfl_xor(v, o);
    return v;
}
__device__ __forceinline__ float sigmoidf_(float x) { return __builtin_amdgcn_rcpf(1.0f + __expf(-x)); }
__device__ __forceinline__ float siluf_(float x) { return x * sigmoidf_(x); }
__device__ __forceinline__ int seq_base(int q) { return q < 8 ? q * 8192 : TP + (q - 8) * 4096; }
__device__ __forceinline__ f32x4 mfma16(bf16x8 a, bf16x8 b, f32x4 c) { return __builtin_amdgcn_mfma_f32_16x16x32_bf16(a, b, c, 0, 0, 0); }
__device__ __forceinline__ bf16x8 cat4(s16x4 a, s16x4 b) { return __builtin_shufflevector(a, b, 0, 1, 2, 3, 4, 5, 6, 7); }
__device__ __forceinline__ s16x4 tr_read(LAS unsigned char* p) { return __builtin_amdgcn_ds_read_tr16_b64_v4i16((LAS s16x4*)p); }
__device__ __forceinline__ bf16x8 pack8(f32x4 a, f32x4 b) {
    u32x4 p; p.x = cvt_pk_bf16(a[0], a[1]); p.y = cvt_pk_bf16(a[2], a[3]); p.z = cvt_pk_bf16(b[0], b[1]); p.w = cvt_pk_bf16(b[2], b[3]);
    return __builtin_bit_cast(bf16x8, p);
}

namespace pg8 {
constexpr int BM = 256, BK = 64, HALF = 128, HTB = HALF * BK * 2, STAGE_BYTES = 8 * HTB, NXCD = 8, WGM = 8;
__device__ __forceinline__ int lds_byte(int r, int c) { const int st = (r >> 4) * 2 + (c >> 5), rr = r & 15, cc = c & 31, ob = rr * 64 + cc * 2; return st * 1024 + (ob ^ (((ob >> 9) & 1) << 5)); }
__device__ __forceinline__ void stage_rc(int b, int& R, int& C) { const int st = b / 1024, sb = b % 1024, swz = sb ^ (((sb >> 9) & 1) << 5); R = (st >> 1) * 16 + swz / 64; C = (st & 1) * 32 + (swz % 64) / 2; }
__device__ __forceinline__ int perm32(int rho) { const int n = rho >> 4, i = rho & 15; return 8 * (i >> 2) + 4 * n + (i & 3); }

struct Unit { int pm, pn; };
struct StaticOrder {
    int nM, nN, nwg, G, c;
    __device__ void init(int M, int N, int G_, int c_) { nM = M / BM; nN = N / BM; nwg = nM * nN; G = G_; c = c_; }
    __device__ bool next(int i, Unit& u) const {
        const long L = (long)i * G + c; if (L >= nwg) return false;
        int wgid = (int)L; { const int q = nwg / NXCD, r = nwg % NXCD, xcd = wgid % NXCD, off = wgid / NXCD; wgid = (xcd < r ? xcd * (q + 1) : r * (q + 1) + (xcd - r) * q) + off; }
        const int nig = WGM * nN, gid = wgid / nig, fm = gid * WGM, gsz = (nM - fm) < WGM ? (nM - fm) : WGM;
        u.pm = fm + ((wgid % nig) % gsz); u.pn = (wgid % nig) / gsz; return true;
    }
};
struct Seg { const char* A; const char* B; unsigned lda, ldb; int nt, kind, pm, pn; };

template <int NSEG, class Epi, class Stream>
__device__ __forceinline__ void gemm_stream(LAS unsigned char* lds, const Stream& S, const Epi& E) {
    const int tid = threadIdx.x, wid = __builtin_amdgcn_readfirstlane(tid >> 6), lane = tid & 63, wr = wid >> 2, wc = wid & 3, fr = lane & 15, fq = lane >> 4;
    unsigned Ra0, Rb0, Cc0;
    { int R, C; stage_rc(tid * 16, R, C); Ra0 = (unsigned)R; Rb0 = (unsigned)(Epi::PERM ? ((R & ~31) + perm32(R & 31)) : R); Cc0 = (unsigned)C * 2u; }
    const size_t kstep = (size_t)(BK * 2);
    const unsigned ldsw = (unsigned)wid * 1024u;
    const int aoff = lds_byte(wr * 64 + fr, fq * 8), boff = lds_byte(wc * 32 + fr, fq * 8);
#define PG8_SA(b, h) (((b) * 2 + (h)) * HTB)
#define PG8_SB(b, h) ((4 + (b) * 2 + (h)) * HTB)
#define PG8_STAGE(bufoff, gbase, v0, ld) do { \
        __builtin_amdgcn_global_load_lds((const unsigned*)((const char*)(gbase) + (v0)), (LAS unsigned*)(lds + (bufoff) + ldsw), 16, 0, 0); \
        __builtin_amdgcn_global_load_lds((const unsigned*)((const char*)(gbase) + (size_t)64 * (ld) + (v0)), (LAS unsigned*)(lds + (bufoff) + ldsw + 8192), 16, 0, 0); } while (0)
#define PG8_LDA(dst, b, h) do { _Pragma("unroll") for (int m = 0; m < 4; ++m) _Pragma("unroll") for (int k = 0; k < 2; ++k) dst[m][k] = *(const LAS bf16x8*)(lds + PG8_SA(b, h) + aoff + m * 2048 + k * 1024); } while (0)
#define PG8_LDB(dst, b, h) do { _Pragma("unroll") for (int n = 0; n < 2; ++n) _Pragma("unroll") for (int k = 0; k < 2; ++k) dst[n][k] = *(const LAS bf16x8*)(lds + PG8_SB(b, h) + boff + n * 2048 + k * 1024); } while (0)
#define PG8_MMA(ai, bj, At, Bt) do { __builtin_amdgcn_s_setprio(1); _Pragma("unroll") for (int m = 0; m < 4; ++m) _Pragma("unroll") for (int n = 0; n < 2; ++n) _Pragma("unroll") for (int k = 0; k < 2; ++k) \
        acc[ai][bj][m][n] = __builtin_amdgcn_mfma_f32_16x16x32_bf16(Bt[n][k], At[m][k], acc[ai][bj][m][n], 0, 0, 0); __builtin_amdgcn_s_setprio(0); } while (0)
#define PG8_WAIT_V(n) asm volatile("s_waitcnt vmcnt(" #n ")" ::: "memory")
#define PG8_WAIT_L(n) asm volatile("s_waitcnt lgkmcnt(" #n ")" ::: "memory")
#define PG8_BAR __builtin_amdgcn_s_barrier()
#define PG8_SCHED __builtin_amdgcn_sched_barrier(0)
#define PG8_ZERO() do { _Pragma("unroll") for (int a_ = 0; a_ < 2; ++a_) _Pragma("unroll") for (int b_ = 0; b_ < 2; ++b_) _Pragma("unroll") for (int m_ = 0; m_ < 4; ++m_) _Pragma("unroll") for (int n_ = 0; n_ < 2; ++n_) \
        acc[a_][b_][m_][n_] = (f32x4){0.f, 0.f, 0.f, 0.f}; } while (0)
    Seg cur, nxt; int ui = 0;
    if (!S.template seg<0>(0, cur)) return;
    f32x4 acc[2][2][4][2];
    PG8_ZERO();
    bf16x8 At[4][2], B0[2][2], B1[2][2];
    const char* cA = cur.A; const char* cB = cur.B;
    unsigned vAc0 = Ra0 * cur.lda + Cc0, vBc0 = Rb0 * cur.ldb + Cc0, ldAc = cur.lda, ldBc = cur.ldb;
    size_t hAc = (size_t)HALF * cur.lda, hBc = (size_t)HALF * cur.ldb;
    PG8_STAGE(PG8_SB(0, 0), cB, vBc0, ldBc); PG8_STAGE(PG8_SA(0, 0), cA, vAc0, ldAc); PG8_STAGE(PG8_SB(0, 1), cB + hBc, vBc0, ldBc); PG8_STAGE(PG8_SA(0, 1), cA + hAc, vAc0, ldAc);
    if (wr == 1) PG8_BAR;
    PG8_WAIT_V(4); PG8_BAR;
    PG8_STAGE(PG8_SB(1, 0), cB + kstep, vBc0, ldBc); PG8_STAGE(PG8_SA(1, 0), cA + kstep, vAc0, ldAc); PG8_STAGE(PG8_SB(1, 1), cB + hBc + kstep, vBc0, ldBc);
    PG8_WAIT_V(6); PG8_BAR;
#define PG8_SEG(KK) if constexpr (NSEG > (KK)) { \
        bool has_next; if constexpr ((KK) + 1 < NSEG) { S.template seg<((KK) + 1 < NSEG ? (KK) + 1 : 0)>(ui, nxt); has_next = true; } else has_next = S.template seg<0>(ui + 1, nxt); \
        if (!has_next) nxt = cur;     \
        const char* nA = nxt.A; const char* nB = nxt.B; \
        const unsigned vAn0 = Ra0 * nxt.lda + Cc0, vBn0 = Rb0 * nxt.ldb + Cc0, ldAn = nxt.lda, ldBn = nxt.ldb; \
        const size_t hAn = (size_t)HALF * nxt.lda, hBn = (size_t)HALF * nxt.ldb; \
        const int nt = cur.nt; \
        for (int t = 0; t < nt; t += 2) { \
            const bool last = (t == nt - 2); \
            const char* a1 = cA + (size_t)(t + 1) * kstep; \
            const char* a2 = last ? nA : cA + (size_t)(t + 2) * kstep; const char* b2 = last ? nB : cB + (size_t)(t + 2) * kstep; \
            const char* a3 = a2 + kstep; const char* b3 = b2 + kstep; \
            const unsigned vA0 = last ? vAn0 : vAc0, vB0 = last ? vBn0 : vBc0, lA2 = last ? ldAn : ldAc, lB2 = last ? ldBn : ldBc; \
            const size_t hA2 = last ? hAn : hAc, hB2 = last ? hBn : hBc; \
            PG8_LDB(B0, 0, 0); PG8_SCHED; PG8_LDA(At, 0, 0); PG8_STAGE(PG8_SA(1, 1), a1 + hAc, vAc0, ldAc); \
            PG8_WAIT_L(8); PG8_BAR; PG8_WAIT_L(0); PG8_MMA(0, 0, At, B0); PG8_BAR; PG8_SCHED; \
            PG8_LDB(B1, 0, 1); PG8_STAGE(PG8_SB(0, 0), b2, vB0, lB2); \
            PG8_BAR; PG8_WAIT_L(0); PG8_MMA(0, 1, At, B1); PG8_BAR; \
            PG8_LDA(At, 0, 1); PG8_STAGE(PG8_SA(0, 0), a2, vA0, lA2); \
            PG8_BAR; PG8_WAIT_L(0); PG8_MMA(1, 0, At, B0); PG8_BAR; PG8_SCHED; \
            PG8_STAGE(PG8_SB(0, 1), b2 + hB2, vB0, lB2); \
            PG8_WAIT_V(6); PG8_BAR; PG8_MMA(1, 1, At, B1); PG8_BAR; \
            PG8_LDB(B0, 1, 0); PG8_SCHED; PG8_LDA(At, 1, 0); PG8_STAGE(PG8_SA(0, 1), a2 + hA2, vA0, lA2); \
            PG8_WAIT_L(8); PG8_BAR; PG8_WAIT_L(0); PG8_MMA(0, 0, At, B0); PG8_BAR; PG8_SCHED; \
            PG8_LDB(B1, 1, 1); PG8_STAGE(PG8_SB(1, 0), b3, vB0, lB2); \
            PG8_BAR; PG8_WAIT_L(0); PG8_MMA(0, 1, At, B1); PG8_BAR; \
            PG8_LDA(At, 1, 1); PG8_STAGE(PG8_SA(1, 0), a3, vA0, lA2); \
            PG8_BAR; PG8_WAIT_L(0); PG8_MMA(1, 0, At, B0); PG8_BAR; PG8_SCHED; \
            PG8_STAGE(PG8_SB(1, 1), b3 + hB2, vB0, lB2); \
            PG8_WAIT_V(6); PG8_BAR; PG8_MMA(1, 1, At, B1); PG8_BAR; \
        } \
        E.template run<(KK)>(acc, cur, wr, wc, fr, fq, tid); \
        if (!has_next) break; \
        if constexpr (Epi::template zero_after<(KK)>()) PG8_ZERO(); \
        cur = nxt; cA = nA; cB = nB; vAc0 = vAn0; vBc0 = vBn0; ldAc = ldAn; ldBc = ldBn; hAc = hAn; hBc = hBn; }
    for (;;) {
        PG8_SEG(0) PG8_SEG(1) PG8_SEG(2) PG8_SEG(3) PG8_SEG(4) PG8_SEG(5)
        ++ui;
    }
    PG8_WAIT_V(0);
    if (wr == 0) PG8_BAR;
    PG8_BAR;
#undef PG8_SA
#undef PG8_SB
#undef PG8_STAGE
#undef PG8_LDA
#undef PG8_LDB
#undef PG8_MMA
#undef PG8_WAIT_V
#undef PG8_WAIT_L
#undef PG8_BAR
#undef PG8_SCHED
#undef PG8_ZERO
#undef PG8_SEG
}
}

struct PlainStream {
    pg8::StaticOrder so; const char* A; const char* B; unsigned lda, ldb; int nt;
    template <int KK> __device__ __forceinline__ bool seg(int i, pg8::Seg& s) const { pg8::Unit u; if (!so.next(i, u)) return false;
        s.A = A + (size_t)u.pm * 256 * lda; s.B = B + (size_t)u.pn * 256 * ldb; s.lda = lda; s.ldb = ldb; s.nt = nt; s.kind = 0; s.pm = u.pm; s.pn = u.pn; return true; }
};
struct EpiStoreBf16 {
    static constexpr bool PERM = true;
    bf16_t* O; int ldc;
    template <int KK> static constexpr bool zero_after() { return true; }
    template <int KK> __device__ __forceinline__ void run(f32x4 (&acc)[2][2][4][2], const pg8::Seg& u, int wr, int wc, int fr, int fq, int) const {
        const int row0 = u.pm * 256 + wr * 64 + fr, col0 = u.pn * 256 + wc * 32 + 8 * fq;
#pragma unroll
        for (int ai = 0; ai < 2; ++ai)
#pragma unroll
            for (int m = 0; m < 4; ++m) { bf16_t* rowp = O + (size_t)(row0 + ai * 128 + m * 16) * ldc + col0;
#pragma unroll
                for (int bj = 0; bj < 2; ++bj) { const f32x4 v0 = acc[ai][bj][m][0], v1 = acc[ai][bj][m][1];
                    u32x4 w; w.x = cvt_pk_bf16(v0[0], v0[1]); w.y = cvt_pk_bf16(v0[2], v0[3]); w.z = cvt_pk_bf16(v1[0], v1[1]); w.w = cvt_pk_bf16(v1[2], v1[3]);
                    *(u32x4*)(rowp + bj * 128) = w; } }
    }
};

struct MergeStream {
    pg8::StaticOrder so; const char *hb, *z1, *win, *wfo, *wna, *wca;
    template <int KK> __device__ __forceinline__ bool seg(int ui, pg8::Seg& s) const { pg8::Unit u; constexpr int k = KK; if (!so.next(ui, u)) return false;
        s.kind = k; s.pm = u.pm; s.pn = u.pn;
        if (k < 3) { s.A = hb + (size_t)u.pm * 256 * (D * 2); s.lda = D * 2; s.B = win + (size_t)(NZ + k * D + u.pn * 256) * (D * 2); s.ldb = D * 2; s.nt = 16; }
        else { s.lda = NZ * 2; const char* a = z1 + (size_t)u.pm * 256 * (NZ * 2);
            if (k == 3) { s.A = a + C_GF * 2; s.B = wfo + (size_t)u.pn * 256 * (384 * 2); s.ldb = 384 * 2; s.nt = 6; }
            else if (k == 4) { s.A = a + C_GNA * 2; s.B = wna + (size_t)u.pn * 256 * (384 * 2); s.ldb = 384 * 2; s.nt = 6; }
            else { s.A = a + C_GCA * 2; s.B = wca + (size_t)u.pn * 256 * (256 * 2); s.ldb = 256 * 2; s.nt = 4; } }
        return true; }
};
struct EpiMerge {
    static constexpr bool PERM = true;
    unsigned char* stash; bf16_t* O;
    template <int KK> static constexpr bool zero_after() { return KK < 3 || KK == 5; }
    template <int KK> __device__ __forceinline__ void run(f32x4 (&acc)[2][2][4][2], const pg8::Seg& u, int wr, int wc, int fr, int fq, int tid) const {
        constexpr int k = KK;
        GAS unsigned char* sbase = (GAS unsigned char*)stash + (size_t)tid * 16; asm volatile("" : "+v"(sbase));
        if constexpr (k < 3) {
            GAS u32x4* st = (GAS u32x4*)(sbase + (size_t)k * 16 * 8192);
#pragma unroll
            for (int ai = 0; ai < 2; ++ai)
#pragma unroll
                for (int bj = 0; bj < 2; ++bj)
#pragma unroll
                    for (int m = 0; m < 4; ++m) { const f32x4 v0 = acc[ai][bj][m][0], v1 = acc[ai][bj][m][1]; u32x4 w;
                        w.x = cvt_pk_bf16(sigmoidf_(v0[0]), sigmoidf_(v0[1])); w.y = cvt_pk_bf16(sigmoidf_(v0[2]), sigmoidf_(v0[3]));
                        w.z = cvt_pk_bf16(sigmoidf_(v1[0]), sigmoidf_(v1[1])); w.w = cvt_pk_bf16(sigmoidf_(v1[2]), sigmoidf_(v1[3]));
                        st[((ai * 2 + bj) * 4 + m) * 512] = w; }
        } else if constexpr (k < 5) {
            const GAS u32x4* sa = (const GAS u32x4*)(sbase + (size_t)(k - 3) * 16 * 8192); const GAS u32x4* sb = (const GAS u32x4*)(sbase + (size_t)(k - 2) * 16 * 8192);
#pragma unroll
            for (int ai = 0; ai < 2; ++ai)
#pragma unroll
                for (int bj = 0; bj < 2; ++bj) {
#pragma unroll
                    for (int m = 0; m < 4; ++m) { const int j16 = (ai * 2 + bj) * 4 + m; const u32x4 a = sa[j16 * 512], b = sb[j16 * 512];
                        f32x4& v0 = acc[ai][bj][m][0]; f32x4& v1 = acc[ai][bj][m][1];
                        v0[0] *= bf_lo(a.x) * __builtin_amdgcn_rcpf(bf_lo(b.x)); v0[1] *= bf_hi(a.x) * __builtin_amdgcn_rcpf(bf_hi(b.x));
                        v0[2] *= bf_lo(a.y) * __builtin_amdgcn_rcpf(bf_lo(b.y)); v0[3] *= bf_hi(a.y) * __builtin_amdgcn_rcpf(bf_hi(b.y));
                        v1[0] *= bf_lo(a.z) * __builtin_amdgcn_rcpf(bf_lo(b.z)); v1[1] *= bf_hi(a.z) * __builtin_amdgcn_rcpf(bf_hi(b.z));
                        v1[2] *= bf_lo(a.w) * __builtin_amdgcn_rcpf(bf_lo(b.w)); v1[3] *= bf_hi(a.w) * __builtin_amdgcn_rcpf(bf_hi(b.w));
                        asm volatile("" : "+v"(acc[ai][bj][m][0]), "+v"(acc[ai][bj][m][1]));
                        if (m & 1) asm volatile("" ::: "memory"); } }
        } else {
            const GAS u32x4* sa = (const GAS u32x4*)(sbase + (size_t)2 * 16 * 8192);
            const int row0 = u.pm * 256 + wr * 64 + fr, col0 = u.pn * 256 + wc * 32 + 8 * fq;
#pragma unroll
            for (int ai = 0; ai < 2; ++ai)
#pragma unroll
                for (int m = 0; m < 4; ++m) { bf16_t* rowp = O + (size_t)(row0 + ai * 128 + m * 16) * D + col0;
#pragma unroll
                    for (int bj = 0; bj < 2; ++bj) { const int j16 = (ai * 2 + bj) * 4 + m; const u32x4 a = sa[j16 * 512]; const f32x4 v0 = acc[ai][bj][m][0], v1 = acc[ai][bj][m][1];
                        u32x4 w; w.x = cvt_pk_bf16(v0[0] * bf_lo(a.x), v0[1] * bf_hi(a.x)); w.y = cvt_pk_bf16(v0[2] * bf_lo(a.y), v0[3] * bf_hi(a.y));
                        w.z = cvt_pk_bf16(v1[0] * bf_lo(a.z), v1[1] * bf_hi(a.z)); w.w = cvt_pk_bf16(v1[2] * bf_lo(a.w), v1[3] * bf_hi(a.w));
                        *(u32x4*)(rowp + bj * 128) = w; } }
        }
    }
};
struct EpiResid {
    static constexpr bool PERM = false;
    const float *xp, *xs; float* out; float* rowss;
    template <int KK> static constexpr bool zero_after() { return true; }
    template <int KK> __device__ __forceinline__ void run(f32x4 (&acc)[2][2][4][2], const pg8::Seg& u, int wr, int wc, int fr, int fq, int) const {
        const int row0 = u.pm * 256 + wr * 64 + fr, col0 = u.pn * 256 + wc * 32 + 4 * fq;
#pragma unroll
        for (int ai = 0; ai < 2; ++ai)
#pragma unroll
            for (int m = 0; m < 4; ++m) { const int r = row0 + ai * 128 + m * 16;
                const float* xr = (r < TP ? xp + (size_t)r * D : xs + (size_t)(r - TP) * D) + col0; float* orow = out + (size_t)r * D + col0; float ss = 0.f;
#pragma unroll
                for (int bj = 0; bj < 2; ++bj)
#pragma unroll
                    for (int n = 0; n < 2; ++n) { const f32x4 xv = *(const f32x4*)(xr + bj * 128 + n * 16); const f32x4 y = xv + acc[ai][bj][m][n];
                        ss += (y[0] * y[0] + y[1] * y[1]) + (y[2] * y[2] + y[3] * y[3]); *(f32x4*)(orow + bj * 128 + n * 16) = y; }
                ss += __shfl_xor(ss, 16); ss += __shfl_xor(ss, 32);
                if (fq == 0) rowss[(size_t)r * 16 + u.pn * 4 + wc] = ss;
                asm volatile("" ::: "memory"); }
    }
};

__device__ __forceinline__ void p0_transpose_item(const float* W, int K, int N, bf16_t* WT, LAS float* scr, int item, int lane) {
    const int nblk = N / 32, kb = item / nblk, nb = item % nblk, k0 = 64 * kb, n0 = 32 * nb;
#pragma unroll 8
    for (int i = 0; i < 32; ++i) { const int kk = 2 * i + (lane >> 5); scr[kk * 33 + (lane & 31)] = W[(size_t)(k0 + kk) * N + n0 + (lane & 31)]; }
    asm volatile("s_waitcnt lgkmcnt(0)" ::: "memory");
    const int c = lane & 7;
#pragma unroll
    for (int j = 0; j < 4; ++j) { const int n = (lane >> 3) + 8 * j; const LAS float* s = scr + (8 * c) * 33 + n;
        u32x4 o; o.x = cvt_pk_bf16(s[0 * 33], s[1 * 33]); o.y = cvt_pk_bf16(s[2 * 33], s[3 * 33]); o.z = cvt_pk_bf16(s[4 * 33], s[5 * 33]); o.w = cvt_pk_bf16(s[6 * 33], s[7 * 33]);
        *(u32x4*)(WT + (size_t)(n0 + n) * K + k0 + 8 * c) = o; }
    asm volatile("s_waitcnt lgkmcnt(0)" ::: "memory");
}
__device__ __forceinline__ void rms_row_to_bf16(const float* xrow, const float* g, bf16_t* orow, int lane) {
    const f32x4* xr = (const f32x4*)xrow + lane; const f32x4* gr = (const f32x4*)g + lane;
    f32x4 v[4]; float s = 0.f;
#pragma unroll
    for (int j = 0; j < 4; ++j) { v[j] = xr[64 * j]; s += (v[j][0] * v[j][0] + v[j][1] * v[j][1]) + (v[j][2] * v[j][2] + v[j][3] * v[j][3]); }
    const float rstd = 1.0f / sqrtf(wave_sum(s) * (1.0f / D) + EPS);
    u32x2* o8 = (u32x2*)orow + lane;
#pragma unroll
    for (int j = 0; j < 4; ++j) { const f32x4 gv = gr[64 * j]; u32x2 w; w.x = cvt_pk_bf16(v[j][0] * rstd * gv[0], v[j][1] * rstd * gv[1]); w.y = cvt_pk_bf16(v[j][2] * rstd * gv[2], v[j][3] * rstd * gv[3]); o8[64 * j] = w; }
}
__device__ __forceinline__ unsigned short f2bf(float f) { return (unsigned short)(cvt_pk_bf16(f, 0.f) & 0xffffu); }
__device__ __forceinline__ float cosrev(float x) { return __builtin_amdgcn_cosf(x); }
__device__ __forceinline__ float sinrev(float x) { return __builtin_amdgcn_sinf(x); }

__device__ __forceinline__ unsigned kv_off(int key, int chunk) { return (unsigned)(key * 128 + ((chunk ^ (key & 7)) << 4)); }
template <bool NA>
__device__ __forceinline__ void attn16(LAS unsigned char* Kimg, LAS unsigned char* Vimg, const LAS float* rpbs, int kbase, int kstride, const bf16_t* qrow  ,
                                       bf16_t* gate_out  , int fr, int fq, int lane,
                                       int qcol, int c0, int drbase  ) {
    bf16x8 qf[2];
#pragma unroll
    for (int ks = 0; ks < 2; ++ks) qf[ks] = *(const bf16x8*)(qrow + 32 * ks + 8 * fq);
    f32x4 sacc[16];
#pragma unroll
    for (int kb = 0; kb < 16; ++kb) {
        const int key = kbase + (kb >> 1) * kstride + (kb & 1) * 16 + fr;
        f32x4 a = (f32x4){0.f, 0.f, 0.f, 0.f};
#pragma unroll
        for (int ks = 0; ks < 2; ++ks) { const bf16x8 kf = *(const LAS bf16x8*)(Kimg + kv_off(key, 4 * ks + fq)); a = mfma16(kf, qf[ks], a); }
        sacc[kb] = a;
    }
    const float L2E = 1.4426950408889634f * 0.125f;
    float mx = -3.0e38f;
    const int cs = NA ? min(max(qcol - 8, 0), 48) : 0;
#pragma unroll
    for (int kb = 0; kb < 16; ++kb)
#pragma unroll
        for (int i = 0; i < 4; ++i) {
            float s = sacc[kb][i] * L2E;
            if (NA) { const int keycol = c0 + 16 * (kb & 1) + 4 * fq + i; const int rel = keycol - cs; const int dc = min(max(keycol - qcol + 15, 0), 30);
                s += rpbs[(drbase + (kb >> 1)) * 31 + dc] * 1.4426950408889634f;
                s = (rel >= 0 && rel < 16) ? s : -3.0e38f; }
            sacc[kb][i] = s; mx = fmaxf(mx, s);
        }
    mx = fmaxf(mx, __shfl_xor(mx, 16)); mx = fmaxf(mx, __shfl_xor(mx, 32));
    float sum = 0.f;
#pragma unroll
    for (int kb = 0; kb < 16; ++kb)
#pragma unroll
        for (int i = 0; i < 4; ++i) { const float p = __builtin_amdgcn_exp2f(sacc[kb][i] - mx); sacc[kb][i] = p; sum += p; }
    sum += __shfl_xor(sum, 16); sum += __shfl_xor(sum, 32);
    const float inv = 1.0f / sum;
    bf16x8 pf[8];
#pragma unroll
    for (int s = 0; s < 8; ++s) pf[s] = pack8(sacc[2 * s], sacc[2 * s + 1]);
    const int q4 = (lane & 15) >> 2, p4 = lane & 3;
    f32x4 oacc[4];
#pragma unroll
    for (int db = 0; db < 4; ++db) oacc[db] = (f32x4){0.f, 0.f, 0.f, 0.f};
#pragma unroll
    for (int s = 0; s < 8; ++s) {
        const int key0 = kbase + s * kstride + 4 * fq + q4, key1 = key0 + 16;
#pragma unroll
        for (int db = 0; db < 4; ++db) {
            const s16x4 v0 = tr_read(Vimg + kv_off(key0, 2 * db + (p4 >> 1)) + 8 * (p4 & 1));
            const s16x4 v1 = tr_read(Vimg + kv_off(key1, 2 * db + (p4 >> 1)) + 8 * (p4 & 1));
            oacc[db] = mfma16(cat4(v0, v1), pf[s], oacc[db]);
        }
    }
#pragma unroll
    for (int db = 0; db < 4; ++db) { u32x2* gp = (u32x2*)(gate_out + 16 * db + 4 * fq); const u32x2 gv = *gp; u32x2 w;
        w.x = cvt_pk_bf16(oacc[db][0] * inv * siluf_(bf_lo(gv.x)), oacc[db][1] * inv * siluf_(bf_hi(gv.x)));
        w.y = cvt_pk_bf16(oacc[db][2] * inv * siluf_(bf_lo(gv.y)), oacc[db][3] * inv * siluf_(bf_hi(gv.y)));
        *gp = w; }
}

__global__ void __launch_bounds__(NTHREADS) mk_fwd(Args a) {
    extern __shared__ __attribute__((aligned(16))) unsigned char lds_raw[];
    LAS unsigned char* lds = (LAS unsigned char*)lds_raw;
    cg::grid_group grid = cg::this_grid();
    const int tid = threadIdx.x, lane = tid & 63, wid = __builtin_amdgcn_readfirstlane(tid >> 6), fr = lane & 15, fq = lane >> 4;
    const int G = gridDim.x, blk = blockIdx.x;
    unsigned char* ws = a.ws; unsigned char* ob = (unsigned char*)a.out;
    bf16_t* z1 = (bf16_t*)(ws + WS_Z1); bf16_t* merged = (bf16_t*)(ws + WS_MERGED);
    bf16_t* WinT = (bf16_t*)(ws + WS_WIN); bf16_t* WkvT = (bf16_t*)(ws + WS_WKV); bf16_t* WfoT = (bf16_t*)(ws + WS_WFO); bf16_t* WnaT = (bf16_t*)(ws + WS_WNA);
    bf16_t* WcaT = (bf16_t*)(ws + WS_WCA); bf16_t* WoutT = (bf16_t*)(ws + WS_WOUT); bf16_t* kvmem = (bf16_t*)(ws + WS_KVMEM); bf16_t* memn = (bf16_t*)(ws + WS_MEMN);
    float* rowss = (float*)(ws + WS_ROWSS);
    bf16_t* tab64 = (bf16_t*)(ws + WS_TAB64); bf16_t* tab128 = (bf16_t*)(ws + WS_TAB128); bf16_t* tabC = (bf16_t*)(ws + WS_TABC);
    bf16_t* hb = (bf16_t*)(ob + OUT_HB); bf16_t* T2 = (bf16_t*)(ob + OUT_T2);
    const int lo = a.ph_lo, hi = a.ph_hi;
#ifndef SKIPMASK
#define SKIPMASK 0
#endif
#define IN(k) (!((SKIPMASK >> (k)) & 1) && lo <= (k) && (k) < hi)
#define SEAM(k) do { if (IN(k) && IN((k) + 1)) grid.sync(); } while (0)

    if (IN(0)) {
        LAS float* scr = (LAS float*)(lds + wid * 16384);
        const int gw = blk * 8 + wid, NGW = G * 8;
        constexpr int I_IN = 16 * (NIN / 32), I_KV = 16 * 16, I_FO = 6 * 32, I_NA = 6 * 32, I_CA = 4 * 32, I_OUT = 16 * 32;
        constexpr int NITEMS = I_IN + I_KV + I_FO + I_NA + I_CA + I_OUT;
        for (int it = gw; it < NITEMS; it += NGW) {
            int r = it;
            if (r < I_IN) { p0_transpose_item(a.w_in, D, NIN, WinT, scr, r, lane); continue; } r -= I_IN;
            if (r < I_KV) { p0_transpose_item(a.w_kv, D, 512, WkvT, scr, r, lane); continue; } r -= I_KV;
            if (r < I_FO) { p0_transpose_item(a.w_fo, 384, D, WfoT, scr, r, lane); continue; } r -= I_FO;
            if (r < I_NA) { p0_transpose_item(a.w_na, 384, D, WnaT, scr, r, lane); continue; } r -= I_NA;
            if (r < I_CA) { p0_transpose_item(a.w_ca, 256, D, WcaT, scr, r, lane); continue; } r -= I_CA;
            p0_transpose_item(a.w_out, D, D, WoutT, scr, r, lane);
        }
        for (int m = gw; m < T; m += NGW) rms_row_to_bf16(m < TP ? a.xp + (size_t)m * D : a.xs + (size_t)(m - TP) * D, a.g_norm, hb + (size_t)m * D, lane);
        for (int m = gw; m < NMEMROWS; m += NGW) rms_row_to_bf16(m < 2048 ? a.memp + (size_t)m * D : a.mems + (size_t)(m - 2048) * D, a.g_mem, memn + (size_t)m * D, lane);
        const int gt = blk * NTHREADS + tid, NT = G * NTHREADS;
        for (int i = gt; i < 64 * 64; i += NT) { const int k = i >> 6, n = i & 63; const float f = (float)((k * n) & 63) * (1.0f / 64.0f); const float c = cosrev(f), s = sinrev(f);
            tab64[i] = f2bf(c); tab64[4096 + i] = f2bf(-s); tab64[8192 + i] = f2bf(s); }
        for (int i = gt; i < 128 * 128; i += NT) { const int k = i >> 7, n = i & 127; const float f = (float)((k * n) & 127) * (1.0f / 128.0f); const float c = cosrev(f), s = sinrev(f);
            tab128[i] = f2bf(c); tab128[16384 + i] = f2bf(-s); tab128[32768 + i] = f2bf(s); }
        for (int i = gt; i < 96 * 96; i += NT) { const int l = i / 96, kap = i % 96; const int s = kap >> 5, g = (kap & 31) >> 3, j = kap & 7; const int m = 32 * s + 16 * (j >> 2) + 4 * g + (j & 3);
            const float f = (float)((m * l) % 96) * (1.0f / 96.0f); tabC[i] = f2bf(cosrev(f)); tabC[9216 + i] = f2bf(sinrev(f)); }
    }
    SEAM(0);

    if (IN(1)) {
        { PlainStream S; S.so.init(T, NZ, G, blk); S.A = (const char*)hb; S.B = (const char*)WinT; S.lda = D * 2; S.ldb = D * 2; S.nt = 16;
          EpiStoreBf16 E{z1, NZ}; pg8::gemm_stream<1>(lds, S, E); }
        { PlainStream S; S.so.init(NMEMROWS, 512, G, blk); S.A = (const char*)memn; S.B = (const char*)WkvT; S.lda = D * 2; S.ldb = D * 2; S.nt = 16;
          EpiStoreBf16 E{kvmem, 512}; pg8::gemm_stream<1>(lds, S, E); }
    }
    SEAM(1);

    if (IN(2)) {
        {
            LAS unsigned char* Kimg = lds; LAS unsigned char* Vimg = lds + 576 * 128; LAS float* rpbs = (LAS float*)(lds + 2 * 576 * 128);
            constexpr int NITEMS = 6144;
            for (int it = blk; it < NITEMS; it += G) {
                int q, band, h, R;
                if (it < 3072) { h = it % 6; const int t2 = it / 6; band = t2 & 63; q = t2 >> 6; R = 128; }
                else { const int i2 = it - 3072; h = i2 % 6; const int t2 = i2 / 6; band = t2 & 31; q = 8 + (t2 >> 5); R = 64; }
                const int sb = seq_base(q), r0 = 2 * band, rb = min(max(r0 - 4, 0), R - 8);
                __syncthreads();
                for (int c = tid; c < 576 * 8; c += NTHREADS) { const int key = c >> 3, ch = c & 7, lr = key >> 6, col = key & 63; const int row = min(rb + lr, R - 1);
                    const bf16_t* src = z1 + (size_t)(sb + row * 64 + col) * NZ + h * 64 + ch * 8;
                    *(LAS u32x4*)(Kimg + kv_off(key, ch)) = *(const u32x4*)(src + C_K); *(LAS u32x4*)(Vimg + kv_off(key, ch)) = *(const u32x4*)(src + C_V); }
                for (int c = tid; c < 465; c += NTHREADS) rpbs[c] = a.rpb[h * 465 + c];
                __syncthreads();
                const int r = r0 + (wid >> 2), j = wid & 3, rs = min(max(r - 4, 0), R - 8), c0 = min(max(16 * j - 8, 0), 32);
                bf16_t* trow = z1 + (size_t)(sb + r * 64 + 16 * j + fr) * NZ;
                attn16<true>(Kimg, Vimg, rpbs, (rs - rb) * 64 + c0, 64, trow + C_Q + h * 64, trow + C_GNA + h * 64, fr, fq, lane, 16 * j + fr, c0, rs - r + 7);
            }
        }
        {
            LAS unsigned char* Kimg = lds; LAS unsigned char* Vimg = lds + 256 * 128;
            constexpr int NITEMS = 512;
            for (int it = blk; it < NITEMS; it += G) {
                int q, h, ck;
                if (it < 256) { ck = it & 7; h = (it >> 3) & 3; q = it >> 5; } else { const int i2 = it - 256; ck = i2 & 3; h = (i2 >> 2) & 3; q = 8 + (i2 >> 4); }
                const int tok0 = seq_base(q) + ck * 1024;
                __syncthreads();
                for (int c = tid; c < 256 * 8; c += NTHREADS) { const int key = c >> 3, ch = c & 7; const bf16_t* src = kvmem + (size_t)(q * 256 + key) * 512 + h * 64 + ch * 8;
                    *(LAS u32x4*)(Kimg + kv_off(key, ch)) = *(const u32x4*)(src); *(LAS u32x4*)(Vimg + kv_off(key, ch)) = *(const u32x4*)(src + 256); }
                __syncthreads();
                for (int i = 0; i < 8; ++i) { bf16_t* trow = z1 + (size_t)(tok0 + (wid * 8 + i) * 16 + fr) * NZ;
                    attn16<false>(Kimg, Vimg, nullptr, 0, 32, trow + C_QCA + h * 64, trow + C_GCA + h * 64, fr, fq, lane, 0, 0, 0); }
            }
        }
        {
            constexpr int US = 784;
            constexpr int NITEMS = 2048;
            bf16x8 af[8][2];
#pragma unroll
            for (int mb = 0; mb < 8; ++mb)
#pragma unroll
                for (int ks = 0; ks < 2; ++ks) af[mb][ks] = *(const bf16x8*)(tab64 + (mb >> 2) * 4096 + ((mb & 3) * 16 + fr) * 64 + 32 * ks + 8 * fq);
            const int q4 = (lane & 15) >> 2, p4 = lane & 3;
            for (int it = blk; it < NITEMS; it += G) {
                int q, n2, N2, S;
                if (it < 1024) { q = it >> 7; n2 = it & 127; N2 = 128; S = 8192; } else { const int i2 = it - 1024; q = 8 + (i2 >> 6); n2 = i2 & 63; N2 = 64; S = 4096; }
                const int sb = seq_base(q);
                __syncthreads();
                for (int c = tid; c < 64 * 48; c += NTHREADS) { const int n1 = c / 48, ch = c % 48;
                    *(LAS u32x4*)(lds + n1 * US + ch * 16) = *(const u32x4*)(z1 + (size_t)(sb + N2 * n1 + n2) * NZ + C_UF + ch * 8); }
                __syncthreads();
                const float invS = 1.0f / (float)S;
#pragma unroll 1
                for (int cc = 0; cc < 3; ++cc) {
                    const int c = wid * 3 + cc;
                    bf16x8 bfr[2];
#pragma unroll
                    for (int ks = 0; ks < 2; ++ks) { LAS unsigned char* p = lds + (32 * ks + 8 * fq + q4) * US + (16 * c + 4 * p4) * 2; bfr[ks] = cat4(tr_read(p), tr_read(p + 4 * US)); }
                    f32x4 acc[8];
#pragma unroll
                    for (int mb = 0; mb < 8; ++mb) { f32x4 v = (f32x4){0.f, 0.f, 0.f, 0.f}; v = mfma16(af[mb][0], bfr[0], v); v = mfma16(af[mb][1], bfr[1], v); acc[mb] = v; }
                    const int ch = 16 * c + fr, grp = ch / 96, mm = ch - grp * 96;
#pragma unroll
                    for (int mb = 0; mb < 4; ++mb)
#pragma unroll
                        for (int i = 0; i < 4; ++i) { const int k1 = mb * 16 + 4 * fq + i; const float f = (float)((n2 * k1) & (S - 1)) * invS; const float cs = cosrev(f), sn = sinrev(f);
                            const float tr = acc[mb][i], ti = acc[mb + 4][i]; bf16_t* dst = T2 + (size_t)(sb + k1 * N2 + n2) * 768 + grp * 192 + mm;
                            dst[0] = f2bf(tr * cs + ti * sn); dst[96] = f2bf(ti * cs - tr * sn); }
                }
            }
        }
    }
    SEAM(2);

    if (IN(3)) {
        constexpr int TS = 400;
        constexpr int NITEMS = 4096;
        const int q4 = (lane & 15) >> 2, p4 = lane & 3;
        for (int it = blk; it < NITEMS; it += G) {
            const bool big = it < 2048;
            int q, k1, grp, kb2, N2, S; LAS unsigned char* tile;
            if (big) { grp = it & 3; k1 = (it >> 2) & 63; q = it >> 8; N2 = 128; S = 8192; kb2 = wid; tile = lds; }
            else { const int i2 = it - 2048; const int gp = i2 & 1; k1 = (i2 >> 1) & 63; q = 8 + (i2 >> 7); N2 = 64; S = 4096; kb2 = wid & 3; grp = 2 * gp + (wid >> 2); tile = lds + (wid >> 2) * 64 * TS; }
            const int sb = seq_base(q);
            __syncthreads();
            if (big) { for (int c = tid; c < 128 * 24; c += NTHREADS) { const int n2 = c / 24, ch = c % 24;
                    *(LAS u32x4*)(lds + n2 * TS + ch * 16) = *(const u32x4*)(T2 + (size_t)(sb + k1 * 128 + n2) * 768 + grp * 192 + ch * 8); } }
            else { const int gp = (it - 2048) & 1; for (int c = tid; c < 128 * 24; c += NTHREADS) { const int rr = c / 24, ch = c % 24, tt = rr >> 6, n2 = rr & 63;
                    *(LAS u32x4*)(lds + rr * TS + ch * 16) = *(const u32x4*)(T2 + (size_t)(sb + k1 * 64 + n2) * 768 + (2 * gp + tt) * 192 + ch * 8); } }
            __syncthreads();
            const bf16_t* tab = big ? tab128 : tab64; const int tsz = N2 * N2; const int nks = N2 / 32;
            f32x4 zr[6], zi[6];
#pragma unroll
            for (int cb = 0; cb < 6; ++cb) { zr[cb] = (f32x4){0.f, 0.f, 0.f, 0.f}; zi[cb] = (f32x4){0.f, 0.f, 0.f, 0.f}; }
#pragma unroll 1
            for (int ks = 0; ks < nks; ++ks) {
                const bf16_t* tp = tab + (16 * kb2 + fr) * N2 + 32 * ks + 8 * fq;
                const bf16x8 wre = *(const bf16x8*)(tp), wim = *(const bf16x8*)(tp + tsz), wni = *(const bf16x8*)(tp + 2 * tsz);
                LAS unsigned char* rowp = tile + (32 * ks + 8 * fq + q4) * TS + 8 * p4;
#pragma unroll
                for (int cb = 0; cb < 6; ++cb) {
                    const bf16x8 trf = cat4(tr_read(rowp + 32 * cb), tr_read(rowp + 32 * cb + 4 * TS));
                    const bf16x8 tif = cat4(tr_read(rowp + 192 + 32 * cb), tr_read(rowp + 192 + 32 * cb + 4 * TS));
                    zr[cb] = mfma16(trf, wre, zr[cb]); zr[cb] = mfma16(tif, wni, zr[cb]);
                    zi[cb] = mfma16(tif, wre, zi[cb]); zi[cb] = mfma16(trf, wim, zi[cb]);
                }
            }
            bf16x8 zfr[3], zfi[3];
#pragma unroll
            for (int s = 0; s < 3; ++s) { zfr[s] = pack8(zr[2 * s], zr[2 * s + 1]); zfi[s] = pack8(zi[2 * s], zi[2 * s + 1]); }
            const float scale = 1.0f / sqrtf((float)S * 96.0f);
            bf16_t* trow = z1 + (size_t)(sb + k1 + 64 * (16 * kb2 + fr)) * NZ + C_GF + grp * 96 + 4 * fq;
#pragma unroll
            for (int lb = 0; lb < 6; ++lb) {
                f32x4 y = (f32x4){0.f, 0.f, 0.f, 0.f};
#pragma unroll
                for (int s = 0; s < 3; ++s) { const bf16_t* cp = tabC + (16 * lb + fr) * 96 + 32 * s + 8 * fq;
                    y = mfma16(*(const bf16x8*)cp, zfr[s], y); y = mfma16(*(const bf16x8*)(cp + 9216), zfi[s], y); }
                u32x2* gp2 = (u32x2*)(trow + 16 * lb); const u32x2 gv = *gp2; u32x2 w;
                w.x = cvt_pk_bf16(y[0] * scale * siluf_(bf_lo(gv.x)), y[1] * scale * siluf_(bf_hi(gv.x)));
                w.y = cvt_pk_bf16(y[2] * scale * siluf_(bf_lo(gv.y)), y[3] * scale * siluf_(bf_hi(gv.y)));
                *gp2 = w;
            }
        }
    }
    SEAM(3);

    if (IN(4)) {
        MergeStream S; S.so.init(T, D, G, blk); S.hb = (const char*)hb; S.z1 = (const char*)z1; S.win = (const char*)WinT; S.wfo = (const char*)WfoT; S.wna = (const char*)WnaT; S.wca = (const char*)WcaT;
        EpiMerge E{ob + OUT_T2 + (size_t)blk * (3 * 16 * 8192), merged};
        pg8::gemm_stream<6>(lds, S, E);
    }
    SEAM(4);

    if (IN(5)) {
        PlainStream S; S.so.init(T, D, G, blk); S.A = (const char*)merged; S.B = (const char*)WoutT; S.lda = D * 2; S.ldb = D * 2; S.nt = 16;
        EpiResid E{a.xp, a.xs, a.out, rowss};
        pg8::gemm_stream<1>(lds, S, E);
    }
    SEAM(5);

    if (IN(6)) {
        const int gw = blk * 8 + wid, NGW = G * 8;
        for (int m = gw; m < T; m += NGW) {
            float s = lane < 16 ? rowss[(size_t)m * 16 + lane] : 0.f;
            s = wave_sum(s);
            const float rstd = 1.0f / sqrtf(s * (1.0f / D) + EPS);
            f32x4* yr = (f32x4*)(a.out + (size_t)m * D) + lane; const f32x4* gr = (const f32x4*)a.g_final + lane;
#pragma unroll
            for (int j = 0; j < 4; ++j) { const f32x4 v = yr[64 * j], gv = gr[64 * j]; yr[64 * j] = v * rstd * gv; }
        }
    }
}

extern "C" void kernel_launch(void* const* d_in, const int* in_sizes, int n_in, void* d_out, int out_size, void* d_ws, size_t ws_size, hipStream_t stream) {
    static int grid = 0;
    if (grid == 0) {
        if (n_in != 14 || out_size != T * D || ws_size < WS_END) { fprintf(stderr, "kernel_launch: unexpected sizes (n_in %d out %d ws %zu, need ws >= %zu)\n", n_in, out_size, ws_size, (size_t)WS_END); grid = -1; return; }
        int dev = 0, cus = 0, per_cu = 0;
        if (hipGetDevice(&dev) != hipSuccess || hipDeviceGetAttribute(&cus, hipDeviceAttributeMultiprocessorCount, dev) != hipSuccess) { grid = -1; return; }
        if (hipFuncSetAttribute((const void*)mk_fwd, hipFuncAttributeMaxDynamicSharedMemorySize, LDS_BYTES) != hipSuccess) { fprintf(stderr, "kernel_launch: hipFuncSetAttribute failed\n"); grid = -1; return; }
        if (hipOccupancyMaxActiveBlocksPerMultiprocessor(&per_cu, (const void*)mk_fwd, NTHREADS, LDS_BYTES) != hipSuccess || per_cu < 1) { fprintf(stderr, "kernel_launch: occupancy query says %d blocks per CU\n", per_cu); grid = -1; return; }
        grid = cus;
    }
    if (grid < 0) return;
    Args a{};
    a.xp = (const float*)d_in[0]; a.xs = (const float*)d_in[1]; a.memp = (const float*)d_in[2]; a.mems = (const float*)d_in[3]; a.g_norm = (const float*)d_in[4];
    a.w_in = (const float*)d_in[5]; a.rpb = (const float*)d_in[6]; a.g_mem = (const float*)d_in[7]; a.w_kv = (const float*)d_in[8]; a.w_fo = (const float*)d_in[9];
    a.w_na = (const float*)d_in[10]; a.w_ca = (const float*)d_in[11]; a.w_out = (const float*)d_in[12]; a.g_final = (const float*)d_in[13];
    a.out = (float*)d_out; a.ws = (unsigned char*)d_ws;
#if MK_N_LAUNCHES == 1
    a.ph_lo = 0; a.ph_hi = NPHASES;
    { void* args[] = {&a}; hipError_t e = hipLaunchCooperativeKernel((const void*)mk_fwd, dim3(grid), dim3(NTHREADS), args, LDS_BYTES, stream);
      if (e != hipSuccess) fprintf(stderr, "kernel_launch: cooperative launch failed: %s\n", hipGetErrorString(e)); }
#else
    for (int p = 0; p < NPHASES; ++p) { a.ph_lo = p; a.ph_hi = p + 1; void* args[] = {&a};
        hipError_t e = hipLaunchCooperativeKernel((const void*)mk_fwd, dim3(grid), dim3(NTHREADS), args, LDS_BYTES, stream);
        if (e != hipSuccess) { fprintf(stderr, "kernel_launch: launch %d failed: %s\n", p, hipGetErrorString(e)); break; } }
#endif
}
```

```cpp
#include <hip/hip_runtime.h>
#include <hip/hip_cooperative_groups.h>
#include <cstdio>
#include <cstdint>
namespace cg = cooperative_groups;

#ifndef MK_N_LAUNCHES
#define MK_N_LAUNCHES 1
#endif

#define LAS __attribute__((address_space(3)))
#define GAS __attribute__((address_space(1)))
typedef unsigned short bf16_t;
typedef short bf16x8 __attribute__((ext_vector_type(8)));
typedef short s16x4 __attribute__((ext_vector_type(4)));
typedef float f32x4 __attribute__((ext_vector_type(4)));
typedef unsigned u32x4 __attribute__((ext_vector_type(4)));
typedef unsigned u32x2 __attribute__((ext_vector_type(2)));

constexpr int D = 1024, T = 131072, TP = 65536, NZ = 2816, NIN = 5888, NMEMROWS = 6144;
constexpr int C_UF = 0, C_GF = 384, C_Q = 768, C_K = 1152, C_V = 1536, C_GNA = 1920, C_QCA = 2304, C_GCA = 2560;
constexpr float EPS = 1e-6f;
constexpr int NPHASES = 7;
constexpr int LDS_BYTES = 153600;
constexpr int NTHREADS = 512;

constexpr size_t WS_Z1 = 0;
constexpr size_t WS_MERGED = WS_Z1 + (size_t)T * NZ * 2;
constexpr size_t WS_WIN = WS_MERGED + (size_t)T * D * 2;
constexpr size_t WS_WKV = WS_WIN + (size_t)NIN * D * 2;
constexpr size_t WS_WFO = WS_WKV + (size_t)512 * D * 2;
constexpr size_t WS_WNA = WS_WFO + (size_t)D * 384 * 2;
constexpr size_t WS_WCA = WS_WNA + (size_t)D * 384 * 2;
constexpr size_t WS_WOUT = WS_WCA + (size_t)D * 256 * 2;
constexpr size_t WS_KVMEM = WS_WOUT + (size_t)D * D * 2;
constexpr size_t WS_MEMN = WS_KVMEM + (size_t)NMEMROWS * 512 * 2;
constexpr size_t WS_ROWSS = WS_MEMN + (size_t)NMEMROWS * D * 2;
constexpr size_t WS_TAB64 = WS_ROWSS + (size_t)T * 16 * 4;
constexpr size_t WS_TAB128 = WS_TAB64 + 3 * 64 * 64 * 2;
constexpr size_t WS_TABC = WS_TAB128 + 3 * 128 * 128 * 2;
constexpr size_t WS_END = WS_TABC + 2 * 96 * 96 * 2;
constexpr size_t OUT_HB = 0;
constexpr size_t OUT_T2 = (size_t)T * D * 2;
constexpr size_t OUT_END = OUT_T2 + (size_t)T * 768 * 2;
static_assert(OUT_END <= (size_t)T * D * 4, "d_out scratch");

struct Args {
    const float *xp, *xs, *memp, *mems, *g_norm, *w_in, *rpb, *g_mem, *w_kv, *w_fo, *w_na, *w_ca, *w_out, *g_final;
    float* out; unsigned char* ws; int ph_lo, ph_hi;
};

typedef __bf16 bf16v2 __attribute__((ext_vector_type(2)));
typedef float f32x2 __attribute__((ext_vector_type(2)));
__device__ __forceinline__ unsigned cvt_pk_bf16(float lo, float hi) { const f32x2 v = {lo, hi}; return __builtin_bit_cast(unsigned, __builtin_convertvector(v, bf16v2)); }
__device__ __forceinline__ float bf_lo(unsigned w) { return __uint_as_float(w << 16); }
__device__ __forceinline__ float bf_hi(unsigned w) { return __uint_as_float(w & 0xffff0000u); }
__device__ __forceinline__ float wave_sum(float v) {
#pragma unroll
    for (int o = 1; o < 64; o <<= 1) v += __shfl_xor(v, o);
    return v;
}
__device__ __forceinline__ float sigmoidf_(float x) { return __builtin_amdgcn_rcpf(1.0f + __expf(-x)); }
__device__ __forceinline__ float siluf_(float x) { return x * sigmoidf_(x); }
__device__ __forceinline__ int seq_base(int q) { return q < 8 ? q * 8192 : TP + (q - 8) * 4096; }
__device__ __forceinline__ f32x4 mfma16(bf16x8 a, bf16x8 b, f32x4 c) { return __builtin_amdgcn_mfma_f32_16x16x32_bf16(a, b, c, 0, 0, 0); }
__device__ __forceinline__ bf16x8 cat4(s16x4 a, s16x4 b) { return __builtin_shufflevector(a, b, 0, 1, 2, 3, 4, 5, 6, 7); }
__device__ __forceinline__ s16x4 tr_read(LAS unsigned char* p) { return __builtin_amdgcn_ds_read_tr16_b64_v4i16((LAS s16x4*)p); }
__device__ __forceinline__ bf16x8 pack8(f32x4 a, f32x4 b) {
    u32x4 p; p.x = cvt_pk_bf16(a[0], a[1]); p.y = cvt_pk_bf16(a[2], a[3]); p.z = cvt_pk_bf16(b[0], b[1]); p.w = cvt_pk_bf16(b[2], b[3]);
    return __builtin_bit_cast(bf16x8, p);
}

namespace pg8 {
constexpr int BM = 256, BK = 64, HALF = 128, HTB = HALF * BK * 2, STAGE_BYTES = 8 * HTB, NXCD = 8, WGM = 8;
__device__ __forceinline__ int lds_byte(int r, int c) { const int st = (r >> 4) * 2 + (c >> 5), rr = r & 15, cc = c & 31, ob = rr * 64 + cc * 2; return st * 1024 + (ob ^ (((ob >> 9) & 1) << 5)); }
__device__ __forceinline__ void stage_rc(int b, int& R, int& C) { const int st = b / 1024, sb = b % 1024, swz = sb ^ (((sb >> 9) & 1) << 5); R = (st >> 1) * 16 + swz / 64; C = (st & 1) * 32 + (swz % 64) / 2; }
__device__ __forceinline__ int perm32(int rho) { const int n = rho >> 4, i = rho & 15; return 8 * (i >> 2) + 4 * n + (i & 3); }

struct Unit { int pm, pn; };
struct StaticOrder {
    int nM, nN, nwg, G, c, rep;
    __device__ void init(int M, int N, int G_, int c_, int rep_ = 1) { nM = M / BM; nN = N / BM; nwg = nM * nN; G = G_; c = c_; rep = rep_; }
    __device__ bool next(int i, Unit& u) const {
        long L = (long)i * G + c; if (L >= (long)nwg * rep) return false;
        L %= nwg;
        int wgid = (int)L; { const int q = nwg / NXCD, r = nwg % NXCD, xcd = wgid % NXCD, off = wgid / NXCD; wgid = (xcd < r ? xcd * (q + 1) : r * (q + 1) + (xcd - r) * q) + off; }
        const int nig = WGM * nN, gid = wgid / nig, fm = gid * WGM, gsz = (nM - fm) < WGM ? (nM - fm) : WGM;
        u.pm = fm + ((wgid % nig) % gsz); u.pn = (wgid % nig) / gsz; return true;
    }
};
struct Seg { const char* A; const char* B; unsigned lda, ldb; int nt, kind, pm, pn; };

template <int NSEG, class Epi, class Stream>
__device__ __forceinline__ void gemm_stream(LAS unsigned char* lds, const Stream& S, const Epi& E) {
    const int tid = threadIdx.x, wid = __builtin_amdgcn_readfirstlane(tid >> 6), lane = tid & 63, wr = wid >> 2, wc = wid & 3, fr = lane & 15, fq = lane >> 4;
    unsigned Ra0, Rb0, Cc0;
    { int R, C; stage_rc(tid * 16, R, C); Ra0 = (unsigned)R; Rb0 = (unsigned)(Epi::PERM ? ((R & ~31) + perm32(R & 31)) : R); Cc0 = (unsigned)C * 2u; }
    const size_t kstep = (size_t)(BK * 2);
    const unsigned ldsw = (unsigned)wid * 1024u;
    const int aoff = lds_byte(wr * 64 + fr, fq * 8), boff = lds_byte(wc * 32 + fr, fq * 8);
#define PG8_SA(b, h) (((b) * 2 + (h)) * HTB)
#define PG8_SB(b, h) ((4 + (b) * 2 + (h)) * HTB)
#define PG8_STAGE(bufoff, gbase, v0, ld) do { \
        __builtin_amdgcn_global_load_lds((const unsigned*)((const char*)(gbase) + (v0)), (LAS unsigned*)(lds + (bufoff) + ldsw), 16, 0, 0); \
        __builtin_amdgcn_global_load_lds((const unsigned*)((const char*)(gbase) + (size_t)64 * (ld) + (v0)), (LAS unsigned*)(lds + (bufoff) + ldsw + 8192), 16, 0, 0); } while (0)
#define PG8_LDA(dst, b, h) do { _Pragma("unroll") for (int m = 0; m < 4; ++m) _Pragma("unroll") for (int k = 0; k < 2; ++k) dst[m][k] = *(const LAS bf16x8*)(lds + PG8_SA(b, h) + aoff + m * 2048 + k * 1024); } while (0)
#define PG8_LDB(dst, b, h) do { _Pragma("unroll") for (int n = 0; n < 2; ++n) _Pragma("unroll") for (int k = 0; k < 2; ++k) dst[n][k] = *(const LAS bf16x8*)(lds + PG8_SB(b, h) + boff + n * 2048 + k * 1024); } while (0)
#define PG8_MMA(ai, bj, At, Bt) do { __builtin_amdgcn_s_setprio(1); _Pragma("unroll") for (int m = 0; m < 4; ++m) _Pragma("unroll") for (int n = 0; n < 2; ++n) _Pragma("unroll") for (int k = 0; k < 2; ++k) \
        acc[ai][bj][m][n] = __builtin_amdgcn_mfma_f32_16x16x32_bf16(Bt[n][k], At[m][k], acc[ai][bj][m][n], 0, 0, 0); __builtin_amdgcn_s_setprio(0); } while (0)
#define PG8_WAIT_V(n) asm volatile("s_waitcnt vmcnt(" #n ")" ::: "memory")
#define PG8_WAIT_L(n) asm volatile("s_waitcnt lgkmcnt(" #n ")" ::: "memory")
#define PG8_BAR __builtin_amdgcn_s_barrier()
#define PG8_SCHED __builtin_amdgcn_sched_barrier(0)
#define PG8_ZERO() do { _Pragma("unroll") for (int a_ = 0; a_ < 2; ++a_) _Pragma("unroll") for (int b_ = 0; b_ < 2; ++b_) _Pragma("unroll") for (int m_ = 0; m_ < 4; ++m_) _Pragma("unroll") for (int n_ = 0; n_ < 2; ++n_) \
        acc[a_][b_][m_][n_] = (f32x4){0.f, 0.f, 0.f, 0.f}; } while (0)
    Seg cur, nxt; int ui = 0;
    if (!S.template seg<0>(0, cur)) return;
    f32x4 acc[2][2][4][2];
    PG8_ZERO();
    bf16x8 At[4][2], B0[2][2], B1[2][2];
    const char* cA = cur.A; const char* cB = cur.B;
    unsigned vAc0 = Ra0 * cur.lda + Cc0, vBc0 = Rb0 * cur.ldb + Cc0, ldAc = cur.lda, ldBc = cur.ldb;
    size_t hAc = (size_t)HALF * cur.lda, hBc = (size_t)HALF * cur.ldb;
    PG8_STAGE(PG8_SB(0, 0), cB, vBc0, ldBc); PG8_STAGE(PG8_SA(0, 0), cA, vAc0, ldAc); PG8_STAGE(PG8_SB(0, 1), cB + hBc, vBc0, ldBc); PG8_STAGE(PG8_SA(0, 1), cA + hAc, vAc0, ldAc);
    if (wr == 1) PG8_BAR;
    PG8_WAIT_V(4); PG8_BAR;
    PG8_STAGE(PG8_SB(1, 0), cB + kstep, vBc0, ldBc); PG8_STAGE(PG8_SA(1, 0), cA + kstep, vAc0, ldAc); PG8_STAGE(PG8_SB(1, 1), cB + hBc + kstep, vBc0, ldBc);
    PG8_WAIT_V(6); PG8_BAR;
#define PG8_SEG(KK) if constexpr (NSEG > (KK)) { \
        bool has_next; if constexpr ((KK) + 1 < NSEG) { S.template seg<((KK) + 1 < NSEG ? (KK) + 1 : 0)>(ui, nxt); has_next = true; } else has_next = S.template seg<0>(ui + 1, nxt); \
        if (!has_next) nxt = cur;     \
        const char* nA = nxt.A; const char* nB = nxt.B; \
        const unsigned vAn0 = Ra0 * nxt.lda + Cc0, vBn0 = Rb0 * nxt.ldb + Cc0, ldAn = nxt.lda, ldBn = nxt.ldb; \
        const size_t hAn = (size_t)HALF * nxt.lda, hBn = (size_t)HALF * nxt.ldb; \
        const int nt = cur.nt; \
        for (int t = 0; t < nt; t += 2) { \
            const bool last = (t == nt - 2); \
            const char* a1 = cA + (size_t)(t + 1) * kstep; \
            const char* a2 = last ? nA : cA + (size_t)(t + 2) * kstep; const char* b2 = last ? nB : cB + (size_t)(t + 2) * kstep; \
            const char* a3 = a2 + kstep; const char* b3 = b2 + kstep; \
            const unsigned vA0 = last ? vAn0 : vAc0, vB0 = last ? vBn0 : vBc0, lA2 = last ? ldAn : ldAc, lB2 = last ? ldBn : ldBc; \
            const size_t hA2 = last ? hAn : hAc, hB2 = last ? hBn : hBc; \
            PG8_LDB(B0, 0, 0); PG8_SCHED; PG8_LDA(At, 0, 0); PG8_STAGE(PG8_SA(1, 1), a1 + hAc, vAc0, ldAc); \
            PG8_WAIT_L(8); PG8_BAR; PG8_WAIT_L(0); PG8_MMA(0, 0, At, B0); PG8_BAR; PG8_SCHED; \
            PG8_LDB(B1, 0, 1); PG8_STAGE(PG8_SB(0, 0), b2, vB0, lB2); \
            PG8_BAR; PG8_WAIT_L(0); PG8_MMA(0, 1, At, B1); PG8_BAR; \
            PG8_LDA(At, 0, 1); PG8_STAGE(PG8_SA(0, 0), a2, vA0, lA2); \
            PG8_BAR; PG8_WAIT_L(0); PG8_MMA(1, 0, At, B0); PG8_BAR; PG8_SCHED; \
            PG8_STAGE(PG8_SB(0, 1), b2 + hB2, vB0, lB2); \
            PG8_WAIT_V(6); PG8_BAR; PG8_MMA(1, 1, At, B1); PG8_BAR; \
            PG8_LDB(B0, 1, 0); PG8_SCHED; PG8_LDA(At, 1, 0); PG8_STAGE(PG8_SA(0, 1), a2 + hA2, vA0, lA2); \
            PG8_WAIT_L(8); PG8_BAR; PG8_WAIT_L(0); PG8_MMA(0, 0, At, B0); PG8_BAR; PG8_SCHED; \
            PG8_LDB(B1, 1, 1); PG8_STAGE(PG8_SB(1, 0), b3, vB0, lB2); \
            PG8_BAR; PG8_WAIT_L(0); PG8_MMA(0, 1, At, B1); PG8_BAR; \
            PG8_LDA(At, 1, 1); PG8_STAGE(PG8_SA(1, 0), a3, vA0, lA2); \
            PG8_BAR; PG8_WAIT_L(0); PG8_MMA(1, 0, At, B0); PG8_BAR; PG8_SCHED; \
            PG8_STAGE(PG8_SB(1, 1), b3 + hB2, vB0, lB2); \
            PG8_WAIT_V(6); PG8_BAR; PG8_MMA(1, 1, At, B1); PG8_BAR; \
        } \
        E.template run<(KK)>(acc, cur, wr, wc, fr, fq, tid); \
        if (!has_next) break; \
        if constexpr (Epi::template zero_after<(KK)>()) PG8_ZERO(); \
        cur = nxt; cA = nA; cB = nB; vAc0 = vAn0; vBc0 = vBn0; ldAc = ldAn; ldBc = ldBn; hAc = hAn; hBc = hBn; }
    for (;;) {
        PG8_SEG(0) PG8_SEG(1) PG8_SEG(2) PG8_SEG(3) PG8_SEG(4) PG8_SEG(5)
        ++ui;
    }
    PG8_WAIT_V(0);
    if (wr == 0) PG8_BAR;
    PG8_BAR;
#undef PG8_SA
#undef PG8_SB
#undef PG8_STAGE
#undef PG8_LDA
#undef PG8_LDB
#undef PG8_MMA
#undef PG8_WAIT_V
#undef PG8_WAIT_L
#undef PG8_BAR
#undef PG8_SCHED
#undef PG8_ZERO
#undef PG8_SEG
}
}

struct PlainStream {
    pg8::StaticOrder so; const char* A; const char* B; unsigned lda, ldb; int nt;
    template <int KK> __device__ __forceinline__ bool seg(int i, pg8::Seg& s) const { pg8::Unit u; if (!so.next(i, u)) return false;
        s.A = A + (size_t)u.pm * 256 * lda; s.B = B + (size_t)u.pn * 256 * ldb; s.lda = lda; s.ldb = ldb; s.nt = nt; s.kind = 0; s.pm = u.pm; s.pn = u.pn; return true; }
};
struct EpiStoreBf16 {
    static constexpr bool PERM = true;
    bf16_t* O; int ldc;
    template <int KK> static constexpr bool zero_after() { return true; }
    template <int KK> __device__ __forceinline__ void run(f32x4 (&acc)[2][2][4][2], const pg8::Seg& u, int wr, int wc, int fr, int fq, int) const {
        const int row0 = u.pm * 256 + wr * 64 + fr, col0 = u.pn * 256 + wc * 32 + 8 * fq;
#pragma unroll
        for (int ai = 0; ai < 2; ++ai)
#pragma unroll
            for (int m = 0; m < 4; ++m) { bf16_t* rowp = O + (size_t)(row0 + ai * 128 + m * 16) * ldc + col0;
#pragma unroll
                for (int bj = 0; bj < 2; ++bj) { const f32x4 v0 = acc[ai][bj][m][0], v1 = acc[ai][bj][m][1];
                    u32x4 w; w.x = cvt_pk_bf16(v0[0], v0[1]); w.y = cvt_pk_bf16(v0[2], v0[3]); w.z = cvt_pk_bf16(v1[0], v1[1]); w.w = cvt_pk_bf16(v1[2], v1[3]);
                    *(u32x4*)(rowp + bj * 128) = w; } }
    }
};

struct MergeStream {
    pg8::StaticOrder so; const char *hb, *z1, *win, *wfo, *wna, *wca;
    template <int KK> __device__ __forceinline__ bool seg(int ui, pg8::Seg& s) const { pg8::Unit u; constexpr int k = KK; if (!so.next(ui, u)) return false;
        s.kind = k; s.pm = u.pm; s.pn = u.pn;
        if (k < 3) { s.A = hb + (size_t)u.pm * 256 * (D * 2); s.lda = D * 2; s.B = win + (size_t)(NZ + k * D + u.pn * 256) * (D * 2); s.ldb = D * 2; s.nt = 16; }
        else { s.lda = NZ * 2; const char* a = z1 + (size_t)u.pm * 256 * (NZ * 2);
            if (k == 3) { s.A = a + C_GF * 2; s.B = wfo + (size_t)u.pn * 256 * (384 * 2); s.ldb = 384 * 2; s.nt = 6; }
            else if (k == 4) { s.A = a + C_GNA * 2; s.B = wna + (size_t)u.pn * 256 * (384 * 2); s.ldb = 384 * 2; s.nt = 6; }
            else { s.A = a + C_GCA * 2; s.B = wca + (size_t)u.pn * 256 * (256 * 2); s.ldb = 256 * 2; s.nt = 4; } }
        return true; }
};
typedef _Float16 f16v2 __attribute__((ext_vector_type(2)));
__device__ __forceinline__ unsigned pk_h2(float lo, float hi) { const f32x2 v = {lo, hi}; return __builtin_bit_cast(unsigned, __builtin_convertvector(v, f16v2)); }
__device__ __forceinline__ f32x2 un_h2(unsigned w) { return __builtin_convertvector(__builtin_bit_cast(f16v2, w), f32x2); }
struct EpiMerge {
    static constexpr bool PERM = true;
    unsigned char* stash; bf16_t* O;
    template <int KK> static constexpr bool zero_after() { return KK < 3 || KK == 5; }
    template <int KK> __device__ __forceinline__ void run(f32x4 (&acc)[2][2][4][2], const pg8::Seg& u, int wr, int wc, int fr, int fq, int tid) const {
        constexpr int k = KK;
        GAS unsigned char* sbase = (GAS unsigned char*)stash + (size_t)tid * 16; asm volatile("" : "+v"(sbase));
        if constexpr (k == 0) {
            GAS u32x4* st = (GAS u32x4*)(sbase);
#pragma unroll
            for (int j = 0; j < 16; ++j) { const f32x4 v0 = acc[j >> 3][(j >> 2) & 1][j & 3][0], v1 = acc[j >> 3][(j >> 2) & 1][j & 3][1]; u32x4 w;
                w.x = pk_h2(sigmoidf_(v0[0]), sigmoidf_(v0[1])); w.y = pk_h2(sigmoidf_(v0[2]), sigmoidf_(v0[3]));
                w.z = pk_h2(sigmoidf_(v1[0]), sigmoidf_(v1[1])); w.w = pk_h2(sigmoidf_(v1[2]), sigmoidf_(v1[3]));
                st[j * 512] = w; }
        } else if constexpr (k < 3) {
            GAS u32x4* sp = (GAS u32x4*)(sbase + (size_t)(k - 1) * 16 * 8192); GAS u32x4* sc = (GAS u32x4*)(sbase + (size_t)k * 16 * 8192);
#pragma unroll
            for (int hb_ = 0; hb_ < 2; ++hb_) {
            u32x4 p[8];
#pragma unroll
            for (int j = 0; j < 8; ++j) p[j] = sp[(hb_ * 8 + j) * 512];
#pragma unroll
            for (int jj = 0; jj < 8; ++jj) { const int j = hb_ * 8 + jj; const f32x4 v0 = acc[j >> 3][(j >> 2) & 1][j & 3][0], v1 = acc[j >> 3][(j >> 2) & 1][j & 3][1];
                float sg[8]; sg[0] = sigmoidf_(v0[0]); sg[1] = sigmoidf_(v0[1]); sg[2] = sigmoidf_(v0[2]); sg[3] = sigmoidf_(v0[3]); sg[4] = sigmoidf_(v1[0]); sg[5] = sigmoidf_(v1[1]); sg[6] = sigmoidf_(v1[2]); sg[7] = sigmoidf_(v1[3]);
                const f32x2 p0 = un_h2(p[jj].x), p1 = un_h2(p[jj].y), p2 = un_h2(p[jj].z), p3 = un_h2(p[jj].w);
                u32x4 w, r; w.x = pk_h2(sg[0], sg[1]); w.y = pk_h2(sg[2], sg[3]); w.z = pk_h2(sg[4], sg[5]); w.w = pk_h2(sg[6], sg[7]);
                r.x = pk_h2(p0[0] * __builtin_amdgcn_rcpf(sg[0]), p0[1] * __builtin_amdgcn_rcpf(sg[1])); r.y = pk_h2(p1[0] * __builtin_amdgcn_rcpf(sg[2]), p1[1] * __builtin_amdgcn_rcpf(sg[3]));
                r.z = pk_h2(p2[0] * __builtin_amdgcn_rcpf(sg[4]), p2[1] * __builtin_amdgcn_rcpf(sg[5])); r.w = pk_h2(p3[0] * __builtin_amdgcn_rcpf(sg[6]), p3[1] * __builtin_amdgcn_rcpf(sg[7]));
                sp[j * 512] = r; sc[j * 512] = w; }
            asm volatile("" ::: "memory"); }
        } else if constexpr (k < 5) {
            const GAS u32x4* sa = (const GAS u32x4*)(sbase + (size_t)(k - 3) * 16 * 8192);
            u32x4 p[16];
#pragma unroll
            for (int j = 0; j < 16; ++j) p[j] = sa[j * 512];
#pragma unroll
            for (int j = 0; j < 16; ++j) { f32x4& v0 = acc[j >> 3][(j >> 2) & 1][j & 3][0]; f32x4& v1 = acc[j >> 3][(j >> 2) & 1][j & 3][1];
                const f32x2 p0 = un_h2(p[j].x), p1 = un_h2(p[j].y), p2 = un_h2(p[j].z), p3 = un_h2(p[j].w);
                v0[0] *= p0[0]; v0[1] *= p0[1]; v0[2] *= p1[0]; v0[3] *= p1[1]; v1[0] *= p2[0]; v1[1] *= p2[1]; v1[2] *= p3[0]; v1[3] *= p3[1];
                asm volatile("" : "+v"(v0), "+v"(v1)); }
        } else {
            const GAS u32x4* sa = (const GAS u32x4*)(sbase + (size_t)2 * 16 * 8192);
            const int row0 = u.pm * 256 + wr * 64 + fr, col0 = u.pn * 256 + wc * 32 + 8 * fq;
            u32x4 p[16];
#pragma unroll
            for (int j = 0; j < 16; ++j) p[j] = sa[j * 512];
#pragma unroll
            for (int ai = 0; ai < 2; ++ai)
#pragma unroll
                for (int m = 0; m < 4; ++m) { bf16_t* rowp = O + (size_t)(row0 + ai * 128 + m * 16) * D + col0;
#pragma unroll
                    for (int bj = 0; bj < 2; ++bj) { const int j16 = (ai * 2 + bj) * 4 + m; const f32x4 v0 = acc[ai][bj][m][0], v1 = acc[ai][bj][m][1];
                        const f32x2 p0 = un_h2(p[j16].x), p1 = un_h2(p[j16].y), p2 = un_h2(p[j16].z), p3 = un_h2(p[j16].w);
                        u32x4 w; w.x = cvt_pk_bf16(v0[0] * p0[0], v0[1] * p0[1]); w.y = cvt_pk_bf16(v0[2] * p1[0], v0[3] * p1[1]);
                        w.z = cvt_pk_bf16(v1[0] * p2[0], v1[1] * p2[1]); w.w = cvt_pk_bf16(v1[2] * p3[0], v1[3] * p3[1]);
                        *(u32x4*)(rowp + bj * 128) = w; } }
        }
    }
};
struct EpiResid {
    static constexpr bool PERM = false;
    const float *xp, *xs; float* out; float* rowss;
    template <int KK> static constexpr bool zero_after() { return true; }
    template <int KK> __device__ __forceinline__ void run(f32x4 (&acc)[2][2][4][2], const pg8::Seg& u, int wr, int wc, int fr, int fq, int) const {
        const int row0 = u.pm * 256 + wr * 64 + fr, col0 = u.pn * 256 + wc * 32 + 4 * fq;
#pragma unroll
        for (int ai = 0; ai < 2; ++ai) {
            f32x4 xv[4][4];
#pragma unroll
            for (int m = 0; m < 4; ++m) { const int r = row0 + ai * 128 + m * 16; const float* xr = (r < TP ? xp + (size_t)r * D : xs + (size_t)(r - TP) * D) + col0;
#pragma unroll
                for (int bj = 0; bj < 2; ++bj)
#pragma unroll
                    for (int n = 0; n < 2; ++n) xv[m][bj * 2 + n] = *(const f32x4*)(xr + bj * 128 + n * 16); }
#pragma unroll
            for (int m = 0; m < 4; ++m) { const int r = row0 + ai * 128 + m * 16; float* orow = out + (size_t)r * D + col0; float ss = 0.f;
#pragma unroll
                for (int bj = 0; bj < 2; ++bj)
#pragma unroll
                    for (int n = 0; n < 2; ++n) { const f32x4 y = xv[m][bj * 2 + n] + acc[ai][bj][m][n];
                        ss += (y[0] * y[0] + y[1] * y[1]) + (y[2] * y[2] + y[3] * y[3]); *(f32x4*)(orow + bj * 128 + n * 16) = y; }
                ss += __shfl_xor(ss, 16); ss += __shfl_xor(ss, 32);
                if (fq == 0) rowss[(size_t)r * 16 + u.pn * 4 + wc] = ss; }
            asm volatile("" ::: "memory"); }
    }
};

__device__ __forceinline__ void p0_transpose_item(const float* W, int K, int N, bf16_t* WT, LAS float* scr, int item, int lane) {
    const int nblk = N / 32, kb = item / nblk, nb = item % nblk, k0 = 64 * kb, n0 = 32 * nb;
#pragma unroll 8
    for (int i = 0; i < 32; ++i) { const int kk = 2 * i + (lane >> 5); scr[kk * 33 + (lane & 31)] = W[(size_t)(k0 + kk) * N + n0 + (lane & 31)]; }
    asm volatile("s_waitcnt lgkmcnt(0)" ::: "memory");
    const int c = lane & 7;
#pragma unroll
    for (int j = 0; j < 4; ++j) { const int n = (lane >> 3) + 8 * j; const LAS float* s = scr + (8 * c) * 33 + n;
        u32x4 o; o.x = cvt_pk_bf16(s[0 * 33], s[1 * 33]); o.y = cvt_pk_bf16(s[2 * 33], s[3 * 33]); o.z = cvt_pk_bf16(s[4 * 33], s[5 * 33]); o.w = cvt_pk_bf16(s[6 * 33], s[7 * 33]);
        *(u32x4*)(WT + (size_t)(n0 + n) * K + k0 + 8 * c) = o; }
    asm volatile("s_waitcnt lgkmcnt(0)" ::: "memory");
}
__device__ __forceinline__ void rms_row_to_bf16(const float* xrow, const float* g, bf16_t* orow, int lane) {
    const f32x4* xr = (const f32x4*)xrow + lane; const f32x4* gr = (const f32x4*)g + lane;
    f32x4 v[4]; float s = 0.f;
#pragma unroll
    for (int j = 0; j < 4; ++j) { v[j] = xr[64 * j]; s += (v[j][0] * v[j][0] + v[j][1] * v[j][1]) + (v[j][2] * v[j][2] + v[j][3] * v[j][3]); }
    const float rstd = 1.0f / sqrtf(wave_sum(s) * (1.0f / D) + EPS);
    u32x2* o8 = (u32x2*)orow + lane;
#pragma unroll
    for (int j = 0; j < 4; ++j) { const f32x4 gv = gr[64 * j]; u32x2 w; w.x = cvt_pk_bf16(v[j][0] * rstd * gv[0], v[j][1] * rstd * gv[1]); w.y = cvt_pk_bf16(v[j][2] * rstd * gv[2], v[j][3] * rstd * gv[3]); o8[64 * j] = w; }
}
__device__ __forceinline__ unsigned short f2bf(float f) { return (unsigned short)(cvt_pk_bf16(f, 0.f) & 0xffffu); }
__device__ __forceinline__ float cosrev(float x) { return __builtin_amdgcn_cosf(x); }
__device__ __forceinline__ float sinrev(float x) { return __builtin_amdgcn_sinf(x); }

__device__ __forceinline__ unsigned kv_off(int key, int chunk) { return (unsigned)(key * 128 + ((chunk ^ (key & 7)) << 4)); }
template <bool NA>
__device__ __forceinline__ void attn16(LAS unsigned char* Kimg, LAS unsigned char* Vimg, const LAS float* rpbs, int kbase, int kstride, const bf16_t* qrow  ,
                                       const bf16_t* gate_in  , bf16_t* gate_out  , int fr, int fq, int lane,
                                       int qcol, int c0, int drbase  ) {
    bf16x8 qf[2];
#pragma unroll
    for (int ks = 0; ks < 2; ++ks) qf[ks] = *(const bf16x8*)(qrow + 32 * ks + 8 * fq);
    f32x4 sacc[16];
#pragma unroll
    for (int kb = 0; kb < 16; ++kb) {
        const int key = kbase + (kb >> 1) * kstride + (kb & 1) * 16 + fr;
        f32x4 a = (f32x4){0.f, 0.f, 0.f, 0.f};
#pragma unroll
        for (int ks = 0; ks < 2; ++ks) { const bf16x8 kf = *(const LAS bf16x8*)(Kimg + kv_off(key, 4 * ks + fq)); a = mfma16(kf, qf[ks], a); }
        sacc[kb] = a;
    }
    const float L2E = 1.4426950408889634f * 0.125f;
    float mx = -3.0e38f;
    const int cs = NA ? min(max(qcol - 8, 0), 48) : 0;
#pragma unroll
    for (int kb = 0; kb < 16; ++kb)
#pragma unroll
        for (int i = 0; i < 4; ++i) {
            float s = sacc[kb][i] * L2E;
            if (NA) { const int keycol = c0 + 16 * (kb & 1) + 4 * fq + i; const int rel = keycol - cs; const int dc = min(max(keycol - qcol + 15, 0), 30);
                s += rpbs[(drbase + (kb >> 1)) * 31 + dc] * 1.4426950408889634f;
                s = (rel >= 0 && rel < 16) ? s : -3.0e38f; }
            sacc[kb][i] = s; mx = fmaxf(mx, s);
        }
    mx = fmaxf(mx, __shfl_xor(mx, 16)); mx = fmaxf(mx, __shfl_xor(mx, 32));
    float sum = 0.f;
#pragma unroll
    for (int kb = 0; kb < 16; ++kb)
#pragma unroll
        for (int i = 0; i < 4; ++i) { const float p = __builtin_amdgcn_exp2f(sacc[kb][i] - mx); sacc[kb][i] = p; sum += p; }
    sum += __shfl_xor(sum, 16); sum += __shfl_xor(sum, 32);
    const float inv = 1.0f / sum;
    bf16x8 pf[8];
#pragma unroll
    for (int s = 0; s < 8; ++s) pf[s] = pack8(sacc[2 * s], sacc[2 * s + 1]);
    const int q4 = (lane & 15) >> 2, p4 = lane & 3;
    f32x4 oacc[4];
#pragma unroll
    for (int db = 0; db < 4; ++db) oacc[db] = (f32x4){0.f, 0.f, 0.f, 0.f};
#pragma unroll
    for (int s = 0; s < 8; ++s) {
        const int key0 = kbase + s * kstride + 4 * fq + q4, key1 = key0 + 16;
#pragma unroll
        for (int db = 0; db < 4; ++db) {
            const s16x4 v0 = tr_read(Vimg + kv_off(key0, 2 * db + (p4 >> 1)) + 8 * (p4 & 1));
            const s16x4 v1 = tr_read(Vimg + kv_off(key1, 2 * db + (p4 >> 1)) + 8 * (p4 & 1));
            oacc[db] = mfma16(cat4(v0, v1), pf[s], oacc[db]);
        }
    }
#pragma unroll
    for (int db = 0; db < 4; ++db) { u32x2* gp = (u32x2*)(gate_out + 16 * db + 4 * fq); const u32x2 gv = *(const u32x2*)(gate_in + 16 * db + 4 * fq); u32x2 w;
        w.x = cvt_pk_bf16(oacc[db][0] * inv * siluf_(bf_lo(gv.x)), oacc[db][1] * inv * siluf_(bf_hi(gv.x)));
        w.y = cvt_pk_bf16(oacc[db][2] * inv * siluf_(bf_lo(gv.y)), oacc[db][3] * inv * siluf_(bf_hi(gv.y)));
        *gp = w; }
}

__global__ void __launch_bounds__(NTHREADS) mk_fwd(Args a) {
    extern __shared__ __attribute__((aligned(16))) unsigned char lds_raw[];
    LAS unsigned char* lds = (LAS unsigned char*)lds_raw;
    cg::grid_group grid = cg::this_grid();
    const int wid = __builtin_amdgcn_readfirstlane((int)threadIdx.x >> 6);
    const int G = gridDim.x, blk = blockIdx.x;
#define PHASE_LANES const int tid = threadIdx.x, lane = tid & 63, fr = lane & 15, fq = lane >> 4; (void)tid; (void)lane; (void)fr; (void)fq
    unsigned char* ws = a.ws; unsigned char* ob = (unsigned char*)a.out;
    bf16_t* z1 = (bf16_t*)(ws + WS_Z1); bf16_t* merged = (bf16_t*)(ws + WS_MERGED);
    bf16_t* WinT = (bf16_t*)(ws + WS_WIN); bf16_t* WkvT = (bf16_t*)(ws + WS_WKV); bf16_t* WfoT = (bf16_t*)(ws + WS_WFO); bf16_t* WnaT = (bf16_t*)(ws + WS_WNA);
    bf16_t* WcaT = (bf16_t*)(ws + WS_WCA); bf16_t* WoutT = (bf16_t*)(ws + WS_WOUT); bf16_t* kvmem = (bf16_t*)(ws + WS_KVMEM); bf16_t* memn = (bf16_t*)(ws + WS_MEMN);
    float* rowss = (float*)(ws + WS_ROWSS);
    bf16_t* tab64 = (bf16_t*)(ws + WS_TAB64); bf16_t* tab128 = (bf16_t*)(ws + WS_TAB128); bf16_t* tabC = (bf16_t*)(ws + WS_TABC);
    bf16_t* hb = (bf16_t*)(ob + OUT_HB); bf16_t* T2 = (bf16_t*)(ob + OUT_T2);
    const int lo = a.ph_lo, hi = a.ph_hi;
#ifndef SKIPMASK
#define SKIPMASK 0
#endif
#define IN(k) (!((SKIPMASK >> (k)) & 1) && lo <= (k) && (k) < hi)
#ifndef REPMASK
#define REPMASK 0
#endif
#define REPS(k) (1 + ((REPMASK >> (k)) & 1))
#define SEAM(k) do { if (IN(k) && IN((k) + 1)) grid.sync(); } while (0)

    if (IN(0)) for (int rep_ = 0; rep_ < REPS(0); ++rep_) {
        PHASE_LANES;
        LAS float* scr = (LAS float*)(lds + wid * 16384);
        const int gw = blk * 8 + wid, NGW = G * 8;
        constexpr int I_IN = 16 * (NIN / 32), I_KV = 16 * 16, I_FO = 6 * 32, I_NA = 6 * 32, I_CA = 4 * 32, I_OUT = 16 * 32;
        constexpr int NITEMS = I_IN + I_KV + I_FO + I_NA + I_CA + I_OUT;
        for (int it = gw; it < NITEMS; it += NGW) {
            int r = it;
            if (r < I_IN) { p0_transpose_item(a.w_in, D, NIN, WinT, scr, r, lane); continue; } r -= I_IN;
            if (r < I_KV) { p0_transpose_item(a.w_kv, D, 512, WkvT, scr, r, lane); continue; } r -= I_KV;
            if (r < I_FO) { p0_transpose_item(a.w_fo, 384, D, WfoT, scr, r, lane); continue; } r -= I_FO;
            if (r < I_NA) { p0_transpose_item(a.w_na, 384, D, WnaT, scr, r, lane); continue; } r -= I_NA;
            if (r < I_CA) { p0_transpose_item(a.w_ca, 256, D, WcaT, scr, r, lane); continue; } r -= I_CA;
            p0_transpose_item(a.w_out, D, D, WoutT, scr, r, lane);
        }
        for (int m = gw; m < T; m += NGW) rms_row_to_bf16(m < TP ? a.xp + (size_t)m * D : a.xs + (size_t)(m - TP) * D, a.g_norm, hb + (size_t)m * D, lane);
        for (int m = gw; m < NMEMROWS; m += NGW) rms_row_to_bf16(m < 2048 ? a.memp + (size_t)m * D : a.mems + (size_t)(m - 2048) * D, a.g_mem, memn + (size_t)m * D, lane);
        const int gt = blk * NTHREADS + tid, NT = G * NTHREADS;
        for (int i = gt; i < 64 * 64; i += NT) { const int k = i >> 6, n = i & 63; const float f = (float)((k * n) & 63) * (1.0f / 64.0f); const float c = cosrev(f), s = sinrev(f);
            tab64[i] = f2bf(c); tab64[4096 + i] = f2bf(-s); tab64[8192 + i] = f2bf(s); }
        for (int i = gt; i < 128 * 128; i += NT) { const int k = i >> 7, n = i & 127; const float f = (float)((k * n) & 127) * (1.0f / 128.0f); const float c = cosrev(f), s = sinrev(f);
            tab128[i] = f2bf(c); tab128[16384 + i] = f2bf(-s); tab128[32768 + i] = f2bf(s); }
        for (int i = gt; i < 96 * 96; i += NT) { const int l = i / 96, kap = i % 96; const int s = kap >> 5, g = (kap & 31) >> 3, j = kap & 7; const int m = 32 * s + 16 * (j >> 2) + 4 * g + (j & 3);
            const float f = (float)((m * l) % 96) * (1.0f / 96.0f); tabC[i] = f2bf(cosrev(f)); tabC[9216 + i] = f2bf(sinrev(f)); }
    }
    SEAM(0);

    if (IN(1)) {
        { PlainStream S; S.so.init(T, NZ, G, blk, REPS(1)); S.A = (const char*)hb; S.B = (const char*)WinT; S.lda = D * 2; S.ldb = D * 2; S.nt = 16;
          EpiStoreBf16 E{z1, NZ}; pg8::gemm_stream<1>(lds, S, E); }
        { PlainStream S; S.so.init(NMEMROWS, 512, G, blk); S.A = (const char*)memn; S.B = (const char*)WkvT; S.lda = D * 2; S.ldb = D * 2; S.nt = 16;
          EpiStoreBf16 E{kvmem, 512}; pg8::gemm_stream<1>(lds, S, E); }
    }
    SEAM(1);

    if (IN(2)) {
        PHASE_LANES;
        {
            LAS unsigned char* Kimg = lds; LAS unsigned char* Vimg = lds + 576 * 128; LAS float* rpbs = (LAS float*)(lds + 2 * 576 * 128);
            constexpr int NITEMS = 6144;
            for (int rep_ = REPS(8) - 1; rep_ >= 0; --rep_)
            for (int it = blk; it < NITEMS; it += G) {
                int q, band, h, R;
                if (it < 3072) { h = it % 6; const int t2 = it / 6; band = t2 & 63; q = t2 >> 6; R = 128; }
                else { const int i2 = it - 3072; h = i2 % 6; const int t2 = i2 / 6; band = t2 & 31; q = 8 + (t2 >> 5); R = 64; }
                const int sb = seq_base(q), r0 = 2 * band, rb = min(max(r0 - 4, 0), R - 8);
                __syncthreads();
                for (int c = tid; c < 576 * 8; c += NTHREADS) { const int key = c >> 3, ch = c & 7, lr = key >> 6, col = key & 63; const int row = min(rb + lr, R - 1);
                    const bf16_t* src = z1 + (size_t)(sb + row * 64 + col) * NZ + h * 64 + ch * 8;
                    *(LAS u32x4*)(Kimg + kv_off(key, ch)) = *(const u32x4*)(src + C_K); *(LAS u32x4*)(Vimg + kv_off(key, ch)) = *(const u32x4*)(src + C_V); }
                for (int c = tid; c < 465; c += NTHREADS) rpbs[c] = a.rpb[h * 465 + c];
                __syncthreads();
                const int r = r0 + (wid >> 2), j = wid & 3, rs = min(max(r - 4, 0), R - 8), c0 = min(max(16 * j - 8, 0), 32);
                bf16_t* trow = z1 + (size_t)(sb + r * 64 + 16 * j + fr) * NZ;
                bf16_t* orow = rep_ ? merged + (size_t)(sb + r * 64 + 16 * j + fr) * D + h * 64 : trow + C_GNA + h * 64;
                attn16<true>(Kimg, Vimg, rpbs, (rs - rb) * 64 + c0, 64, trow + C_Q + h * 64, trow + C_GNA + h * 64, orow, fr, fq, lane, 16 * j + fr, c0, rs - r + 7);
            }
        }
        {
            LAS unsigned char* Kimg = lds; LAS unsigned char* Vimg = lds + 256 * 128;
            constexpr int NITEMS = 512;
            for (int rep_ = REPS(9) - 1; rep_ >= 0; --rep_)
            for (int it = blk; it < NITEMS; it += G) {
                int q, h, ck;
                if (it < 256) { ck = it & 7; h = (it >> 3) & 3; q = it >> 5; } else { const int i2 = it - 256; ck = i2 & 3; h = (i2 >> 2) & 3; q = 8 + (i2 >> 4); }
                const int tok0 = seq_base(q) + ck * 1024;
                __syncthreads();
                for (int c = tid; c < 256 * 8; c += NTHREADS) { const int key = c >> 3, ch = c & 7; const bf16_t* src = kvmem + (size_t)(q * 256 + key) * 512 + h * 64 + ch * 8;
                    *(LAS u32x4*)(Kimg + kv_off(key, ch)) = *(const u32x4*)(src); *(LAS u32x4*)(Vimg + kv_off(key, ch)) = *(const u32x4*)(src + 256); }
                __syncthreads();
                for (int i = 0; i < 8; ++i) { bf16_t* trow = z1 + (size_t)(tok0 + (wid * 8 + i) * 16 + fr) * NZ;
                    bf16_t* orow = rep_ ? merged + (size_t)(tok0 + (wid * 8 + i) * 16 + fr) * D + 512 + h * 64 : trow + C_GCA + h * 64;
                    attn16<false>(Kimg, Vimg, nullptr, 0, 32, trow + C_QCA + h * 64, trow + C_GCA + h * 64, orow, fr, fq, lane, 0, 0, 0); }
            }
        }
        for (int rep_ = 0; rep_ < REPS(7); ++rep_)
        {
            constexpr int US = 784;
            constexpr int NITEMS = 2048;
            bf16x8 af[8][2];
#pragma unroll
            for (int mb = 0; mb < 8; ++mb)
#pragma unroll
                for (int ks = 0; ks < 2; ++ks) af[mb][ks] = *(const bf16x8*)(tab64 + (mb >> 2) * 4096 + ((mb & 3) * 16 + fr) * 64 + 32 * ks + 8 * fq);
            const int q4 = (lane & 15) >> 2, p4 = lane & 3;
            for (int it = blk; it < NITEMS; it += G) {
                int q, n2, N2, S;
                if (it < 1024) { q = it >> 7; n2 = it & 127; N2 = 128; S = 8192; } else { const int i2 = it - 1024; q = 8 + (i2 >> 6); n2 = i2 & 63; N2 = 64; S = 4096; }
                const int sb = seq_base(q);
                __syncthreads();
                for (int c = tid; c < 64 * 48; c += NTHREADS) { const int n1 = c / 48, ch = c % 48;
                    *(LAS u32x4*)(lds + n1 * US + ch * 16) = *(const u32x4*)(z1 + (size_t)(sb + N2 * n1 + n2) * NZ + C_UF + ch * 8); }
                __syncthreads();
                const float invS = 1.0f / (float)S;
#pragma unroll 1
                for (int cc = 0; cc < 3; ++cc) {
                    const int c = wid * 3 + cc;
                    bf16x8 bfr[2];
#pragma unroll
                    for (int ks = 0; ks < 2; ++ks) { LAS unsigned char* p = lds + (32 * ks + 8 * fq + q4) * US + (16 * c + 4 * p4) * 2; bfr[ks] = cat4(tr_read(p), tr_read(p + 4 * US)); }
                    f32x4 acc[8];
#pragma unroll
                    for (int mb = 0; mb < 8; ++mb) { f32x4 v = (f32x4){0.f, 0.f, 0.f, 0.f}; v = mfma16(af[mb][0], bfr[0], v); v = mfma16(af[mb][1], bfr[1], v); acc[mb] = v; }
                    const int ch = 16 * c + fr, grp = ch / 96, mm = ch - grp * 96;
#pragma unroll
                    for (int mb = 0; mb < 4; ++mb)
#pragma unroll
                        for (int i = 0; i < 4; ++i) { const int k1 = mb * 16 + 4 * fq + i; const float f = (float)((n2 * k1) & (S - 1)) * invS; const float cs = cosrev(f), sn = sinrev(f);
                            const float tr = acc[mb][i], ti = acc[mb + 4][i]; bf16_t* dst = T2 + (size_t)(sb + k1 * N2 + n2) * 768 + grp * 192 + mm;
                            dst[0] = f2bf(tr * cs + ti * sn); dst[96] = f2bf(ti * cs - tr * sn); }
                }
            }
        }
    }
    SEAM(2);

    if (IN(3)) {
        PHASE_LANES;
        constexpr int TS = 400;
        constexpr int NITEMS = 4096;
        const int q4 = (lane & 15) >> 2, p4 = lane & 3;
        for (int rep_ = REPS(10) - 1; rep_ >= 0; --rep_)
        for (int it = blk; it < NITEMS; it += G) {
            const bool big = it < 2048;
            int q, k1, grp, kb2, N2, S; LAS unsigned char* tile;
            if (big) { grp = it & 3; k1 = (it >> 2) & 63; q = it >> 8; N2 = 128; S = 8192; kb2 = wid; tile = lds; }
            else { const int i2 = it - 2048; const int gp = i2 & 1; k1 = (i2 >> 1) & 63; q = 8 + (i2 >> 7); N2 = 64; S = 4096; kb2 = wid & 3; grp = 2 * gp + (wid >> 2); tile = lds + (wid >> 2) * 64 * TS; }
            const int sb = seq_base(q);
            __syncthreads();
            if (big) { for (int c = tid; c < 128 * 24; c += NTHREADS) { const int n2 = c / 24, ch = c % 24;
                    *(LAS u32x4*)(lds + n2 * TS + ch * 16) = *(const u32x4*)(T2 + (size_t)(sb + k1 * 128 + n2) * 768 + grp * 192 + ch * 8); } }
            else { const int gp = (it - 2048) & 1; for (int c = tid; c < 128 * 24; c += NTHREADS) { const int rr = c / 24, ch = c % 24, tt = rr >> 6, n2 = rr & 63;
                    *(LAS u32x4*)(lds + rr * TS + ch * 16) = *(const u32x4*)(T2 + (size_t)(sb + k1 * 64 + n2) * 768 + (2 * gp + tt) * 192 + ch * 8); } }
            __syncthreads();
            const bf16_t* tab = big ? tab128 : tab64; const int tsz = N2 * N2; const int nks = N2 / 32;
            f32x4 zr[6], zi[6];
#pragma unroll
            for (int cb = 0; cb < 6; ++cb) { zr[cb] = (f32x4){0.f, 0.f, 0.f, 0.f}; zi[cb] = (f32x4){0.f, 0.f, 0.f, 0.f}; }
#pragma unroll 1
            for (int ks = 0; ks < nks; ++ks) {
                const bf16_t* tp = tab + (16 * kb2 + fr) * N2 + 32 * ks + 8 * fq;
                const bf16x8 wre = *(const bf16x8*)(tp), wim = *(const bf16x8*)(tp + tsz), wni = *(const bf16x8*)(tp + 2 * tsz);
                LAS unsigned char* rowp = tile + (32 * ks + 8 * fq + q4) * TS + 8 * p4;
#pragma unroll
                for (int cb = 0; cb < 6; ++cb) {
                    const bf16x8 trf = cat4(tr_read(rowp + 32 * cb), tr_read(rowp + 32 * cb + 4 * TS));
                    const bf16x8 tif = cat4(tr_read(rowp + 192 + 32 * cb), tr_read(rowp + 192 + 32 * cb + 4 * TS));
                    zr[cb] = mfma16(trf, wre, zr[cb]); zr[cb] = mfma16(tif, wni, zr[cb]);
                    zi[cb] = mfma16(tif, wre, zi[cb]); zi[cb] = mfma16(trf, wim, zi[cb]);
                }
            }
            bf16x8 zfr[3], zfi[3];
#pragma unroll
            for (int s = 0; s < 3; ++s) { zfr[s] = pack8(zr[2 * s], zr[2 * s + 1]); zfi[s] = pack8(zi[2 * s], zi[2 * s + 1]); }
            const float scale = 1.0f / sqrtf((float)S * 96.0f);
            bf16_t* trow = z1 + (size_t)(sb + k1 + 64 * (16 * kb2 + fr)) * NZ + C_GF + grp * 96 + 4 * fq;
#pragma unroll
            for (int lb = 0; lb < 6; ++lb) {
                f32x4 y = (f32x4){0.f, 0.f, 0.f, 0.f};
#pragma unroll
                for (int s = 0; s < 3; ++s) { const bf16_t* cp = tabC + (16 * lb + fr) * 96 + 32 * s + 8 * fq;
                    y = mfma16(*(const bf16x8*)cp, zfr[s], y); y = mfma16(*(const bf16x8*)(cp + 9216), zfi[s], y); }
                u32x2* gp2 = rep_ ? (u32x2*)(merged + (size_t)(sb + k1 + 64 * (16 * kb2 + fr)) * D + grp * 96 + 4 * fq + 16 * lb) : (u32x2*)(trow + 16 * lb); const u32x2 gv = *(const u32x2*)(trow + 16 * lb); u32x2 w;
                w.x = cvt_pk_bf16(y[0] * scale * siluf_(bf_lo(gv.x)), y[1] * scale * siluf_(bf_hi(gv.x)));
                w.y = cvt_pk_bf16(y[2] * scale * siluf_(bf_lo(gv.y)), y[3] * scale * siluf_(bf_hi(gv.y)));
                *gp2 = w;
            }
        }
    }
    SEAM(3);

    if (IN(4)) {
        MergeStream S; S.so.init(T, D, G, blk, REPS(4)); S.hb = (const char*)hb; S.z1 = (const char*)z1; S.win = (const char*)WinT; S.wfo = (const char*)WfoT; S.wna = (const char*)WnaT; S.wca = (const char*)WcaT;
        EpiMerge E{ob + OUT_T2 + (size_t)blk * (3 * 16 * 8192), merged};
        pg8::gemm_stream<6>(lds, S, E);
    }
    SEAM(4);

    if (IN(5)) {
        PlainStream S; S.so.init(T, D, G, blk, REPS(5)); S.A = (const char*)merged; S.B = (const char*)WoutT; S.lda = D * 2; S.ldb = D * 2; S.nt = 16;
        EpiResid E{a.xp, a.xs, a.out, rowss};
        pg8::gemm_stream<1>(lds, S, E);
    }
    SEAM(5);

    if (IN(6)) {
        PHASE_LANES;
        const int gw = blk * 8 + wid, NGW = G * 8;
        for (int m = gw; m < T; m += NGW) {
            float s = lane < 16 ? rowss[(size_t)m * 16 + lane] : 0.f;
            s = wave_sum(s);
            const float rstd = 1.0f / sqrtf(s * (1.0f / D) + EPS);
            f32x4* yr = (f32x4*)(a.out + (size_t)m * D) + lane; const f32x4* gr = (const f32x4*)a.g_final + lane;
#pragma unroll
            for (int j = 0; j < 4; ++j) { const f32x4 v = yr[64 * j], gv = gr[64 * j]; yr[64 * j] = v * rstd * gv; }
        }
    }
}

extern "C" void kernel_launch(void* const* d_in, const int* in_sizes, int n_in, void* d_out, int out_size, void* d_ws, size_t ws_size, hipStream_t stream) {
    static int grid = 0;
    if (grid == 0) {
        if (n_in != 14 || out_size != T * D || ws_size < WS_END) { fprintf(stderr, "kernel_launch: unexpected sizes (n_in %d out %d ws %zu, need ws >= %zu)\n", n_in, out_size, ws_size, (size_t)WS_END); grid = -1; return; }
        int dev = 0, cus = 0, per_cu = 0;
        if (hipGetDevice(&dev) != hipSuccess || hipDeviceGetAttribute(&cus, hipDeviceAttributeMultiprocessorCount, dev) != hipSuccess) { grid = -1; return; }
        if (hipFuncSetAttribute((const void*)mk_fwd, hipFuncAttributeMaxDynamicSharedMemorySize, LDS_BYTES) != hipSuccess) { fprintf(stderr, "kernel_launch: hipFuncSetAttribute failed\n"); grid = -1; return; }
        if (hipOccupancyMaxActiveBlocksPerMultiprocessor(&per_cu, (const void*)mk_fwd, NTHREADS, LDS_BYTES) != hipSuccess || per_cu < 1) { fprintf(stderr, "kernel_launch: occupancy query says %d blocks per CU\n", per_cu); grid = -1; return; }
        grid = cus;
    }
    if (grid < 0) return;
    Args a{};
    a.xp = (const float*)d_in[0]; a.xs = (const float*)d_in[1]; a.memp = (const float*)d_in[2]; a.mems = (const float*)d_in[3]; a.g_norm = (const float*)d_in[4];
    a.w_in = (const float*)d_in[5]; a.rpb = (const float*)d_in[6]; a.g_mem = (const float*)d_in[7]; a.w_kv = (const float*)d_in[8]; a.w_fo = (const float*)d_in[9];
    a.w_na = (const float*)d_in[10]; a.w_ca = (const float*)d_in[11]; a.w_out = (const float*)d_in[12]; a.g_final = (const float*)d_in[13];
    a.out = (float*)d_out; a.ws = (unsigned char*)d_ws;
#if MK_N_LAUNCHES == 1
    a.ph_lo = 0; a.ph_hi = NPHASES;
    { void* args[] = {&a}; hipError_t e = hipLaunchCooperativeKernel((const void*)mk_fwd, dim3(grid), dim3(NTHREADS), args, LDS_BYTES, stream);
      if (e != hipSuccess) fprintf(stderr, "kernel_launch: cooperative launch failed: %s\n", hipGetErrorString(e)); }
#else
    for (int p = 0; p < NPHASES; ++p) { a.ph_lo = p; a.ph_hi = p + 1; void* args[] = {&a};
        hipError_t e = hipLaunchCooperativeKernel((const void*)mk_fwd, dim3(grid), dim3(NTHREADS), args, LDS_BYTES, stream);
        if (e != hipSuccess) { fprintf(stderr, "kernel_launch: launch %d failed: %s\n", p, hipGetErrorString(e)); break; } }
#endif
}
```

```cpp
#include <hip/hip_runtime.h>
#include <hip/hip_cooperative_groups.h>
#include <cstdio>
#include <cstdint>
namespace cg = cooperative_groups;

#ifndef MK_N_LAUNCHES
#define MK_N_LAUNCHES 1
#endif

#define LAS __attribute__((address_space(3)))
#define GAS __attribute__((address_space(1)))
typedef unsigned short bf16_t;
typedef short bf16x8 __attribute__((ext_vector_type(8)));
typedef short s16x4 __attribute__((ext_vector_type(4)));
typedef float f32x4 __attribute__((ext_vector_type(4)));
typedef unsigned u32x4 __attribute__((ext_vector_type(4)));
typedef unsigned u32x2 __attribute__((ext_vector_type(2)));

constexpr int D = 1024, T = 131072, TP = 65536, NZ = 2816, NIN = 5888, NMEMROWS = 6144;
constexpr int C_UF = 0, C_GF = 384, C_Q = 768, C_K = 1152, C_V = 1536, C_GNA = 1920, C_QCA = 2304, C_GCA = 2560;
constexpr float EPS = 1e-6f;
constexpr int NPHASES = 7;
constexpr int LDS_BYTES = 153600;
constexpr int NTHREADS = 512;

constexpr size_t WS_Z1 = 0;
constexpr size_t WS_MERGED = WS_Z1 + (size_t)T * NZ * 2;
constexpr size_t WS_WIN = WS_MERGED + (size_t)T * D * 2;
constexpr size_t WS_WKV = WS_WIN + (size_t)NIN * D * 2;
constexpr size_t WS_WFO = WS_WKV + (size_t)512 * D * 2;
constexpr size_t WS_WNA = WS_WFO + (size_t)D * 384 * 2;
constexpr size_t WS_WCA = WS_WNA + (size_t)D * 384 * 2;
constexpr size_t WS_WOUT = WS_WCA + (size_t)D * 256 * 2;
constexpr size_t WS_KVMEM = WS_WOUT + (size_t)D * D * 2;
constexpr size_t WS_MEMN = WS_KVMEM + (size_t)NMEMROWS * 512 * 2;
constexpr size_t WS_ROWSS = WS_MEMN + (size_t)NMEMROWS * D * 2;
constexpr size_t WS_TAB64 = WS_ROWSS + (size_t)T * 16 * 4;
constexpr size_t WS_TAB128 = WS_TAB64 + 3 * 64 * 64 * 2;
constexpr size_t WS_TABC = WS_TAB128 + 3 * 128 * 128 * 2;
constexpr size_t WS_END = WS_TABC + 2 * 96 * 96 * 2;
constexpr size_t OUT_HB = 0;
constexpr size_t OUT_T2 = (size_t)T * D * 2;
constexpr size_t OUT_END = OUT_T2 + (size_t)T * 768 * 2;
static_assert(OUT_END <= (size_t)T * D * 4, "d_out scratch");

struct Args {
    const float *xp, *xs, *memp, *mems, *g_norm, *w_in, *rpb, *g_mem, *w_kv, *w_fo, *w_na, *w_ca, *w_out, *g_final;
    float* out; unsigned char* ws; int ph_lo, ph_hi;
};

typedef __bf16 bf16v2 __attribute__((ext_vector_type(2)));
typedef float f32x2 __attribute__((ext_vector_type(2)));
__device__ __forceinline__ unsigned cvt_pk_bf16(float lo, float hi) { const f32x2 v = {lo, hi}; return __builtin_bit_cast(unsigned, __builtin_convertvector(v, bf16v2)); }
__device__ __forceinline__ float bf_lo(unsigned w) { return __uint_as_float(w << 16); }
__device__ __forceinline__ float bf_hi(unsigned w) { return __uint_as_float(w & 0xffff0000u); }
__device__ __forceinline__ float wave_sum(float v) {
#pragma unroll
    for (int o = 1; o < 64; o <<= 1) v += __shfl_xor(v, o);
    return v;
}
__device__ __forceinline__ float sigmoidf_(float x) { return __builtin_amdgcn_rcpf(1.0f + __expf(-x)); }
__device__ __forceinline__ float siluf_(float x) { return x * sigmoidf_(x); }
__device__ __forceinline__ int seq_base(int q) { return q < 8 ? q * 8192 : TP + (q - 8) * 4096; }
__device__ __forceinline__ f32x4 mfma16(bf16x8 a, bf16x8 b, f32x4 c) { return __builtin_amdgcn_mfma_f32_16x16x32_bf16(a, b, c, 0, 0, 0); }
__device__ __forceinline__ bf16x8 cat4(s16x4 a, s16x4 b) { return __builtin_shufflevector(a, b, 0, 1, 2, 3, 4, 5, 6, 7); }
__device__ __forceinline__ s16x4 tr_read(LAS unsigned char* p) { return __builtin_amdgcn_ds_read_tr16_b64_v4i16((LAS s16x4*)p); }
__device__ __forceinline__ bf16x8 pack8(f32x4 a, f32x4 b) {
    u32x4 p; p.x = cvt_pk_bf16(a[0], a[1]); p.y = cvt_pk_bf16(a[2], a[3]); p.z = cvt_pk_bf16(b[0], b[1]); p.w = cvt_pk_bf16(b[2], b[3]);
    return __builtin_bit_cast(bf16x8, p);
}

namespace pg8 {
constexpr int BM = 256, BK = 64, HALF = 128, HTB = HALF * BK * 2, STAGE_BYTES = 8 * HTB, NXCD = 8, WGM = 8;
__device__ __forceinline__ int lds_byte(int r, int c) { const int st = (r >> 4) * 2 + (c >> 5), rr = r & 15, cc = c & 31, ob = rr * 64 + cc * 2; return st * 1024 + (ob ^ (((ob >> 9) & 1) << 5)); }
__device__ __forceinline__ void stage_rc(int b, int& R, int& C) { const int st = b / 1024, sb = b % 1024, swz = sb ^ (((sb >> 9) & 1) << 5); R = (st >> 1) * 16 + swz / 64; C = (st & 1) * 32 + (swz % 64) / 2; }
__device__ __forceinline__ int perm32(int rho) { const int n = rho >> 4, i = rho & 15; return 8 * (i >> 2) + 4 * n + (i & 3); }

struct Unit { int pm, pn; };
struct StaticOrder {
    int nM, nN, nwg, G, c, rep;
    __device__ void init(int M, int N, int G_, int c_, int rep_ = 1) { nM = M / BM; nN = N / BM; nwg = nM * nN; G = G_; c = c_; rep = rep_; }
    __device__ bool next(int i, Unit& u) const {
        long L = (long)i * G + c; if (L >= (long)nwg * rep) return false;
        L %= nwg;
        int wgid = (int)L; { const int q = nwg / NXCD, r = nwg % NXCD, xcd = wgid % NXCD, off = wgid / NXCD; wgid = (xcd < r ? xcd * (q + 1) : r * (q + 1) + (xcd - r) * q) + off; }
        const int nig = WGM * nN, gid = wgid / nig, fm = gid * WGM, gsz = (nM - fm) < WGM ? (nM - fm) : WGM;
        u.pm = fm + ((wgid % nig) % gsz); u.pn = (wgid % nig) / gsz; return true;
    }
};
struct Seg { const char* A; const char* B; unsigned lda, ldb; int nt, kind, pm, pn; };

template <int NSEG, class Epi, class Stream>
__device__ __forceinline__ void gemm_stream(LAS unsigned char* lds, const Stream& S, const Epi& E) {
    const int tid = threadIdx.x, wid = __builtin_amdgcn_readfirstlane(tid >> 6), lane = tid & 63, wr = wid >> 2, wc = wid & 3, fr = lane & 15, fq = lane >> 4;
    unsigned Ra0, Rb0, Cc0;
    { int R, C; stage_rc(tid * 16, R, C); Ra0 = (unsigned)R; Rb0 = (unsigned)(Epi::PERM ? ((R & ~31) + perm32(R & 31)) : R); Cc0 = (unsigned)C * 2u; }
    const size_t kstep = (size_t)(BK * 2);
    const unsigned ldsw = (unsigned)wid * 1024u;
    const int aoff = lds_byte(wr * 64 + fr, fq * 8), boff = lds_byte(wc * 32 + fr, fq * 8);
#define PG8_SA(b, h) (((b) * 2 + (h)) * HTB)
#define PG8_SB(b, h) ((4 + (b) * 2 + (h)) * HTB)
#define PG8_STAGE(bufoff, gbase, v0, ld) do { \
        __builtin_amdgcn_global_load_lds((const unsigned*)((const char*)(gbase) + (v0)), (LAS unsigned*)(lds + (bufoff) + ldsw), 16, 0, 0); \
        __builtin_amdgcn_global_load_lds((const unsigned*)((const char*)(gbase) + (size_t)64 * (ld) + (v0)), (LAS unsigned*)(lds + (bufoff) + ldsw + 8192), 16, 0, 0); } while (0)
#define PG8_LDA(dst, b, h) do { _Pragma("unroll") for (int m = 0; m < 4; ++m) _Pragma("unroll") for (int k = 0; k < 2; ++k) dst[m][k] = *(const LAS bf16x8*)(lds + PG8_SA(b, h) + aoff + m * 2048 + k * 1024); } while (0)
#define PG8_LDB(dst, b, h) do { _Pragma("unroll") for (int n = 0; n < 2; ++n) _Pragma("unroll") for (int k = 0; k < 2; ++k) dst[n][k] = *(const LAS bf16x8*)(lds + PG8_SB(b, h) + boff + n * 2048 + k * 1024); } while (0)
#define PG8_MMA(ai, bj, At, Bt) do { __builtin_amdgcn_s_setprio(1); _Pragma("unroll") for (int m = 0; m < 4; ++m) _Pragma("unroll") for (int n = 0; n < 2; ++n) _Pragma("unroll") for (int k = 0; k < 2; ++k) \
        acc[ai][bj][m][n] = __builtin_amdgcn_mfma_f32_16x16x32_bf16(Bt[n][k], At[m][k], acc[ai][bj][m][n], 0, 0, 0); __builtin_amdgcn_s_setprio(0); } while (0)
#define PG8_WAIT_V(n) asm volatile("s_waitcnt vmcnt(" #n ")" ::: "memory")
#define PG8_WAIT_L(n) asm volatile("s_waitcnt lgkmcnt(" #n ")" ::: "memory")
#define PG8_BAR __builtin_amdgcn_s_barrier()
#define PG8_SCHED __builtin_amdgcn_sched_barrier(0)
#define PG8_ZERO() do { _Pragma("unroll") for (int a_ = 0; a_ < 2; ++a_) _Pragma("unroll") for (int b_ = 0; b_ < 2; ++b_) _Pragma("unroll") for (int m_ = 0; m_ < 4; ++m_) _Pragma("unroll") for (int n_ = 0; n_ < 2; ++n_) \
        acc[a_][b_][m_][n_] = (f32x4){0.f, 0.f, 0.f, 0.f}; } while (0)
    Seg cur, nxt; int ui = 0;
    if (!S.template seg<0>(0, cur)) return;
    f32x4 acc[2][2][4][2];
    PG8_ZERO();
    bf16x8 At[4][2], B0[2][2], B1[2][2];
    const char* cA = cur.A; const char* cB = cur.B;
    unsigned vAc0 = Ra0 * cur.lda + Cc0, vBc0 = Rb0 * cur.ldb + Cc0, ldAc = cur.lda, ldBc = cur.ldb;
    size_t hAc = (size_t)HALF * cur.lda, hBc = (size_t)HALF * cur.ldb;
    PG8_STAGE(PG8_SB(0, 0), cB, vBc0, ldBc); PG8_STAGE(PG8_SA(0, 0), cA, vAc0, ldAc); PG8_STAGE(PG8_SB(0, 1), cB + hBc, vBc0, ldBc); PG8_STAGE(PG8_SA(0, 1), cA + hAc, vAc0, ldAc);
    if (wr == 1) PG8_BAR;
    PG8_WAIT_V(4); PG8_BAR;
    PG8_STAGE(PG8_SB(1, 0), cB + kstep, vBc0, ldBc); PG8_STAGE(PG8_SA(1, 0), cA + kstep, vAc0, ldAc); PG8_STAGE(PG8_SB(1, 1), cB + hBc + kstep, vBc0, ldBc);
    PG8_WAIT_V(6); PG8_BAR;
#define PG8_SEG(KK) if constexpr (NSEG > (KK)) { \
        bool has_next; if constexpr ((KK) + 1 < NSEG) { S.template seg<((KK) + 1 < NSEG ? (KK) + 1 : 0)>(ui, nxt); has_next = true; } else has_next = S.template seg<0>(ui + 1, nxt); \
        if (!has_next) nxt = cur;     \
        const char* nA = nxt.A; const char* nB = nxt.B; \
        const unsigned vAn0 = Ra0 * nxt.lda + Cc0, vBn0 = Rb0 * nxt.ldb + Cc0, ldAn = nxt.lda, ldBn = nxt.ldb; \
        const size_t hAn = (size_t)HALF * nxt.lda, hBn = (size_t)HALF * nxt.ldb; \
        const int nt = cur.nt; \
        for (int t = 0; t < nt; t += 2) { \
            const bool last = (t == nt - 2); \
            const char* a1 = cA + (size_t)(t + 1) * kstep; \
            const char* a2 = last ? nA : cA + (size_t)(t + 2) * kstep; const char* b2 = last ? nB : cB + (size_t)(t + 2) * kstep; \
            const char* a3 = a2 + kstep; const char* b3 = b2 + kstep; \
            const unsigned vA0 = last ? vAn0 : vAc0, vB0 = last ? vBn0 : vBc0, lA2 = last ? ldAn : ldAc, lB2 = last ? ldBn : ldBc; \
            const size_t hA2 = last ? hAn : hAc, hB2 = last ? hBn : hBc; \
            PG8_LDB(B0, 0, 0); PG8_SCHED; PG8_LDA(At, 0, 0); PG8_STAGE(PG8_SA(1, 1), a1 + hAc, vAc0, ldAc); \
            PG8_WAIT_L(8); PG8_BAR; PG8_WAIT_L(0); PG8_MMA(0, 0, At, B0); PG8_BAR; PG8_SCHED; \
            PG8_LDB(B1, 0, 1); PG8_STAGE(PG8_SB(0, 0), b2, vB0, lB2); \
            PG8_BAR; PG8_WAIT_L(0); PG8_MMA(0, 1, At, B1); PG8_BAR; \
            PG8_LDA(At, 0, 1); PG8_STAGE(PG8_SA(0, 0), a2, vA0, lA2); \
            PG8_BAR; PG8_WAIT_L(0); PG8_MMA(1, 0, At, B0); PG8_BAR; PG8_SCHED; \
            PG8_STAGE(PG8_SB(0, 1), b2 + hB2, vB0, lB2); \
            PG8_WAIT_V(6); PG8_BAR; PG8_MMA(1, 1, At, B1); PG8_BAR; \
            PG8_LDB(B0, 1, 0); PG8_SCHED; PG8_LDA(At, 1, 0); PG8_STAGE(PG8_SA(0, 1), a2 + hA2, vA0, lA2); \
            PG8_WAIT_L(8); PG8_BAR; PG8_WAIT_L(0); PG8_MMA(0, 0, At, B0); PG8_BAR; PG8_SCHED; \
            PG8_LDB(B1, 1, 1); PG8_STAGE(PG8_SB(1, 0), b3, vB0, lB2); \
            PG8_BAR; PG8_WAIT_L(0); PG8_MMA(0, 1, At, B1); PG8_BAR; \
            PG8_LDA(At, 1, 1); PG8_STAGE(PG8_SA(1, 0), a3, vA0, lA2); \
            PG8_BAR; PG8_WAIT_L(0); PG8_MMA(1, 0, At, B0); PG8_BAR; PG8_SCHED; \
            PG8_STAGE(PG8_SB(1, 1), b3 + hB2, vB0, lB2); \
            PG8_WAIT_V(6); PG8_BAR; PG8_MMA(1, 1, At, B1); PG8_BAR; \
        } \
        E.template run<(KK)>(acc, cur, wr, wc, fr, fq, tid); \
        if (!has_next) break; \
        if constexpr (Epi::template zero_after<(KK)>()) PG8_ZERO(); \
        cur = nxt; cA = nA; cB = nB; vAc0 = vAn0; vBc0 = vBn0; ldAc = ldAn; ldBc = ldBn; hAc = hAn; hBc = hBn; }
    for (;;) {
        PG8_SEG(0) PG8_SEG(1) PG8_SEG(2) PG8_SEG(3) PG8_SEG(4) PG8_SEG(5)
        ++ui;
    }
    PG8_WAIT_V(0);
    if (wr == 0) PG8_BAR;
    PG8_BAR;
#undef PG8_SA
#undef PG8_SB
#undef PG8_STAGE
#undef PG8_LDA
#undef PG8_LDB
#undef PG8_MMA
#undef PG8_WAIT_V
#undef PG8_WAIT_L
#undef PG8_BAR
#undef PG8_SCHED
#undef PG8_ZERO
#undef PG8_SEG
}
}

struct PlainStream {
    pg8::StaticOrder so; const char* A; const char* B; unsigned lda, ldb; int nt;
    template <int KK> __device__ __forceinline__ bool seg(int i, pg8::Seg& s) const { pg8::Unit u; if (!so.next(i, u)) return false;
        s.A = A + (size_t)u.pm * 256 * lda; s.B = B + (size_t)u.pn * 256 * ldb; s.lda = lda; s.ldb = ldb; s.nt = nt; s.kind = 0; s.pm = u.pm; s.pn = u.pn; return true; }
};
struct EpiStoreBf16 {
    static constexpr bool PERM = true;
    bf16_t* O; int ldc;
    template <int KK> static constexpr bool zero_after() { return true; }
    template <int KK> __device__ __forceinline__ void run(f32x4 (&acc)[2][2][4][2], const pg8::Seg& u, int wr, int wc, int fr, int fq, int) const {
        const int row0 = u.pm * 256 + wr * 64 + fr, col0 = u.pn * 256 + wc * 32 + 8 * fq;
#pragma unroll
        for (int ai = 0; ai < 2; ++ai)
#pragma unroll
            for (int m = 0; m < 4; ++m) { bf16_t* rowp = O + (size_t)(row0 + ai * 128 + m * 16) * ldc + col0;
#pragma unroll
                for (int bj = 0; bj < 2; ++bj) { const f32x4 v0 = acc[ai][bj][m][0], v1 = acc[ai][bj][m][1];
                    u32x4 w; w.x = cvt_pk_bf16(v0[0], v0[1]); w.y = cvt_pk_bf16(v0[2], v0[3]); w.z = cvt_pk_bf16(v1[0], v1[1]); w.w = cvt_pk_bf16(v1[2], v1[3]);
                    *(u32x4*)(rowp + bj * 128) = w; } }
    }
};

struct MergeStream {
    pg8::StaticOrder so; const char *hb, *z1, *win, *wfo, *wna, *wca;
    template <int KK> __device__ __forceinline__ bool seg(int ui, pg8::Seg& s) const { pg8::Unit u; constexpr int k = KK; if (!so.next(ui, u)) return false;
        s.kind = k; s.pm = u.pm; s.pn = u.pn;
        if (k < 3) { s.A = hb + (size_t)u.pm * 256 * (D * 2); s.lda = D * 2; s.B = win + (size_t)(NZ + k * D + u.pn * 256) * (D * 2); s.ldb = D * 2; s.nt = 16; }
        else { s.lda = NZ * 2; const char* a = z1 + (size_t)u.pm * 256 * (NZ * 2);
            if (k == 3) { s.A = a + C_GF * 2; s.B = wfo + (size_t)u.pn * 256 * (384 * 2); s.ldb = 384 * 2; s.nt = 6; }
            else if (k == 4) { s.A = a + C_GNA * 2; s.B = wna + (size_t)u.pn * 256 * (384 * 2); s.ldb = 384 * 2; s.nt = 6; }
            else { s.A = a + C_GCA * 2; s.B = wca + (size_t)u.pn * 256 * (256 * 2); s.ldb = 256 * 2; s.nt = 4; } }
        return true; }
};
typedef _Float16 f16v2 __attribute__((ext_vector_type(2)));
__device__ __forceinline__ unsigned pk_h2(float lo, float hi) { const f32x2 v = {lo, hi}; return __builtin_bit_cast(unsigned, __builtin_convertvector(v, f16v2)); }
__device__ __forceinline__ f32x2 un_h2(unsigned w) { return __builtin_convertvector(__builtin_bit_cast(f16v2, w), f32x2); }
struct EpiMerge {
    static constexpr bool PERM = true;
    unsigned char* stash; bf16_t* O;
    template <int KK> static constexpr bool zero_after() { return KK < 3 || KK == 5; }
    template <int KK> __device__ __forceinline__ void run(f32x4 (&acc)[2][2][4][2], const pg8::Seg& u, int wr, int wc, int fr, int fq, int tid) const {
        constexpr int k = KK;
        GAS unsigned char* sbase = (GAS unsigned char*)stash + (size_t)tid * 16; asm volatile("" : "+v"(sbase));
        if constexpr (k == 0) {
            GAS u32x4* st = (GAS u32x4*)(sbase);
#pragma unroll
            for (int j = 0; j < 16; ++j) { const f32x4 v0 = acc[j >> 3][(j >> 2) & 1][j & 3][0], v1 = acc[j >> 3][(j >> 2) & 1][j & 3][1]; u32x4 w;
                w.x = pk_h2(sigmoidf_(v0[0]), sigmoidf_(v0[1])); w.y = pk_h2(sigmoidf_(v0[2]), sigmoidf_(v0[3]));
                w.z = pk_h2(sigmoidf_(v1[0]), sigmoidf_(v1[1])); w.w = pk_h2(sigmoidf_(v1[2]), sigmoidf_(v1[3]));
                st[j * 512] = w; }
        } else if constexpr (k < 3) {
            GAS u32x4* sp = (GAS u32x4*)(sbase + (size_t)(k - 1) * 16 * 8192); GAS u32x4* sc = (GAS u32x4*)(sbase + (size_t)k * 16 * 8192);
#pragma unroll
            for (int hb_ = 0; hb_ < 2; ++hb_) {
            u32x4 p[8];
#pragma unroll
            for (int j = 0; j < 8; ++j) p[j] = sp[(hb_ * 8 + j) * 512];
#pragma unroll
            for (int jj = 0; jj < 8; ++jj) { const int j = hb_ * 8 + jj; const f32x4 v0 = acc[j >> 3][(j >> 2) & 1][j & 3][0], v1 = acc[j >> 3][(j >> 2) & 1][j & 3][1];
                float sg[8]; sg[0] = sigmoidf_(v0[0]); sg[1] = sigmoidf_(v0[1]); sg[2] = sigmoidf_(v0[2]); sg[3] = sigmoidf_(v0[3]); sg[4] = sigmoidf_(v1[0]); sg[5] = sigmoidf_(v1[1]); sg[6] = sigmoidf_(v1[2]); sg[7] = sigmoidf_(v1[3]);
                const f32x2 p0 = un_h2(p[jj].x), p1 = un_h2(p[jj].y), p2 = un_h2(p[jj].z), p3 = un_h2(p[jj].w);
                u32x4 w, r; w.x = pk_h2(sg[0], sg[1]); w.y = pk_h2(sg[2], sg[3]); w.z = pk_h2(sg[4], sg[5]); w.w = pk_h2(sg[6], sg[7]);
                r.x = pk_h2(p0[0] * __builtin_amdgcn_rcpf(sg[0]), p0[1] * __builtin_amdgcn_rcpf(sg[1])); r.y = pk_h2(p1[0] * __builtin_amdgcn_rcpf(sg[2]), p1[1] * __builtin_amdgcn_rcpf(sg[3]));
                r.z = pk_h2(p2[0] * __builtin_amdgcn_rcpf(sg[4]), p2[1] * __builtin_amdgcn_rcpf(sg[5])); r.w = pk_h2(p3[0] * __builtin_amdgcn_rcpf(sg[6]), p3[1] * __builtin_amdgcn_rcpf(sg[7]));
                sp[j * 512] = r; sc[j * 512] = w; }
            asm volatile("" ::: "memory"); }
        } else if constexpr (k < 5) {
            const GAS u32x4* sa = (const GAS u32x4*)(sbase + (size_t)(k - 3) * 16 * 8192);
#pragma unroll
            for (int hb_ = 0; hb_ < 2; ++hb_) {
            u32x4 p[8];
#pragma unroll
            for (int j = 0; j < 8; ++j) p[j] = sa[(hb_ * 8 + j) * 512];
#pragma unroll
            for (int jj = 0; jj < 8; ++jj) { const int j = hb_ * 8 + jj; f32x4& v0 = acc[j >> 3][(j >> 2) & 1][j & 3][0]; f32x4& v1 = acc[j >> 3][(j >> 2) & 1][j & 3][1];
                const f32x2 p0 = un_h2(p[jj].x), p1 = un_h2(p[jj].y), p2 = un_h2(p[jj].z), p3 = un_h2(p[jj].w);
                v0[0] *= p0[0]; v0[1] *= p0[1]; v0[2] *= p1[0]; v0[3] *= p1[1]; v1[0] *= p2[0]; v1[1] *= p2[1]; v1[2] *= p3[0]; v1[3] *= p3[1];
                asm volatile("" : "+v"(v0), "+v"(v1)); }
            asm volatile("" ::: "memory"); }
        } else {
            const GAS u32x4* sa = (const GAS u32x4*)(sbase + (size_t)2 * 16 * 8192);
            const int row0 = u.pm * 256 + wr * 64 + fr, col0 = u.pn * 256 + wc * 32 + 8 * fq;
            u32x4 p[16];
#pragma unroll
            for (int j = 0; j < 16; ++j) p[j] = sa[j * 512];
#pragma unroll
            for (int ai = 0; ai < 2; ++ai)
#pragma unroll
                for (int m = 0; m < 4; ++m) { bf16_t* rowp = O + (size_t)(row0 + ai * 128 + m * 16) * D + col0;
#pragma unroll
                    for (int bj = 0; bj < 2; ++bj) { const int j16 = (ai * 2 + bj) * 4 + m; const f32x4 v0 = acc[ai][bj][m][0], v1 = acc[ai][bj][m][1];
                        const f32x2 p0 = un_h2(p[j16].x), p1 = un_h2(p[j16].y), p2 = un_h2(p[j16].z), p3 = un_h2(p[j16].w);
                        u32x4 w; w.x = cvt_pk_bf16(v0[0] * p0[0], v0[1] * p0[1]); w.y = cvt_pk_bf16(v0[2] * p1[0], v0[3] * p1[1]);
                        w.z = cvt_pk_bf16(v1[0] * p2[0], v1[1] * p2[1]); w.w = cvt_pk_bf16(v1[2] * p3[0], v1[3] * p3[1]);
                        *(u32x4*)(rowp + bj * 128) = w; } }
        }
    }
};
struct EpiResid {
    static constexpr bool PERM = false;
    const float *xp, *xs; float* out; float* rowss;
    template <int KK> static constexpr bool zero_after() { return true; }
    template <int KK> __device__ __forceinline__ void run(f32x4 (&acc)[2][2][4][2], const pg8::Seg& u, int wr, int wc, int fr, int fq, int) const {
        const int row0 = u.pm * 256 + wr * 64 + fr, col0 = u.pn * 256 + wc * 32 + 4 * fq;
#pragma unroll
        for (int ai = 0; ai < 2; ++ai) {
            f32x4 xv[4][4];
#pragma unroll
            for (int m = 0; m < 4; ++m) { const int r = row0 + ai * 128 + m * 16; const float* xr = (r < TP ? xp + (size_t)r * D : xs + (size_t)(r - TP) * D) + col0;
#pragma unroll
                for (int bj = 0; bj < 2; ++bj)
#pragma unroll
                    for (int n = 0; n < 2; ++n) xv[m][bj * 2 + n] = *(const f32x4*)(xr + bj * 128 + n * 16); }
#pragma unroll
            for (int m = 0; m < 4; ++m) { const int r = row0 + ai * 128 + m * 16; float* orow = out + (size_t)r * D + col0; float ss = 0.f;
#pragma unroll
                for (int bj = 0; bj < 2; ++bj)
#pragma unroll
                    for (int n = 0; n < 2; ++n) { const f32x4 y = xv[m][bj * 2 + n] + acc[ai][bj][m][n];
                        ss += (y[0] * y[0] + y[1] * y[1]) + (y[2] * y[2] + y[3] * y[3]); *(f32x4*)(orow + bj * 128 + n * 16) = y; }
                ss += __shfl_xor(ss, 16); ss += __shfl_xor(ss, 32);
                if (fq == 0) rowss[(size_t)r * 16 + u.pn * 4 + wc] = ss; }
            asm volatile("" ::: "memory"); }
    }
};

__device__ __forceinline__ void p0_transpose_item(const float* W, int K, int N, bf16_t* WT, LAS float* scr, int item, int lane) {
    const int nblk = N / 32, kb = item / nblk, nb = item % nblk, k0 = 64 * kb, n0 = 32 * nb;
#pragma unroll 8
    for (int i = 0; i < 32; ++i) { const int kk = 2 * i + (lane >> 5); scr[kk * 33 + (lane & 31)] = W[(size_t)(k0 + kk) * N + n0 + (lane & 31)]; }
    asm volatile("s_waitcnt lgkmcnt(0)" ::: "memory");
    const int c = lane & 7;
#pragma unroll
    for (int j = 0; j < 4; ++j) { const int n = (lane >> 3) + 8 * j; const LAS float* s = scr + (8 * c) * 33 + n;
        u32x4 o; o.x = cvt_pk_bf16(s[0 * 33], s[1 * 33]); o.y = cvt_pk_bf16(s[2 * 33], s[3 * 33]); o.z = cvt_pk_bf16(s[4 * 33], s[5 * 33]); o.w = cvt_pk_bf16(s[6 * 33], s[7 * 33]);
        *(u32x4*)(WT + (size_t)(n0 + n) * K + k0 + 8 * c) = o; }
    asm volatile("s_waitcnt lgkmcnt(0)" ::: "memory");
}
__device__ __forceinline__ void rms_row_to_bf16(const float* xrow, const float* g, bf16_t* orow, int lane) {
    const f32x4* xr = (const f32x4*)xrow + lane; const f32x4* gr = (const f32x4*)g + lane;
    f32x4 v[4]; float s = 0.f;
#pragma unroll
    for (int j = 0; j < 4; ++j) { v[j] = xr[64 * j]; s += (v[j][0] * v[j][0] + v[j][1] * v[j][1]) + (v[j][2] * v[j][2] + v[j][3] * v[j][3]); }
    const float rstd = 1.0f / sqrtf(wave_sum(s) * (1.0f / D) + EPS);
    u32x2* o8 = (u32x2*)orow + lane;
#pragma unroll
    for (int j = 0; j < 4; ++j) { const f32x4 gv = gr[64 * j]; u32x2 w; w.x = cvt_pk_bf16(v[j][0] * rstd * gv[0], v[j][1] * rstd * gv[1]); w.y = cvt_pk_bf16(v[j][2] * rstd * gv[2], v[j][3] * rstd * gv[3]); o8[64 * j] = w; }
}
__device__ __forceinline__ unsigned short f2bf(float f) { return (unsigned short)(cvt_pk_bf16(f, 0.f) & 0xffffu); }
__device__ __forceinline__ float cosrev(float x) { return __builtin_amdgcn_cosf(x); }
__device__ __forceinline__ float sinrev(float x) { return __builtin_amdgcn_sinf(x); }

__device__ __forceinline__ unsigned kv_off(int key, int chunk) { return (unsigned)(key * 128 + ((chunk ^ (key & 7)) << 4)); }
struct QG { bf16x8 q0, q1; };
__device__ __forceinline__ QG load_qg(const bf16_t* qrow, const bf16_t*, int fq) {
    QG r; r.q0 = *(const bf16x8*)(qrow + 8 * fq); r.q1 = *(const bf16x8*)(qrow + 32 + 8 * fq);
    return r;
}
template <bool NA>
__device__ __forceinline__ void attn16(LAS unsigned char* Kimg, LAS unsigned char* Vimg, const LAS float* rpbs, const int (&krow)[8], const QG& in,
                                       bf16_t* gate_out  , int fr, int fq, int lane,
                                       int qcol, int c0, int drbase  ) {
    u32x2 gin[4];
#pragma unroll
    for (int db = 0; db < 4; ++db) gin[db] = *(const u32x2*)(gate_out + 16 * db + 4 * fq);
    const unsigned kl0 = (unsigned)(fr * 128 + ((fq ^ (fr & 7)) << 4)), kl1 = (unsigned)(fr * 128 + (((4 + fq) ^ (fr & 7)) << 4));
    f32x4 sacc[16];
#pragma unroll
    for (int kb = 0; kb < 16; ++kb) {
        LAS unsigned char* kp = Kimg + (krow[kb >> 1] + (kb & 1) * 16) * 128;
        f32x4 a = (f32x4){0.f, 0.f, 0.f, 0.f};
        a = mfma16(*(const LAS bf16x8*)(kp + kl0), in.q0, a);
        a = mfma16(*(const LAS bf16x8*)(kp + kl1), in.q1, a);
        sacc[kb] = a;
    }
    const float L2E = 1.4426950408889634f * 0.125f;
    float mx = -3.0e38f, sum = 0.f;
    if (NA) {
        const int cs = min(max(qcol - 8, 0), 48), relb = c0 + 4 * fq - cs;
        const LAS float* bp = rpbs + (drbase * 31 + c0 + 4 * fq - qcol + 15);
        bool valid[2][4];
#pragma unroll
        for (int hc = 0; hc < 2; ++hc)
#pragma unroll
            for (int i = 0; i < 4; ++i) valid[hc][i] = (unsigned)(relb + 16 * hc + i) < 16u;
#pragma unroll
        for (int kb = 0; kb < 16; ++kb)
#pragma unroll
            for (int i = 0; i < 4; ++i) { float sv = __builtin_fmaf(sacc[kb][i], L2E, bp[(kb >> 1) * 31 + 16 * (kb & 1) + i]); sv = valid[kb & 1][i] ? sv : -3.0e38f; sacc[kb][i] = sv; mx = fmaxf(mx, sv); }
        mx = fmaxf(mx, __shfl_xor(mx, 16)); mx = fmaxf(mx, __shfl_xor(mx, 32));
#pragma unroll
        for (int kb = 0; kb < 16; ++kb)
#pragma unroll
            for (int i = 0; i < 4; ++i) { const float p = __builtin_amdgcn_exp2f(sacc[kb][i] - mx); sacc[kb][i] = p; sum += p; }
    } else {
#pragma unroll
        for (int kb = 0; kb < 16; ++kb)
#pragma unroll
            for (int i = 0; i < 4; ++i) mx = fmaxf(mx, sacc[kb][i]);
        mx = fmaxf(mx, __shfl_xor(mx, 16)); mx = fmaxf(mx, __shfl_xor(mx, 32));
        const float mb = -mx * L2E;
#pragma unroll
        for (int kb = 0; kb < 16; ++kb)
#pragma unroll
            for (int i = 0; i < 4; ++i) { const float p = __builtin_amdgcn_exp2f(__builtin_fmaf(sacc[kb][i], L2E, mb)); sacc[kb][i] = p; sum += p; }
    }
    sum += __shfl_xor(sum, 16); sum += __shfl_xor(sum, 32);
    const float inv = 1.0f / sum;
    bf16x8 pf[8];
#pragma unroll
    for (int s = 0; s < 8; ++s) pf[s] = pack8(sacc[2 * s], sacc[2 * s + 1]);
    const int q4 = (lane & 15) >> 2, p4 = lane & 3, kl = 4 * fq + q4;
    unsigned vl[4];
#pragma unroll
    for (int db = 0; db < 4; ++db) vl[db] = (unsigned)(kl * 128 + (((2 * db + (p4 >> 1)) ^ (kl & 7)) << 4) + 8 * (p4 & 1));
    f32x4 oacc[4];
#pragma unroll
    for (int db = 0; db < 4; ++db) oacc[db] = (f32x4){0.f, 0.f, 0.f, 0.f};
#pragma unroll
    for (int s = 0; s < 8; ++s) {
        LAS unsigned char* vp = Vimg + krow[s] * 128;
#pragma unroll
        for (int db = 0; db < 4; ++db) {
            const s16x4 v0 = tr_read(vp + vl[db]);
            const s16x4 v1 = tr_read(vp + 2048 + vl[db]);
            oacc[db] = mfma16(cat4(v0, v1), pf[s], oacc[db]);
        }
        if (s & 1) __builtin_amdgcn_sched_barrier(0);
    }
#pragma unroll
    for (int db = 0; db < 4; ++db) { const u32x2 gv = gin[db]; u32x2 w;
        w.x = cvt_pk_bf16(oacc[db][0] * inv * siluf_(bf_lo(gv.x)), oacc[db][1] * inv * siluf_(bf_hi(gv.x)));
        w.y = cvt_pk_bf16(oacc[db][2] * inv * siluf_(bf_lo(gv.y)), oacc[db][3] * inv * siluf_(bf_hi(gv.y)));
        *(u32x2*)(gate_out + 16 * db + 4 * fq) = w; }
}

__global__ void __launch_bounds__(NTHREADS) mk_fwd(Args a) {
    extern __shared__ __attribute__((aligned(16))) unsigned char lds_raw[];
    LAS unsigned char* lds = (LAS unsigned char*)lds_raw;
    cg::grid_group grid = cg::this_grid();
    const int wid = __builtin_amdgcn_readfirstlane((int)threadIdx.x >> 6);
    const int G = gridDim.x, blk = blockIdx.x;
#define PHASE_LANES const int tid = threadIdx.x, lane = tid & 63, fr = lane & 15, fq = lane >> 4; (void)tid; (void)lane; (void)fr; (void)fq
    unsigned char* ws = a.ws; unsigned char* ob = (unsigned char*)a.out;
    bf16_t* z1 = (bf16_t*)(ws + WS_Z1); bf16_t* merged = (bf16_t*)(ws + WS_MERGED);
    bf16_t* WinT = (bf16_t*)(ws + WS_WIN); bf16_t* WkvT = (bf16_t*)(ws + WS_WKV); bf16_t* WfoT = (bf16_t*)(ws + WS_WFO); bf16_t* WnaT = (bf16_t*)(ws + WS_WNA);
    bf16_t* WcaT = (bf16_t*)(ws + WS_WCA); bf16_t* WoutT = (bf16_t*)(ws + WS_WOUT); bf16_t* kvmem = (bf16_t*)(ws + WS_KVMEM); bf16_t* memn = (bf16_t*)(ws + WS_MEMN);
    float* rowss = (float*)(ws + WS_ROWSS);
    bf16_t* tab64 = (bf16_t*)(ws + WS_TAB64); bf16_t* tab128 = (bf16_t*)(ws + WS_TAB128); bf16_t* tabC = (bf16_t*)(ws + WS_TABC);
    bf16_t* hb = (bf16_t*)(ob + OUT_HB); bf16_t* T2 = (bf16_t*)(ob + OUT_T2);
    const int lo = a.ph_lo, hi = a.ph_hi;
#ifndef SKIPMASK
#define SKIPMASK 0
#endif
#define IN(k) (!((SKIPMASK >> (k)) & 1) && lo <= (k) && (k) < hi)
#ifndef REPMASK
#define REPMASK 0
#endif
#define REPS(k) (1 + ((REPMASK >> (k)) & 1))
#define SEAM(k) do { if (IN(k) && IN((k) + 1)) grid.sync(); } while (0)

    if (IN(0)) for (int rep_ = 0; rep_ < REPS(0); ++rep_) {
        PHASE_LANES;
        LAS float* scr = (LAS float*)(lds + wid * 16384);
        const int gw = blk * 8 + wid, NGW = G * 8;
        constexpr int I_IN = 16 * (NIN / 32), I_KV = 16 * 16, I_FO = 6 * 32, I_NA = 6 * 32, I_CA = 4 * 32, I_OUT = 16 * 32;
        constexpr int NITEMS = I_IN + I_KV + I_FO + I_NA + I_CA + I_OUT;
        for (int it = gw; it < NITEMS; it += NGW) {
            int r = it;
            if (r < I_IN) { p0_transpose_item(a.w_in, D, NIN, WinT, scr, r, lane); continue; } r -= I_IN;
            if (r < I_KV) { p0_transpose_item(a.w_kv, D, 512, WkvT, scr, r, lane); continue; } r -= I_KV;
            if (r < I_FO) { p0_transpose_item(a.w_fo, 384, D, WfoT, scr, r, lane); continue; } r -= I_FO;
            if (r < I_NA) { p0_transpose_item(a.w_na, 384, D, WnaT, scr, r, lane); continue; } r -= I_NA;
            if (r < I_CA) { p0_transpose_item(a.w_ca, 256, D, WcaT, scr, r, lane); continue; } r -= I_CA;
            p0_transpose_item(a.w_out, D, D, WoutT, scr, r, lane);
        }
        for (int m = gw; m < T; m += NGW) rms_row_to_bf16(m < TP ? a.xp + (size_t)m * D : a.xs + (size_t)(m - TP) * D, a.g_norm, hb + (size_t)m * D, lane);
        for (int m = gw; m < NMEMROWS; m += NGW) rms_row_to_bf16(m < 2048 ? a.memp + (size_t)m * D : a.mems + (size_t)(m - 2048) * D, a.g_mem, memn + (size_t)m * D, lane);
        const int gt = blk * NTHREADS + tid, NT = G * NTHREADS;
        for (int i = gt; i < 64 * 64; i += NT) { const int k = i >> 6, n = i & 63; const float f = (float)((k * n) & 63) * (1.0f / 64.0f); const float c = cosrev(f), s = sinrev(f);
            tab64[i] = f2bf(c); tab64[4096 + i] = f2bf(-s); tab64[8192 + i] = f2bf(s); }
        for (int i = gt; i < 128 * 128; i += NT) { const int k = i >> 7, n = i & 127; const float f = (float)((k * n) & 127) * (1.0f / 128.0f); const float c = cosrev(f), s = sinrev(f);
            tab128[i] = f2bf(c); tab128[16384 + i] = f2bf(-s); tab128[32768 + i] = f2bf(s); }
        for (int i = gt; i < 96 * 96; i += NT) { const int l = i / 96, kap = i % 96; const int s = kap >> 5, g = (kap & 31) >> 3, j = kap & 7; const int m = 32 * s + 16 * (j >> 2) + 4 * g + (j & 3);
            const float f = (float)((m * l) % 96) * (1.0f / 96.0f); tabC[i] = f2bf(cosrev(f)); tabC[9216 + i] = f2bf(sinrev(f)); }
    }
    SEAM(0);

    if (IN(1)) {
        { PlainStream S; S.so.init(T, NZ, G, blk, REPS(1)); S.A = (const char*)hb; S.B = (const char*)WinT; S.lda = D * 2; S.ldb = D * 2; S.nt = 16;
          EpiStoreBf16 E{z1, NZ}; pg8::gemm_stream<1>(lds, S, E); }
        { PlainStream S; S.so.init(NMEMROWS, 512, G, blk); S.A = (const char*)memn; S.B = (const char*)WkvT; S.lda = D * 2; S.ldb = D * 2; S.nt = 16;
          EpiStoreBf16 E{kvmem, 512}; pg8::gemm_stream<1>(lds, S, E); }
    }
    SEAM(1);

    if (IN(2)) {
        PHASE_LANES;
        {
            LAS unsigned char* Kimg = lds; LAS unsigned char* Vimg = lds + 576 * 128; LAS float* rpbs = (LAS float*)(lds + 2 * 576 * 128);
            constexpr int NITEMS = 768;
            for (int it = blk; it < NITEMS; it += G) {
                int q, chunk, h, R;
                if (it < 384) { h = it % 6; const int t2 = it / 6; chunk = t2 & 7; q = t2 >> 3; R = 128; }
                else { const int i2 = it - 384; h = i2 % 6; const int t2 = i2 / 6; chunk = t2 & 3; q = 8 + (t2 >> 2); R = 64; }
                const int sb = seq_base(q), rowbase = 16 * chunk;
                const bf16_t* kvbase = z1 + (size_t)sb * NZ + h * 64;
                int rb = min(max(rowbase - 4, 0), R - 8), hi = min(rb + 8, R - 1);
                __syncthreads();
                for (int c = tid; c < (hi - rb + 1) * 512; c += NTHREADS) { const int row = rb + (c >> 9), col = (c >> 3) & 63, ch = c & 7, key = (row % 9) * 64 + col;
                    const bf16_t* src = kvbase + (size_t)(row * 64 + col) * NZ + ch * 8;
                    *(LAS u32x4*)(Kimg + kv_off(key, ch)) = *(const u32x4*)(src + C_K); *(LAS u32x4*)(Vimg + kv_off(key, ch)) = *(const u32x4*)(src + C_V); }
                for (int c = tid; c < 465; c += NTHREADS) rpbs[c] = a.rpb[h * 465 + c] * 1.4426950408889634f;
                const int j = wid & 3, c0 = min(max(16 * j - 8, 0), 32), pcol = tid >> 3, pch = tid & 7;
                bf16_t* trow = z1 + (size_t)(sb + (rowbase + (wid >> 2)) * 64 + 16 * j + fr) * NZ;
                QG cur = load_qg(trow + C_Q + h * 64, trow + C_GNA + h * 64, fq);
                __syncthreads();
#pragma unroll 1
                for (int bi = 0; bi < 8; ++bi) {
                    const int r0 = rowbase + 2 * bi, r = r0 + (wid >> 2), rs = min(max(r - 4, 0), R - 8);
                    const int rb2 = min(max(r0 + 2 - 4, 0), R - 8), hi2 = (bi < 7) ? min(rb2 + 8, R - 1) : hi;
                    const int nrow0 = min(hi + 1, R - 1), nrow1 = min(hi + 2, R - 1);
                    const bf16_t* s0 = kvbase + (size_t)(nrow0 * 64 + pcol) * NZ + pch * 8; const bf16_t* s1 = kvbase + (size_t)(nrow1 * 64 + pcol) * NZ + pch * 8;
                    const u32x4 pk0 = *(const u32x4*)(s0 + C_K), pv0 = *(const u32x4*)(s0 + C_V), pk1 = *(const u32x4*)(s1 + C_K), pv1 = *(const u32x4*)(s1 + C_V);
                    bf16_t* trow2 = trow + (size_t)(bi < 7 ? 128 : 0) * NZ;
                    const QG nxt = load_qg(trow2 + C_Q + h * 64, trow2 + C_GNA + h * 64, fq);
                    int krow[8]; { const int sl0 = rs % 9;
#pragma unroll
                        for (int kr = 0; kr < 8; ++kr) { int sl = sl0 + kr; sl = sl >= 9 ? sl - 9 : sl; krow[kr] = sl * 64 + c0; } }
                    attn16<true>(Kimg, Vimg, rpbs, krow, cur, trow + C_GNA + h * 64, fr, fq, lane, 16 * j + fr, c0, rs - r + 7);
                    __syncthreads();
                    if (hi + 1 <= hi2) { const int key = ((hi + 1) % 9) * 64 + pcol; *(LAS u32x4*)(Kimg + kv_off(key, pch)) = pk0; *(LAS u32x4*)(Vimg + kv_off(key, pch)) = pv0; }
                    if (hi + 2 <= hi2) { const int key = ((hi + 2) % 9) * 64 + pcol; *(LAS u32x4*)(Kimg + kv_off(key, pch)) = pk1; *(LAS u32x4*)(Vimg + kv_off(key, pch)) = pv1; }
                    __syncthreads();
                    hi = hi2; cur = nxt; trow = trow2;
                }
            }
        }
        {
            LAS unsigned char* Kimg = lds; LAS unsigned char* Vimg = lds + 256 * 128;
            constexpr int NITEMS = 512;
            int krow[8];
#pragma unroll
            for (int kr = 0; kr < 8; ++kr) krow[kr] = kr * 32;
            for (int it = blk; it < NITEMS; it += G) {
                int q, h, ck;
                if (it < 256) { ck = it & 7; h = (it >> 3) & 3; q = it >> 5; } else { const int i2 = it - 256; ck = i2 & 3; h = (i2 >> 2) & 3; q = 8 + (i2 >> 4); }
                const int tok0 = seq_base(q) + ck * 1024;
                __syncthreads();
                for (int c = tid; c < 256 * 8; c += NTHREADS) { const int key = c >> 3, ch = c & 7; const bf16_t* src = kvmem + (size_t)(q * 256 + key) * 512 + h * 64 + ch * 8;
                    *(LAS u32x4*)(Kimg + kv_off(key, ch)) = *(const u32x4*)(src); *(LAS u32x4*)(Vimg + kv_off(key, ch)) = *(const u32x4*)(src + 256); }
                bf16_t* trow = z1 + (size_t)(tok0 + wid * 128 + fr) * NZ;
                QG cur = load_qg(trow + C_QCA + h * 64, trow + C_GCA + h * 64, fq);
                __syncthreads();
#pragma unroll 1
                for (int i = 0; i < 8; ++i) { bf16_t* trow2 = trow + (size_t)(i < 7 ? 16 : 0) * NZ;
                    const QG nxt = load_qg(trow2 + C_QCA + h * 64, trow2 + C_GCA + h * 64, fq);
                    attn16<false>(Kimg, Vimg, nullptr, krow, cur, trow + C_GCA + h * 64, fr, fq, lane, 0, 0, 0);
                    cur = nxt; trow = trow2; }
            }
        }
        for (int rep_ = 0; rep_ < REPS(7); ++rep_)
        {
            constexpr int US = 784;
            constexpr int NITEMS = 2048;
            bf16x8 af[8][2];
#pragma unroll
            for (int mb = 0; mb < 8; ++mb)
#pragma unroll
                for (int ks = 0; ks < 2; ++ks) af[mb][ks] = *(const bf16x8*)(tab64 + (mb >> 2) * 4096 + ((mb & 3) * 16 + fr) * 64 + 32 * ks + 8 * fq);
            const int q4 = (lane & 15) >> 2, p4 = lane & 3;
            for (int it = blk; it < NITEMS; it += G) {
                int q, n2, N2, S;
                if (it < 1024) { q = it >> 7; n2 = it & 127; N2 = 128; S = 8192; } else { const int i2 = it - 1024; q = 8 + (i2 >> 6); n2 = i2 & 63; N2 = 64; S = 4096; }
                const int sb = seq_base(q);
                __syncthreads();
                for (int c = tid; c < 64 * 48; c += NTHREADS) { const int n1 = c / 48, ch = c % 48;
                    *(LAS u32x4*)(lds + n1 * US + ch * 16) = *(const u32x4*)(z1 + (size_t)(sb + N2 * n1 + n2) * NZ + C_UF + ch * 8); }
                __syncthreads();
                const float invS = 1.0f / (float)S;
#pragma unroll 1
                for (int cc = 0; cc < 3; ++cc) {
                    const int c = wid * 3 + cc;
                    bf16x8 bfr[2];
#pragma unroll
                    for (int ks = 0; ks < 2; ++ks) { LAS unsigned char* p = lds + (32 * ks + 8 * fq + q4) * US + (16 * c + 4 * p4) * 2; bfr[ks] = cat4(tr_read(p), tr_read(p + 4 * US)); }
                    f32x4 acc[8];
#pragma unroll
                    for (int mb = 0; mb < 8; ++mb) { f32x4 v = (f32x4){0.f, 0.f, 0.f, 0.f}; v = mfma16(af[mb][0], bfr[0], v); v = mfma16(af[mb][1], bfr[1], v); acc[mb] = v; }
                    const int ch = 16 * c + fr, grp = ch / 96, mm = ch - grp * 96;
#pragma unroll
                    for (int mb = 0; mb < 4; ++mb)
#pragma unroll
                        for (int i = 0; i < 4; ++i) { const int k1 = mb * 16 + 4 * fq + i; const float f = (float)((n2 * k1) & (S - 1)) * invS; const float cs = cosrev(f), sn = sinrev(f);
                            const float tr = acc[mb][i], ti = acc[mb + 4][i]; bf16_t* dst = T2 + (size_t)(sb + k1 * N2 + n2) * 768 + grp * 192 + mm;
                            dst[0] = f2bf(tr * cs + ti * sn); dst[96] = f2bf(ti * cs - tr * sn); }
                }
            }
        }
    }
    SEAM(2);

    if (IN(3)) {
        PHASE_LANES;
        constexpr int TS = 400;
        constexpr int NITEMS = 4096;
        const int q4 = (lane & 15) >> 2, p4 = lane & 3;
#define FC_DECODE(IT, BIG, Q, K1, GG, SB) const bool BIG = (IT) < 2048; const int GG = BIG ? ((IT) & 3) : (((IT) - 2048) & 1), K1 = BIG ? (((IT) >> 2) & 63) : ((((IT) - 2048) >> 1) & 63), \
        Q = BIG ? ((IT) >> 8) : (8 + (((IT) - 2048) >> 7)), SB = seq_base(Q)
#define FC_LOAD_TILE(DST, BIG, K1, GG, SB) do { _Pragma("unroll") for (int i_ = 0; i_ < 6; ++i_) { const int c_ = tid + NTHREADS * i_, rr_ = c_ / 24, ch_ = c_ - rr_ * 24; \
        const size_t row_ = BIG ? (size_t)(SB + K1 * 128 + rr_) : (size_t)(SB + K1 * 64 + (rr_ & 63)); const int gcol_ = BIG ? GG * 192 : (2 * GG + (rr_ >> 6)) * 192; \
        DST[i_] = *(const u32x4*)(T2 + row_ * 768 + gcol_ + ch_ * 8); } } while (0)
#define FC_STORE_TILE(SRC) do { _Pragma("unroll") for (int i_ = 0; i_ < 6; ++i_) { const int c_ = tid + NTHREADS * i_, rr_ = c_ / 24, ch_ = c_ - rr_ * 24; *(LAS u32x4*)(lds + rr_ * TS + ch_ * 16) = SRC[i_]; } } while (0)
#define FC_GATE_ROW(BIG, K1, GG, SB) (z1 + (size_t)(SB + K1 + 64 * (16 * (BIG ? wid : (wid & 3)) + fr)) * NZ + C_GF + (BIG ? GG : 2 * GG + (wid >> 2)) * 96 + 4 * fq)
        u32x4 pre[6]; u32x2 gcur[6];
        int it = blk;
        if (it < NITEMS) { FC_DECODE(it, big0, q0_, k10, g0_, sb0); FC_LOAD_TILE(pre, big0, k10, g0_, sb0); const bf16_t* gr = FC_GATE_ROW(big0, k10, g0_, sb0);
#pragma unroll
            for (int lb = 0; lb < 6; ++lb) gcur[lb] = *(const u32x2*)(gr + 16 * lb);
            __syncthreads(); FC_STORE_TILE(pre); __syncthreads(); }
        for (; it < NITEMS; it += G) {
            FC_DECODE(it, big, q, k1, gg, sb);
            const int nit = it + G; const bool hasn = nit < NITEMS; const int nit_c = hasn ? nit : it;
            FC_DECODE(nit_c, bign, qn, k1n, ggn, sbn);
            u32x2 gnx[6];
            FC_LOAD_TILE(pre, bign, k1n, ggn, sbn);
            { const bf16_t* gr = FC_GATE_ROW(bign, k1n, ggn, sbn);
#pragma unroll
              for (int lb = 0; lb < 6; ++lb) gnx[lb] = *(const u32x2*)(gr + 16 * lb); }
            const int N2 = big ? 128 : 64, S = big ? 8192 : 4096, kb2 = big ? wid : (wid & 3);
            LAS unsigned char* tile = big ? lds : lds + (wid >> 2) * 64 * TS;
            const bf16_t* tab = big ? tab128 : tab64; const int tsz = N2 * N2; const int nks = N2 / 32;
            f32x4 zr[6], zi[6];
#pragma unroll
            for (int cb = 0; cb < 6; ++cb) { zr[cb] = (f32x4){0.f, 0.f, 0.f, 0.f}; zi[cb] = (f32x4){0.f, 0.f, 0.f, 0.f}; }
#pragma unroll 1
            for (int ks = 0; ks < nks; ++ks) {
                const bf16_t* tp = tab + (16 * kb2 + fr) * N2 + 32 * ks + 8 * fq;
                const bf16x8 wre = *(const bf16x8*)(tp), wim = *(const bf16x8*)(tp + tsz), wni = *(const bf16x8*)(tp + 2 * tsz);
                LAS unsigned char* rowp = tile + (32 * ks + 8 * fq + q4) * TS + 8 * p4;
#pragma unroll
                for (int cb = 0; cb < 6; ++cb) {
                    const bf16x8 trf = cat4(tr_read(rowp + 32 * cb), tr_read(rowp + 32 * cb + 4 * TS));
                    const bf16x8 tif = cat4(tr_read(rowp + 192 + 32 * cb), tr_read(rowp + 192 + 32 * cb + 4 * TS));
                    zr[cb] = mfma16(trf, wre, zr[cb]); zr[cb] = mfma16(tif, wni, zr[cb]);
                    zi[cb] = mfma16(tif, wre, zi[cb]); zi[cb] = mfma16(trf, wim, zi[cb]);
                }
            }
            bf16x8 zfr[3], zfi[3];
#pragma unroll
            for (int s_ = 0; s_ < 3; ++s_) { zfr[s_] = pack8(zr[2 * s_], zr[2 * s_ + 1]); zfi[s_] = pack8(zi[2 * s_], zi[2 * s_ + 1]); }
            const float scale = 1.0f / sqrtf((float)S * 96.0f);
            bf16_t* trow = (bf16_t*)FC_GATE_ROW(big, k1, gg, sb);
#pragma unroll
            for (int lb = 0; lb < 6; ++lb) {
                f32x4 y = (f32x4){0.f, 0.f, 0.f, 0.f};
#pragma unroll
                for (int s_ = 0; s_ < 3; ++s_) { const bf16_t* cp = tabC + (16 * lb + fr) * 96 + 32 * s_ + 8 * fq;
                    y = mfma16(*(const bf16x8*)cp, zfr[s_], y); y = mfma16(*(const bf16x8*)(cp + 9216), zfi[s_], y); }
                const u32x2 gv = gcur[lb]; u32x2 w;
                w.x = cvt_pk_bf16(y[0] * scale * siluf_(bf_lo(gv.x)), y[1] * scale * siluf_(bf_hi(gv.x)));
                w.y = cvt_pk_bf16(y[2] * scale * siluf_(bf_lo(gv.y)), y[3] * scale * siluf_(bf_hi(gv.y)));
                *(u32x2*)(trow + 16 * lb) = w;
            }
            __syncthreads();
            if (hasn) FC_STORE_TILE(pre);
            __syncthreads();
#pragma unroll
            for (int lb = 0; lb < 6; ++lb) gcur[lb] = gnx[lb];
        }
#undef FC_DECODE
#undef FC_LOAD_TILE
#undef FC_STORE_TILE
#undef FC_GATE_ROW
    }
    SEAM(3);

    if (IN(4)) {
        MergeStream S; S.so.init(T, D, G, blk, REPS(4)); S.hb = (const char*)hb; S.z1 = (const char*)z1; S.win = (const char*)WinT; S.wfo = (const char*)WfoT; S.wna = (const char*)WnaT; S.wca = (const char*)WcaT;
        EpiMerge E{ob + OUT_T2 + (size_t)blk * (3 * 16 * 8192), merged};
        pg8::gemm_stream<6>(lds, S, E);
    }
    SEAM(4);

    if (IN(5)) {
        PlainStream S; S.so.init(T, D, G, blk, REPS(5)); S.A = (const char*)merged; S.B = (const char*)WoutT; S.lda = D * 2; S.ldb = D * 2; S.nt = 16;
        EpiResid E{a.xp, a.xs, a.out, rowss};
        pg8::gemm_stream<1>(lds, S, E);
    }
    SEAM(5);

    if (IN(6)) {
        PHASE_LANES;
        const int gw = blk * 8 + wid, NGW = G * 8;
        for (int m = gw; m < T; m += NGW) {
            float s = lane < 16 ? rowss[(size_t)m * 16 + lane] : 0.f;
            s = wave_sum(s);
            const float rstd = 1.0f / sqrtf(s * (1.0f / D) + EPS);
            f32x4* yr = (f32x4*)(a.out + (size_t)m * D) + lane; const f32x4* gr = (const f32x4*)a.g_final + lane;
#pragma unroll
            for (int j = 0; j < 4; ++j) { const f32x4 v = yr[64 * j], gv = gr[64 * j]; yr[64 * j] = v * rstd * gv; }
        }
    }
}

extern "C" void kernel_launch(void* const* d_in, const int* in_sizes, int n_in, void* d_out, int out_size, void* d_ws, size_t ws_size, hipStream_t stream) {
    static int grid = 0;
    if (grid == 0) {
        if (n_in != 14 || out_size != T * D || ws_size < WS_END) { fprintf(stderr, "kernel_launch: unexpected sizes (n_in %d out %d ws %zu, need ws >= %zu)\n", n_in, out_size, ws_size, (size_t)WS_END); grid = -1; return; }
        int dev = 0, cus = 0, per_cu = 0;
        if (hipGetDevice(&dev) != hipSuccess || hipDeviceGetAttribute(&cus, hipDeviceAttributeMultiprocessorCount, dev) != hipSuccess) { grid = -1; return; }
        if (hipFuncSetAttribute((const void*)mk_fwd, hipFuncAttributeMaxDynamicSharedMemorySize, LDS_BYTES) != hipSuccess) { fprintf(stderr, "kernel_launch: hipFuncSetAttribute failed\n"); grid = -1; return; }
        if (hipOccupancyMaxActiveBlocksPerMultiprocessor(&per_cu, (const void*)mk_fwd, NTHREADS, LDS_BYTES) != hipSuccess || per_cu < 1) { fprintf(stderr, "kernel_launch: occupancy query says %d blocks per CU\n", per_cu); grid = -1; return; }
        grid = cus;
    }
    if (grid < 0) return;
    Args a{};
    a.xp = (const float*)d_in[0]; a.xs = (const float*)d_in[1]; a.memp = (const float*)d_in[2]; a.mems = (const float*)d_in[3]; a.g_norm = (const float*)d_in[4];
    a.w_in = (const float*)d_in[5]; a.rpb = (const float*)d_in[6]; a.g_mem = (const float*)d_in[7]; a.w_kv = (const float*)d_in[8]; a.w_fo = (const float*)d_in[9];
    a.w_na = (const float*)d_in[10]; a.w_ca = (const float*)d_in[11]; a.w_out = (const float*)d_in[12]; a.g_final = (const float*)d_in[13];
    a.out = (float*)d_out; a.ws = (unsigned char*)d_ws;
#if MK_N_LAUNCHES == 1
    a.ph_lo = 0; a.ph_hi = NPHASES;
    { void* args[] = {&a}; hipError_t e = hipLaunchCooperativeKernel((const void*)mk_fwd, dim3(grid), dim3(NTHREADS), args, LDS_BYTES, stream);
      if (e != hipSuccess) fprintf(stderr, "kernel_launch: cooperative launch failed: %s\n", hipGetErrorString(e)); }
#else
    for (int p = 0; p < NPHASES; ++p) { a.ph_lo = p; a.ph_hi = p + 1; void* args[] = {&a};
        hipError_t e = hipLaunchCooperativeKernel((const void*)mk_fwd, dim3(grid), dim3(NTHREADS), args, LDS_BYTES, stream);
        if (e != hipSuccess) { fprintf(stderr, "kernel_launch: launch %d failed: %s\n", p, hipGetErrorString(e)); break; } }
#endif
}
```

```cpp
#include <hip/hip_runtime.h>
#include <hip/hip_cooperative_groups.h>
#include <cstdio>
#include <cstdint>
namespace cg = cooperative_groups;

#ifndef FUSE_NORM
#define FUSE_NORM 0
#endif
#ifndef MK_N_LAUNCHES
#define MK_N_LAUNCHES 1
#endif

#define LAS __attribute__((address_space(3)))
#define GAS __attribute__((address_space(1)))
typedef unsigned short bf16_t;
typedef short bf16x8 __attribute__((ext_vector_type(8)));
typedef short s16x4 __attribute__((ext_vector_type(4)));
typedef float f32x4 __attribute__((ext_vector_type(4)));
typedef unsigned u32x4 __attribute__((ext_vector_type(4)));
typedef unsigned u32x2 __attribute__((ext_vector_type(2)));

constexpr int D = 1024, T = 131072, TP = 65536, NZ = 2816, NIN = 5888, NMEMROWS = 6144;
constexpr int C_UF = 0, C_GF = 384, C_Q = 768, C_K = 1152, C_V = 1536, C_GNA = 1920, C_QCA = 2304, C_GCA = 2560;
constexpr float EPS = 1e-6f;
constexpr int NPHASES = 7;
constexpr int LDS_BYTES = 153600;
constexpr int NTHREADS = 512;

constexpr size_t WS_Z1 = 0;
constexpr size_t WS_MERGED = WS_Z1 + (size_t)T * NZ * 2;
constexpr size_t WS_WIN = WS_MERGED + (size_t)T * D * 2;
constexpr size_t WS_WKV = WS_WIN + (size_t)NIN * D * 2;
constexpr size_t WS_WFO = WS_WKV + (size_t)512 * D * 2;
constexpr size_t WS_WNA = WS_WFO + (size_t)D * 384 * 2;
constexpr size_t WS_WCA = WS_WNA + (size_t)D * 384 * 2;
constexpr size_t WS_WOUT = WS_WCA + (size_t)D * 256 * 2;
constexpr size_t WS_KVMEM = WS_WOUT + (size_t)D * D * 2;
constexpr size_t WS_MEMN = WS_KVMEM + (size_t)NMEMROWS * 512 * 2;
constexpr size_t WS_ROWSS = WS_MEMN + (size_t)NMEMROWS * D * 2;
constexpr size_t WS_TAB64 = WS_ROWSS + (size_t)T * 16 * 4;
constexpr size_t WS_TAB128 = WS_TAB64 + 3 * 64 * 64 * 2;
constexpr size_t WS_TABC = WS_TAB128 + 3 * 128 * 128 * 2;
constexpr size_t WS_CNT = (WS_TABC + 2 * 96 * 96 * 2 + 255) / 256 * 256;
constexpr size_t WS_BAR = WS_CNT + 512 * 256;
constexpr size_t WS_END = WS_BAR + 3456 * 4;
constexpr size_t OUT_HB = 0;
constexpr size_t OUT_T2 = (size_t)T * D * 2;
constexpr size_t OUT_END = OUT_T2 + (size_t)T * 768 * 2;
static_assert(OUT_END <= (size_t)T * D * 4, "d_out scratch");

struct Args {
    const float *xp, *xs, *memp, *mems, *g_norm, *w_in, *rpb, *g_mem, *w_kv, *w_fo, *w_na, *w_ca, *w_out, *g_final;
    float* out; unsigned char* ws; int ph_lo, ph_hi;
};

typedef __bf16 bf16v2 __attribute__((ext_vector_type(2)));
typedef float f32x2 __attribute__((ext_vector_type(2)));
__device__ __forceinline__ unsigned cvt_pk_bf16(float lo, float hi) { const f32x2 v = {lo, hi}; return __builtin_bit_cast(unsigned, __builtin_convertvector(v, bf16v2)); }
__device__ __forceinline__ float bf_lo(unsigned w) { return __uint_as_float(w << 16); }
__device__ __forceinline__ float bf_hi(unsigned w) { return __uint_as_float(w & 0xffff0000u); }
__device__ __forceinline__ float wave_sum(float v) {
#pragma unroll
    for (int o = 1; o < 64; o <<= 1) v += __shfl_xor(v, o);
    return v;
}
__device__ __forceinline__ float sigmoidf_(float x) { return __builtin_amdgcn_rcpf(1.0f + __expf(-x)); }
__device__ __forceinline__ float siluf_(float x) { return x * sigmoidf_(x); }
__device__ __forceinline__ int seq_base(int q) { return q < 8 ? q * 8192 : TP + (q - 8) * 4096; }
__device__ __forceinline__ f32x4 mfma16(bf16x8 a, bf16x8 b, f32x4 c) { return __builtin_amdgcn_mfma_f32_16x16x32_bf16(a, b, c, 0, 0, 0); }
__device__ __forceinline__ bf16x8 cat4(s16x4 a, s16x4 b) { return __builtin_shufflevector(a, b, 0, 1, 2, 3, 4, 5, 6, 7); }
__device__ __forceinline__ s16x4 tr_read(LAS unsigned char* p) { return __builtin_amdgcn_ds_read_tr16_b64_v4i16((LAS s16x4*)p); }
__device__ __forceinline__ bf16x8 pack8(f32x4 a, f32x4 b) {
    u32x4 p; p.x = cvt_pk_bf16(a[0], a[1]); p.y = cvt_pk_bf16(a[2], a[3]); p.z = cvt_pk_bf16(b[0], b[1]); p.w = cvt_pk_bf16(b[2], b[3]);
    return __builtin_bit_cast(bf16x8, p);
}

namespace pg8 {
constexpr int BM = 256, BK = 64, HALF = 128, HTB = HALF * BK * 2, STAGE_BYTES = 8 * HTB, NXCD = 8, WGM = 8;
__device__ __forceinline__ int lds_byte(int r, int c) { const int st = (r >> 4) * 2 + (c >> 5), rr = r & 15, cc = c & 31, ob = rr * 64 + cc * 2; return st * 1024 + (ob ^ (((ob >> 9) & 1) << 5)); }
__device__ __forceinline__ void stage_rc(int b, int& R, int& C) { const int st = b / 1024, sb = b % 1024, swz = sb ^ (((sb >> 9) & 1) << 5); R = (st >> 1) * 16 + swz / 64; C = (st & 1) * 32 + (swz % 64) / 2; }
__device__ __forceinline__ int perm32(int rho) { const int n = rho >> 4, i = rho & 15; return 8 * (i >> 2) + 4 * n + (i & 3); }

struct Unit { int pm, pn; };
struct StaticOrder {
    int nM, nN, nwg, G, c, rep;
    __device__ void init(int M, int N, int G_, int c_, int rep_ = 1) { nM = M / BM; nN = N / BM; nwg = nM * nN; G = G_; c = c_; rep = rep_; }
    __device__ bool next(int i, Unit& u) const {
        long L = (long)i * G + c; if (L >= (long)nwg * rep) return false;
        L %= nwg;
        int wgid = (int)L; { const int q = nwg / NXCD, r = nwg % NXCD, xcd = wgid % NXCD, off = wgid / NXCD; wgid = (xcd < r ? xcd * (q + 1) : r * (q + 1) + (xcd - r) * q) + off; }
        const int nig = WGM * nN, gid = wgid / nig, fm = gid * WGM, gsz = (nM - fm) < WGM ? (nM - fm) : WGM;
        u.pm = fm + ((wgid % nig) % gsz); u.pn = (wgid % nig) / gsz; return true;
    }
};
struct Seg { const char* A; const char* B; unsigned lda, ldb; int nt, kind, pm, pn; };

template <int NSEG, class Epi, class Stream>
__device__ __forceinline__ void gemm_stream(LAS unsigned char* lds, const Stream& S, const Epi& E) {
    const int tid = threadIdx.x, wid = __builtin_amdgcn_readfirstlane(tid >> 6), lane = tid & 63, wr = wid >> 2, wc = wid & 3, fr = lane & 15, fq = lane >> 4;
    unsigned Ra0, Rb0, Cc0;
    { int R, C; stage_rc(tid * 16, R, C); Ra0 = (unsigned)R; Rb0 = (unsigned)(Epi::PERM ? ((R & ~31) + perm32(R & 31)) : R); Cc0 = (unsigned)C * 2u; }
    const size_t kstep = (size_t)(BK * 2);
    const unsigned ldsw = (unsigned)wid * 1024u;
    const int aoff = lds_byte(wr * 64 + fr, fq * 8), boff = lds_byte(wc * 32 + fr, fq * 8);
#define PG8_SA(b, h) (((b) * 2 + (h)) * HTB)
#define PG8_SB(b, h) ((4 + (b) * 2 + (h)) * HTB)
#define PG8_STAGE(bufoff, gbase, v0, ld) do { \
        __builtin_amdgcn_global_load_lds((const unsigned*)((const char*)(gbase) + (v0)), (LAS unsigned*)(lds + (bufoff) + ldsw), 16, 0, 0); \
        __builtin_amdgcn_global_load_lds((const unsigned*)((const char*)(gbase) + (size_t)64 * (ld) + (v0)), (LAS unsigned*)(lds + (bufoff) + ldsw + 8192), 16, 0, 0); } while (0)
#define PG8_LDA(dst, b, h) do { _Pragma("unroll") for (int m = 0; m < 4; ++m) _Pragma("unroll") for (int k = 0; k < 2; ++k) dst[m][k] = *(const LAS bf16x8*)(lds + PG8_SA(b, h) + aoff + m * 2048 + k * 1024); } while (0)
#define PG8_LDB(dst, b, h) do { _Pragma("unroll") for (int n = 0; n < 2; ++n) _Pragma("unroll") for (int k = 0; k < 2; ++k) dst[n][k] = *(const LAS bf16x8*)(lds + PG8_SB(b, h) + boff + n * 2048 + k * 1024); } while (0)
#define PG8_MMA(ai, bj, At, Bt) do { __builtin_amdgcn_s_setprio(1); _Pragma("unroll") for (int m = 0; m < 4; ++m) _Pragma("unroll") for (int n = 0; n < 2; ++n) _Pragma("unroll") for (int k = 0; k < 2; ++k) \
        acc[ai][bj][m][n] = __builtin_amdgcn_mfma_f32_16x16x32_bf16(Bt[n][k], At[m][k], acc[ai][bj][m][n], 0, 0, 0); __builtin_amdgcn_s_setprio(0); } while (0)
#define PG8_WAIT_V(n) asm volatile("s_waitcnt vmcnt(" #n ")" ::: "memory")
#define PG8_WAIT_L(n) asm volatile("s_waitcnt lgkmcnt(" #n ")" ::: "memory")
#define PG8_BAR __builtin_amdgcn_s_barrier()
#define PG8_SCHED __builtin_amdgcn_sched_barrier(0)
#define PG8_ZERO() do { _Pragma("unroll") for (int a_ = 0; a_ < 2; ++a_) _Pragma("unroll") for (int b_ = 0; b_ < 2; ++b_) _Pragma("unroll") for (int m_ = 0; m_ < 4; ++m_) _Pragma("unroll") for (int n_ = 0; n_ < 2; ++n_) \
        acc[a_][b_][m_][n_] = (f32x4){0.f, 0.f, 0.f, 0.f}; } while (0)
    Seg cur, nxt; int ui = 0;
    if (!S.template seg<0>(0, cur)) return;
    f32x4 acc[2][2][4][2];
    PG8_ZERO();
    bf16x8 At[4][2], B0[2][2], B1[2][2];
    const char* cA = cur.A; const char* cB = cur.B;
    unsigned vAc0 = Ra0 * cur.lda + Cc0, vBc0 = Rb0 * cur.ldb + Cc0, ldAc = cur.lda, ldBc = cur.ldb;
    size_t hAc = (size_t)HALF * cur.lda, hBc = (size_t)HALF * cur.ldb;
    PG8_STAGE(PG8_SB(0, 0), cB, vBc0, ldBc); PG8_STAGE(PG8_SA(0, 0), cA, vAc0, ldAc); PG8_STAGE(PG8_SB(0, 1), cB + hBc, vBc0, ldBc); PG8_STAGE(PG8_SA(0, 1), cA + hAc, vAc0, ldAc);
    if (wr == 1) PG8_BAR;
    PG8_WAIT_V(4); PG8_BAR;
    PG8_STAGE(PG8_SB(1, 0), cB + kstep, vBc0, ldBc); PG8_STAGE(PG8_SA(1, 0), cA + kstep, vAc0, ldAc); PG8_STAGE(PG8_SB(1, 1), cB + hBc + kstep, vBc0, ldBc);
    PG8_WAIT_V(6); PG8_BAR;
#define PG8_SEG(KK) if constexpr (NSEG > (KK)) { \
        bool has_next; if constexpr ((KK) + 1 < NSEG) { S.template seg<((KK) + 1 < NSEG ? (KK) + 1 : 0)>(ui, nxt); has_next = true; } else has_next = S.template seg<0>(ui + 1, nxt); \
        if (!has_next) nxt = cur;     \
        const char* nA = nxt.A; const char* nB = nxt.B; \
        const unsigned vAn0 = Ra0 * nxt.lda + Cc0, vBn0 = Rb0 * nxt.ldb + Cc0, ldAn = nxt.lda, ldBn = nxt.ldb; \
        const size_t hAn = (size_t)HALF * nxt.lda, hBn = (size_t)HALF * nxt.ldb; \
        const int nt = cur.nt; \
        for (int t = 0; t < nt; t += 2) { \
            const bool last = (t == nt - 2); \
            const char* a1 = cA + (size_t)(t + 1) * kstep; \
            const char* a2 = last ? nA : cA + (size_t)(t + 2) * kstep; const char* b2 = last ? nB : cB + (size_t)(t + 2) * kstep; \
            const char* a3 = a2 + kstep; const char* b3 = b2 + kstep; \
            const unsigned vA0 = last ? vAn0 : vAc0, vB0 = last ? vBn0 : vBc0, lA2 = last ? ldAn : ldAc, lB2 = last ? ldBn : ldBc; \
            const size_t hA2 = last ? hAn : hAc, hB2 = last ? hBn : hBc; \
            PG8_LDB(B0, 0, 0); PG8_SCHED; PG8_LDA(At, 0, 0); PG8_STAGE(PG8_SA(1, 1), a1 + hAc, vAc0, ldAc); \
            PG8_WAIT_L(8); PG8_BAR; PG8_WAIT_L(0); PG8_MMA(0, 0, At, B0); PG8_BAR; PG8_SCHED; \
            PG8_LDB(B1, 0, 1); PG8_STAGE(PG8_SB(0, 0), b2, vB0, lB2); \
            PG8_BAR; PG8_WAIT_L(0); PG8_MMA(0, 1, At, B1); PG8_BAR; \
            PG8_LDA(At, 0, 1); PG8_STAGE(PG8_SA(0, 0), a2, vA0, lA2); \
            PG8_BAR; PG8_WAIT_L(0); PG8_MMA(1, 0, At, B0); PG8_BAR; PG8_SCHED; \
            PG8_STAGE(PG8_SB(0, 1), b2 + hB2, vB0, lB2); \
            PG8_WAIT_V(6); PG8_BAR; PG8_MMA(1, 1, At, B1); PG8_BAR; \
            PG8_LDB(B0, 1, 0); PG8_SCHED; PG8_LDA(At, 1, 0); PG8_STAGE(PG8_SA(0, 1), a2 + hA2, vA0, lA2); \
            PG8_WAIT_L(8); PG8_BAR; PG8_WAIT_L(0); PG8_MMA(0, 0, At, B0); PG8_BAR; PG8_SCHED; \
            PG8_LDB(B1, 1, 1); PG8_STAGE(PG8_SB(1, 0), b3, vB0, lB2); \
            PG8_BAR; PG8_WAIT_L(0); PG8_MMA(0, 1, At, B1); PG8_BAR; \
            PG8_LDA(At, 1, 1); PG8_STAGE(PG8_SA(1, 0), a3, vA0, lA2); \
            PG8_BAR; PG8_WAIT_L(0); PG8_MMA(1, 0, At, B0); PG8_BAR; PG8_SCHED; \
            PG8_STAGE(PG8_SB(1, 1), b3 + hB2, vB0, lB2); \
            PG8_WAIT_V(6); PG8_BAR; PG8_MMA(1, 1, At, B1); PG8_BAR; \
        } \
        E.template run<(KK)>(acc, cur, wr, wc, fr, fq, tid); \
        if (!has_next) break; \
        if constexpr (Epi::template zero_after<(KK)>()) PG8_ZERO(); \
        cur = nxt; cA = nA; cB = nB; vAc0 = vAn0; vBc0 = vBn0; ldAc = ldAn; ldBc = ldBn; hAc = hAn; hBc = hBn; }
    for (;;) {
        PG8_SEG(0) PG8_SEG(1) PG8_SEG(2) PG8_SEG(3) PG8_SEG(4) PG8_SEG(5)
        ++ui;
    }
    PG8_WAIT_V(0);
    if (wr == 0) PG8_BAR;
    PG8_BAR;
#undef PG8_SA
#undef PG8_SB
#undef PG8_STAGE
#undef PG8_LDA
#undef PG8_LDB
#undef PG8_MMA
#undef PG8_WAIT_V
#undef PG8_WAIT_L
#undef PG8_BAR
#undef PG8_SCHED
#undef PG8_ZERO
#undef PG8_SEG
}
}

struct PlainStream {
    pg8::StaticOrder so; const char* A; const char* B; unsigned lda, ldb; int nt;
    template <int KK> __device__ __forceinline__ bool seg(int i, pg8::Seg& s) const { pg8::Unit u; if (!so.next(i, u)) return false;
        s.A = A + (size_t)u.pm * 256 * lda; s.B = B + (size_t)u.pn * 256 * ldb; s.lda = lda; s.ldb = ldb; s.nt = nt; s.kind = 0; s.pm = u.pm; s.pn = u.pn; return true; }
};
struct EpiStoreBf16 {
    static constexpr bool PERM = true;
    bf16_t* O; int ldc;
    template <int KK> static constexpr bool zero_after() { return true; }
    template <int KK> __device__ __forceinline__ void run(f32x4 (&acc)[2][2][4][2], const pg8::Seg& u, int wr, int wc, int fr, int fq, int) const {
        const int row0 = u.pm * 256 + wr * 64 + fr, col0 = u.pn * 256 + wc * 32 + 8 * fq;
#pragma unroll
        for (int ai = 0; ai < 2; ++ai)
#pragma unroll
            for (int m = 0; m < 4; ++m) { bf16_t* rowp = O + (size_t)(row0 + ai * 128 + m * 16) * ldc + col0;
#pragma unroll
                for (int bj = 0; bj < 2; ++bj) { const f32x4 v0 = acc[ai][bj][m][0], v1 = acc[ai][bj][m][1];
                    u32x4 w; w.x = cvt_pk_bf16(v0[0], v0[1]); w.y = cvt_pk_bf16(v0[2], v0[3]); w.z = cvt_pk_bf16(v1[0], v1[1]); w.w = cvt_pk_bf16(v1[2], v1[3]);
                    *(u32x4*)(rowp + bj * 128) = w; } }
    }
};

struct MergeStream {
    pg8::StaticOrder so; const char *hb, *z1, *win, *wfo, *wna, *wca;
    template <int KK> __device__ __forceinline__ bool seg(int ui, pg8::Seg& s) const { pg8::Unit u; constexpr int k = KK; if (!so.next(ui, u)) return false;
        s.kind = k; s.pm = u.pm; s.pn = u.pn;
        if (k < 3) { s.A = hb + (size_t)u.pm * 256 * (D * 2); s.lda = D * 2; s.B = win + (size_t)(NZ + k * D + u.pn * 256) * (D * 2); s.ldb = D * 2; s.nt = 16; }
        else { s.lda = NZ * 2; const char* a = z1 + (size_t)u.pm * 256 * (NZ * 2);
            if (k == 3) { s.A = a + C_GF * 2; s.B = wfo + (size_t)u.pn * 256 * (384 * 2); s.ldb = 384 * 2; s.nt = 6; }
            else if (k == 4) { s.A = a + C_GNA * 2; s.B = wna + (size_t)u.pn * 256 * (384 * 2); s.ldb = 384 * 2; s.nt = 6; }
            else { s.A = a + C_GCA * 2; s.B = wca + (size_t)u.pn * 256 * (256 * 2); s.ldb = 256 * 2; s.nt = 4; } }
        return true; }
};
typedef _Float16 f16v2 __attribute__((ext_vector_type(2)));
__device__ __forceinline__ unsigned pk_h2(float lo, float hi) { const f32x2 v = {lo, hi}; return __builtin_bit_cast(unsigned, __builtin_convertvector(v, f16v2)); }
__device__ __forceinline__ f32x2 un_h2(unsigned w) { return __builtin_convertvector(__builtin_bit_cast(f16v2, w), f32x2); }
struct EpiMerge {
    static constexpr bool PERM = true;
    unsigned char* stash; bf16_t* O;
    template <int KK> static constexpr bool zero_after() { return KK < 3 || KK == 5; }
    template <int KK> __device__ __forceinline__ void run(f32x4 (&acc)[2][2][4][2], const pg8::Seg& u, int wr, int wc, int fr, int fq, int tid) const {
        constexpr int k = KK;
        GAS unsigned char* sbase = (GAS unsigned char*)stash + (size_t)tid * 16; asm volatile("" : "+v"(sbase));
        if constexpr (k < 3) {
            GAS u32x4* st = (GAS u32x4*)(sbase + (size_t)k * 16 * 8192);
#pragma unroll
            for (int j = 0; j < 16; ++j) { const f32x4 v0 = acc[j >> 3][(j >> 2) & 1][j & 3][0], v1 = acc[j >> 3][(j >> 2) & 1][j & 3][1]; u32x4 w;
                w.x = pk_h2(sigmoidf_(v0[0]), sigmoidf_(v0[1])); w.y = pk_h2(sigmoidf_(v0[2]), sigmoidf_(v0[3]));
                w.z = pk_h2(sigmoidf_(v1[0]), sigmoidf_(v1[1])); w.w = pk_h2(sigmoidf_(v1[2]), sigmoidf_(v1[3]));
                st[j * 512] = w; }
        } else if constexpr (k < 5) {
            const GAS u32x4* sa = (const GAS u32x4*)(sbase + (size_t)(k - 3) * 16 * 8192); const GAS u32x4* sb = (const GAS u32x4*)(sbase + (size_t)(k - 2) * 16 * 8192);
#pragma unroll
            for (int hb_ = 0; hb_ < 2; ++hb_) {
            u32x4 p[8], q[8];
#pragma unroll
            for (int j = 0; j < 8; ++j) { p[j] = sa[(hb_ * 8 + j) * 512]; q[j] = sb[(hb_ * 8 + j) * 512]; }
#pragma unroll
            for (int jj = 0; jj < 8; ++jj) { const int j = hb_ * 8 + jj; f32x4& v0 = acc[j >> 3][(j >> 2) & 1][j & 3][0]; f32x4& v1 = acc[j >> 3][(j >> 2) & 1][j & 3][1];
                const f32x2 p0 = un_h2(p[jj].x), p1 = un_h2(p[jj].y), p2 = un_h2(p[jj].z), p3 = un_h2(p[jj].w);
                const f32x2 q0 = un_h2(q[jj].x), q1 = un_h2(q[jj].y), q2 = un_h2(q[jj].z), q3 = un_h2(q[jj].w);
                v0[0] *= p0[0] * __builtin_amdgcn_rcpf(q0[0]); v0[1] *= p0[1] * __builtin_amdgcn_rcpf(q0[1]); v0[2] *= p1[0] * __builtin_amdgcn_rcpf(q1[0]); v0[3] *= p1[1] * __builtin_amdgcn_rcpf(q1[1]);
                v1[0] *= p2[0] * __builtin_amdgcn_rcpf(q2[0]); v1[1] *= p2[1] * __builtin_amdgcn_rcpf(q2[1]); v1[2] *= p3[0] * __builtin_amdgcn_rcpf(q3[0]); v1[3] *= p3[1] * __builtin_amdgcn_rcpf(q3[1]);
                asm volatile("" : "+v"(v0), "+v"(v1)); }
            asm volatile("" ::: "memory"); }
        } else {
            const GAS u32x4* sa = (const GAS u32x4*)(sbase + (size_t)2 * 16 * 8192);
            const int row0 = u.pm * 256 + wr * 64 + fr, col0 = u.pn * 256 + wc * 32 + 8 * fq;
            u32x4 p[16];
#pragma unroll
            for (int j = 0; j < 16; ++j) p[j] = sa[j * 512];
#pragma unroll
            for (int ai = 0; ai < 2; ++ai)
#pragma unroll
                for (int m = 0; m < 4; ++m) { bf16_t* rowp = O + (size_t)(row0 + ai * 128 + m * 16) * D + col0;
#pragma unroll
                    for (int bj = 0; bj < 2; ++bj) { const int j16 = (ai * 2 + bj) * 4 + m; const f32x4 v0 = acc[ai][bj][m][0], v1 = acc[ai][bj][m][1];
                        const f32x2 p0 = un_h2(p[j16].x), p1 = un_h2(p[j16].y), p2 = un_h2(p[j16].z), p3 = un_h2(p[j16].w);
                        u32x4 w; w.x = cvt_pk_bf16(v0[0] * p0[0], v0[1] * p0[1]); w.y = cvt_pk_bf16(v0[2] * p1[0], v0[3] * p1[1]);
                        w.z = cvt_pk_bf16(v1[0] * p2[0], v1[1] * p2[1]); w.w = cvt_pk_bf16(v1[2] * p3[0], v1[3] * p3[1]);
                        *(u32x4*)(rowp + bj * 128) = w; } }
        }
    }
};
struct EpiResid {
    static constexpr bool PERM = false;
    const float *xp, *xs; float* out; float* rowss; unsigned* cnt; const float* g_final; int fused;
    template <int KK> static constexpr bool zero_after() { return true; }
    template <int KK> __device__ __forceinline__ void run(f32x4 (&acc)[2][2][4][2], const pg8::Seg& u, int wr, int wc, int fr, int fq, int tid) const {
        const int row0 = u.pm * 256 + wr * 64 + fr, col0 = u.pn * 256 + wc * 32 + 4 * fq;
#pragma unroll
        for (int ai = 0; ai < 2; ++ai) {
            f32x4 xv[4][4];
#pragma unroll
            for (int m = 0; m < 4; ++m) { const int r = row0 + ai * 128 + m * 16; const float* xr = (r < TP ? xp + (size_t)r * D : xs + (size_t)(r - TP) * D) + col0;
#pragma unroll
                for (int bj = 0; bj < 2; ++bj)
#pragma unroll
                    for (int n = 0; n < 2; ++n) xv[m][bj * 2 + n] = *(const f32x4*)(xr + bj * 128 + n * 16); }
#pragma unroll
            for (int m = 0; m < 4; ++m) { const int r = row0 + ai * 128 + m * 16; float* orow = out + (size_t)r * D + col0; float ss = 0.f;
#pragma unroll
                for (int bj = 0; bj < 2; ++bj)
#pragma unroll
                    for (int n = 0; n < 2; ++n) { const f32x4 y = xv[m][bj * 2 + n] + acc[ai][bj][m][n]; acc[ai][bj][m][n] = y;
                        ss += (y[0] * y[0] + y[1] * y[1]) + (y[2] * y[2] + y[3] * y[3]); if (!fused) *(f32x4*)(orow + bj * 128 + n * 16) = y; }
                ss += __shfl_xor(ss, 16); ss += __shfl_xor(ss, 32);
                if (fq == 0) { float* slot = rowss + (size_t)r * 16 + u.pn * 4 + wc; if (fused) __hip_atomic_store(slot, ss, __ATOMIC_RELAXED, __HIP_MEMORY_SCOPE_AGENT); else *slot = ss; } }
            asm volatile("" ::: "memory"); }
        if (!fused) return;
        asm volatile("s_waitcnt vmcnt(0)" ::: "memory");
        unsigned* cw = cnt + 64 * u.pm + 16 * wr;
        if ((tid & 63) == 0) __hip_atomic_fetch_add(cw, 1u, __ATOMIC_RELAXED, __HIP_MEMORY_SCOPE_AGENT);
        { const unsigned long long t0 = __builtin_amdgcn_s_memrealtime();
          while ((unsigned)__builtin_amdgcn_readfirstlane(__hip_atomic_load(cw, __ATOMIC_RELAXED, __HIP_MEMORY_SCOPE_AGENT)) < 16u) {
              if (__builtin_amdgcn_s_memrealtime() - t0 > 2000000ull) break;
              __builtin_amdgcn_s_sleep(2); } }
        __builtin_amdgcn_fence(__ATOMIC_ACQUIRE, "agent");
        asm volatile("s_waitcnt vmcnt(0)" ::: "memory");
        unsigned long long pl[8][2];
#pragma unroll
        for (int ai = 0; ai < 2; ++ai)
#pragma unroll
            for (int m = 0; m < 4; ++m) { const int r = row0 + ai * 128 + m * 16; const unsigned long long* pp = (const unsigned long long*)(rowss + (size_t)r * 16 + fq * 4);
                pl[ai * 4 + m][0] = __hip_atomic_load(pp, __ATOMIC_RELAXED, __HIP_MEMORY_SCOPE_AGENT); pl[ai * 4 + m][1] = __hip_atomic_load(pp + 1, __ATOMIC_RELAXED, __HIP_MEMORY_SCOPE_AGENT); }
        f32x4 gf[4];
#pragma unroll
        for (int bj = 0; bj < 2; ++bj)
#pragma unroll
            for (int n = 0; n < 2; ++n) gf[bj * 2 + n] = *(const f32x4*)(g_final + col0 + bj * 128 + n * 16);
#pragma unroll
        for (int ai = 0; ai < 2; ++ai)
#pragma unroll
            for (int m = 0; m < 4; ++m) { const int r = row0 + ai * 128 + m * 16; float* orow = out + (size_t)r * D + col0;
                const unsigned long long w0 = pl[ai * 4 + m][0], w1 = pl[ai * 4 + m][1];
                float t = (__uint_as_float((unsigned)w0) + __uint_as_float((unsigned)(w0 >> 32))) + (__uint_as_float((unsigned)w1) + __uint_as_float((unsigned)(w1 >> 32)));
                t += __shfl_xor(t, 16); t += __shfl_xor(t, 32);
                const float rstd = 1.0f / sqrtf(t * (1.0f / D) + EPS);
#pragma unroll
                for (int bj = 0; bj < 2; ++bj)
#pragma unroll
                    for (int n = 0; n < 2; ++n) *(f32x4*)(orow + bj * 128 + n * 16) = acc[ai][bj][m][n] * rstd * gf[bj * 2 + n]; }
    }
};

__device__ __forceinline__ void p0_transpose_item(const float* W, int K, int N, bf16_t* WT, LAS float* scr, int item, int lane) {
    const int nblk = N / 32, kb = item / nblk, nb = item % nblk, k0 = 64 * kb, n0 = 32 * nb;
#pragma unroll 8
    for (int i = 0; i < 32; ++i) { const int kk = 2 * i + (lane >> 5); scr[kk * 33 + (lane & 31)] = W[(size_t)(k0 + kk) * N + n0 + (lane & 31)]; }
    asm volatile("s_waitcnt lgkmcnt(0)" ::: "memory");
    const int c = lane & 7;
#pragma unroll
    for (int j = 0; j < 4; ++j) { const int n = (lane >> 3) + 8 * j; const LAS float* s = scr + (8 * c) * 33 + n;
        u32x4 o; o.x = cvt_pk_bf16(s[0 * 33], s[1 * 33]); o.y = cvt_pk_bf16(s[2 * 33], s[3 * 33]); o.z = cvt_pk_bf16(s[4 * 33], s[5 * 33]); o.w = cvt_pk_bf16(s[6 * 33], s[7 * 33]);
        *(u32x4*)(WT + (size_t)(n0 + n) * K + k0 + 8 * c) = o; }
    asm volatile("s_waitcnt lgkmcnt(0)" ::: "memory");
}
__device__ __forceinline__ void rms_row_to_bf16(const float* xrow, const float* g, bf16_t* orow, int lane) {
    const f32x4* xr = (const f32x4*)xrow + lane; const f32x4* gr = (const f32x4*)g + lane;
    f32x4 v[4]; float s = 0.f;
#pragma unroll
    for (int j = 0; j < 4; ++j) { v[j] = xr[64 * j]; s += (v[j][0] * v[j][0] + v[j][1] * v[j][1]) + (v[j][2] * v[j][2] + v[j][3] * v[j][3]); }
    const float rstd = 1.0f / sqrtf(wave_sum(s) * (1.0f / D) + EPS);
    u32x2* o8 = (u32x2*)orow + lane;
#pragma unroll
    for (int j = 0; j < 4; ++j) { const f32x4 gv = gr[64 * j]; u32x2 w; w.x = cvt_pk_bf16(v[j][0] * rstd * gv[0], v[j][1] * rstd * gv[1]); w.y = cvt_pk_bf16(v[j][2] * rstd * gv[2], v[j][3] * rstd * gv[3]); o8[64 * j] = w; }
}
__device__ __forceinline__ void rms_rows4_to_bf16(const float* const (&xrow)[4], const float* g, bf16_t* const (&orow)[4], int lane) {
    f32x4 v[4][4]; float s[4];
#pragma unroll
    for (int r = 0; r < 4; ++r) { const f32x4* xr = (const f32x4*)xrow[r] + lane;
#pragma unroll
        for (int j = 0; j < 4; ++j) v[r][j] = xr[64 * j]; }
#pragma unroll
    for (int r = 0; r < 4; ++r) { float t = 0.f;
#pragma unroll
        for (int j = 0; j < 4; ++j) t += (v[r][j][0] * v[r][j][0] + v[r][j][1] * v[r][j][1]) + (v[r][j][2] * v[r][j][2] + v[r][j][3] * v[r][j][3]);
        s[r] = 1.0f / sqrtf(wave_sum(t) * (1.0f / D) + EPS); }
    const f32x4* gr = (const f32x4*)g + lane;
#pragma unroll
    for (int j = 0; j < 4; ++j) { const f32x4 gv = gr[64 * j];
#pragma unroll
        for (int r = 0; r < 4; ++r) { u32x2 w; w.x = cvt_pk_bf16(v[r][j][0] * s[r] * gv[0], v[r][j][1] * s[r] * gv[1]); w.y = cvt_pk_bf16(v[r][j][2] * s[r] * gv[2], v[r][j][3] * s[r] * gv[3]);
            ((u32x2*)orow[r] + lane)[64 * j] = w; } }
}
__device__ __forceinline__ unsigned short f2bf(float f) { return (unsigned short)(cvt_pk_bf16(f, 0.f) & 0xffffu); }
__device__ __forceinline__ float cosrev(float x) { return __builtin_amdgcn_cosf(x); }
__device__ __forceinline__ float sinrev(float x) { return __builtin_amdgcn_sinf(x); }

__device__ __forceinline__ unsigned kv_off(int key, int chunk) { return (unsigned)(key * 128 + ((chunk ^ (key & 7)) << 4)); }
struct QG { bf16x8 q0, q1; };
__device__ __forceinline__ QG load_qg(const bf16_t* qrow, const bf16_t*, int fq) {
    QG r; r.q0 = *(const bf16x8*)(qrow + 8 * fq); r.q1 = *(const bf16x8*)(qrow + 32 + 8 * fq);
    return r;
}
template <bool NA>
__device__ __forceinline__ void attn16(LAS unsigned char* Kimg, LAS unsigned char* Vimg, const LAS float* rpbs, const int (&krow)[8], const QG& in,
                                       bf16_t* gate_out  , int fr, int fq, int lane,
                                       int qcol, int c0, int drbase  ) {
    u32x2 gin[4];
#pragma unroll
    for (int db = 0; db < 4; ++db) gin[db] = *(const u32x2*)(gate_out + 16 * db + 4 * fq);
    const unsigned kl0 = (unsigned)(fr * 128 + ((fq ^ (fr & 7)) << 4)), kl1 = (unsigned)(fr * 128 + (((4 + fq) ^ (fr & 7)) << 4));
    f32x4 sacc[16];
#pragma unroll
    for (int kb = 0; kb < 16; ++kb) {
        LAS unsigned char* kp = Kimg + (krow[kb >> 1] + (kb & 1) * 16) * 128;
        f32x4 a = (f32x4){0.f, 0.f, 0.f, 0.f};
        a = mfma16(*(const LAS bf16x8*)(kp + kl0), in.q0, a);
        a = mfma16(*(const LAS bf16x8*)(kp + kl1), in.q1, a);
        sacc[kb] = a;
    }
    const float L2E = 1.4426950408889634f * 0.125f;
    float mx = -3.0e38f, sum = 0.f;
    if (NA) {
        const int cs = min(max(qcol - 8, 0), 48), relb = c0 + 4 * fq - cs;
        const LAS float* bp = rpbs + (drbase * 31 + c0 + 4 * fq - qcol + 15);
        bool valid[2][4];
#pragma unroll
        for (int hc = 0; hc < 2; ++hc)
#pragma unroll
            for (int i = 0; i < 4; ++i) valid[hc][i] = (unsigned)(relb + 16 * hc + i) < 16u;
#pragma unroll
        for (int kb = 0; kb < 16; ++kb)
#pragma unroll
            for (int i = 0; i < 4; ++i) { float sv = __builtin_fmaf(sacc[kb][i], L2E, bp[(kb >> 1) * 31 + 16 * (kb & 1) + i]); sv = valid[kb & 1][i] ? sv : -3.0e38f; sacc[kb][i] = sv; mx = fmaxf(mx, sv); }
        mx = fmaxf(mx, __shfl_xor(mx, 16)); mx = fmaxf(mx, __shfl_xor(mx, 32));
#pragma unroll
        for (int kb = 0; kb < 16; ++kb)
#pragma unroll
            for (int i = 0; i < 4; ++i) { const float p = __builtin_amdgcn_exp2f(sacc[kb][i] - mx); sacc[kb][i] = p; sum += p; }
    } else {
#pragma unroll
        for (int kb = 0; kb < 16; ++kb)
#pragma unroll
            for (int i = 0; i < 4; ++i) mx = fmaxf(mx, sacc[kb][i]);
        mx = fmaxf(mx, __shfl_xor(mx, 16)); mx = fmaxf(mx, __shfl_xor(mx, 32));
        const float mb = -mx * L2E;
#pragma unroll
        for (int kb = 0; kb < 16; ++kb)
#pragma unroll
            for (int i = 0; i < 4; ++i) { const float p = __builtin_amdgcn_exp2f(__builtin_fmaf(sacc[kb][i], L2E, mb)); sacc[kb][i] = p; sum += p; }
    }
    sum += __shfl_xor(sum, 16); sum += __shfl_xor(sum, 32);
    const float inv = 1.0f / sum;
    bf16x8 pf[8];
#pragma unroll
    for (int s = 0; s < 8; ++s) pf[s] = pack8(sacc[2 * s], sacc[2 * s + 1]);
    const int q4 = (lane & 15) >> 2, p4 = lane & 3, kl = 4 * fq + q4;
    unsigned vl[4];
#pragma unroll
    for (int db = 0; db < 4; ++db) vl[db] = (unsigned)(kl * 128 + (((2 * db + (p4 >> 1)) ^ (kl & 7)) << 4) + 8 * (p4 & 1));
    f32x4 oacc[4];
#pragma unroll
    for (int db = 0; db < 4; ++db) oacc[db] = (f32x4){0.f, 0.f, 0.f, 0.f};
#pragma unroll
    for (int s = 0; s < 8; ++s) {
        LAS unsigned char* vp = Vimg + krow[s] * 128;
#pragma unroll
        for (int db = 0; db < 4; ++db) {
            const s16x4 v0 = tr_read(vp + vl[db]);
            const s16x4 v1 = tr_read(vp + 2048 + vl[db]);
            oacc[db] = mfma16(cat4(v0, v1), pf[s], oacc[db]);
        }
        if (s & 1) __builtin_amdgcn_sched_barrier(0);
    }
#pragma unroll
    for (int db = 0; db < 4; ++db) { const u32x2 gv = gin[db]; u32x2 w;
        w.x = cvt_pk_bf16(oacc[db][0] * inv * siluf_(bf_lo(gv.x)), oacc[db][1] * inv * siluf_(bf_hi(gv.x)));
        w.y = cvt_pk_bf16(oacc[db][2] * inv * siluf_(bf_lo(gv.y)), oacc[db][3] * inv * siluf_(bf_hi(gv.y)));
        *(u32x2*)(gate_out + 16 * db + 4 * fq) = w; }
}

#define XB_TMO      128
#define XB_XCNT(j)  (256  + 64 * (j))
#define XB_XSUB(j)  (1280 + 64 * (j))
#define XB_XGEN(j)  (2304 + 64 * (j))
#define XB_TOP      3328
#define XB_TOPGEN   3392
#define XCD_BAR_WORDS 3456
#define XB_SPIN_CAP (1u << 18)
__device__ __forceinline__ unsigned xb_ld(unsigned* p)              { return __hip_atomic_load(p, __ATOMIC_RELAXED, __HIP_MEMORY_SCOPE_AGENT); }
__device__ __forceinline__ unsigned xb_add(unsigned* p, unsigned v) { return __hip_atomic_fetch_add(p, v, __ATOMIC_RELAXED, __HIP_MEMORY_SCOPE_AGENT); }
__device__ __forceinline__ unsigned xb_xcc_id() { return (unsigned)__builtin_amdgcn_s_getreg((3 << 11) | 20) & 0xFu; }
#define XB_SPIN(cond, bar) do { unsigned _sp = 0; while (cond) { __builtin_amdgcn_s_sleep(1); \
    if ((++_sp & 255u) == 0u) { if (xb_ld(&(bar)[XB_TMO])) break; if (_sp > XB_SPIN_CAP) { atomicAdd(&(bar)[XB_TMO], 1u); break; } } } } while (0)
struct XcdBarrier { unsigned* bar; unsigned x; volatile LAS unsigned* st; };
__device__ __forceinline__ XcdBarrier xcd_barrier_post(unsigned* bar, volatile LAS unsigned* st) {
    XcdBarrier b; b.bar = bar; b.x = xb_xcc_id(); b.st = st;
    if (threadIdx.x == 0) (void)xb_add(&bar[XB_XCNT(b.x)], 1u);
    return b;
}
__device__ __forceinline__ void xcd_barrier_complete(unsigned* bar, unsigned x, unsigned& nloc, unsigned& nx) {
    const unsigned G = gridDim.x * gridDim.y * gridDim.z;
    unsigned sum, cnt, mine, sp = 0u;
    for (;;) {
        sum = 0u; cnt = 0u; mine = 0u;
#pragma unroll
        for (unsigned j = 0; j < 16; ++j) { const unsigned c = xb_ld(&bar[XB_XCNT(j)]); sum += c; cnt += (c > 0u) ? 1u : 0u; mine = (j == x) ? c : mine; }
        if (sum == G) break;
        __builtin_amdgcn_s_sleep(1);
        if ((++sp & 255u) == 0u) { if (xb_ld(&bar[XB_TMO])) break; if (sp > XB_SPIN_CAP) { atomicAdd(&bar[XB_TMO], 1u); break; } }
    }
    nloc = mine > 0u ? mine : 1u; nx = cnt > 0u ? cnt : 1u;
}
__device__ __forceinline__ void xcd_barrier(const XcdBarrier& b) {
    asm volatile("s_waitcnt vmcnt(0)" ::: "memory");
    __syncthreads();
    if (threadIdx.x == 0) {
        unsigned* bar = b.bar;
        __builtin_amdgcn_s_waitcnt(0);
        unsigned nloc = b.st[0], nx = b.st[1];
        if (nloc == 0u) { xcd_barrier_complete(bar, b.x, nloc, nx); b.st[0] = nloc; b.st[1] = nx; }
        const unsigned old = xb_add(&bar[XB_XSUB(b.x)], 1u);
        const unsigned gen = old / nloc;
        if (old + 1u == (gen + 1u) * nloc) {
            __builtin_amdgcn_fence(__ATOMIC_RELEASE, "agent");
            asm volatile("s_waitcnt vmcnt(0)" ::: "memory");
            const unsigned og = xb_add(&bar[XB_TOP], 1u);
            const unsigned tg = og / nx;
            if (og + 1u == (tg + 1u) * nx) xb_add(&bar[XB_TOPGEN], 1u);
            else XB_SPIN(xb_ld(&bar[XB_TOPGEN]) == tg, bar);
            __builtin_amdgcn_fence(__ATOMIC_ACQUIRE, "agent");
            xb_add(&bar[XB_XGEN(b.x)], 1u);
            asm volatile("s_waitcnt vmcnt(0)" ::: "memory");
        } else {
            XB_SPIN(xb_ld(&bar[XB_XGEN(b.x)]) == gen, bar);
            __builtin_amdgcn_fence(__ATOMIC_ACQUIRE, "agent");
            asm volatile("s_waitcnt vmcnt(0)" ::: "memory");
        }
    }
    __syncthreads();
}

__global__ void __launch_bounds__(NTHREADS) mk_fwd(Args a) {
    extern __shared__ __attribute__((aligned(16))) unsigned char lds_raw[];
    LAS unsigned char* lds = (LAS unsigned char*)lds_raw;
    cg::grid_group grid = cg::this_grid();
    const int wid = __builtin_amdgcn_readfirstlane((int)threadIdx.x >> 6);
    const int G = gridDim.x, blk = blockIdx.x;
#define PHASE_LANES const int tid = threadIdx.x, lane = tid & 63, fr = lane & 15, fq = lane >> 4; (void)tid; (void)lane; (void)fr; (void)fq
    unsigned char* ws = a.ws; unsigned char* ob = (unsigned char*)a.out;
    bf16_t* z1 = (bf16_t*)(ws + WS_Z1); bf16_t* merged = (bf16_t*)(ws + WS_MERGED);
    bf16_t* WinT = (bf16_t*)(ws + WS_WIN); bf16_t* WkvT = (bf16_t*)(ws + WS_WKV); bf16_t* WfoT = (bf16_t*)(ws + WS_WFO); bf16_t* WnaT = (bf16_t*)(ws + WS_WNA);
    bf16_t* WcaT = (bf16_t*)(ws + WS_WCA); bf16_t* WoutT = (bf16_t*)(ws + WS_WOUT); bf16_t* kvmem = (bf16_t*)(ws + WS_KVMEM); bf16_t* memn = (bf16_t*)(ws + WS_MEMN);
    float* rowss = (float*)(ws + WS_ROWSS);
    bf16_t* tab64 = (bf16_t*)(ws + WS_TAB64); bf16_t* tab128 = (bf16_t*)(ws + WS_TAB128); bf16_t* tabC = (bf16_t*)(ws + WS_TABC);
    bf16_t* hb = (bf16_t*)(ob + OUT_HB); bf16_t* T2 = (bf16_t*)(ob + OUT_T2);
    const int lo = a.ph_lo, hi = a.ph_hi;
    volatile LAS unsigned* xbst = (volatile LAS unsigned*)(lds + LDS_BYTES - 16);
    if (threadIdx.x == 0) { xbst[0] = 0u; xbst[1] = 0u; }
    __syncthreads();
    XcdBarrier xb = xcd_barrier_post((unsigned*)(ws + WS_BAR), xbst);
    if (a.ph_hi < 0) grid.sync();
#ifndef SKIPMASK
#define SKIPMASK 0
#endif
#define IN(k) (!((SKIPMASK >> (k)) & 1) && lo <= (k) && (k) < hi)
#ifndef REPMASK
#define REPMASK 0
#endif
#define REPS(k) (1 + ((REPMASK >> (k)) & 1))
#ifndef CG_SEAMS
#define CG_SEAMS 0
#endif
#define SEAM(k) do { if (IN(k) && IN((k) + 1)) { if ((k) < CG_SEAMS) grid.sync(); else xcd_barrier(xb); } } while (0)

    if (IN(0)) for (int rep_ = 0; rep_ < REPS(0); ++rep_) {
        PHASE_LANES;
        LAS float* scr = (LAS float*)(lds + wid * 16384);
        const int gw = blk * 8 + wid, NGW = G * 8;
        constexpr int I_IN = 16 * (NIN / 32), I_KV = 16 * 16, I_FO = 6 * 32, I_NA = 6 * 32, I_CA = 4 * 32, I_OUT = 16 * 32;
        constexpr int NITEMS = I_IN + I_KV + I_FO + I_NA + I_CA + I_OUT;
        for (int it = gw; it < NITEMS; it += NGW) {
            int r = it;
            if (r < I_IN) { p0_transpose_item(a.w_in, D, NIN, WinT, scr, r, lane); continue; } r -= I_IN;
            if (r < I_KV) { p0_transpose_item(a.w_kv, D, 512, WkvT, scr, r, lane); continue; } r -= I_KV;
            if (r < I_FO) { p0_transpose_item(a.w_fo, 384, D, WfoT, scr, r, lane); continue; } r -= I_FO;
            if (r < I_NA) { p0_transpose_item(a.w_na, 384, D, WnaT, scr, r, lane); continue; } r -= I_NA;
            if (r < I_CA) { p0_transpose_item(a.w_ca, 256, D, WcaT, scr, r, lane); continue; } r -= I_CA;
            p0_transpose_item(a.w_out, D, D, WoutT, scr, r, lane);
        }
        for (int m4 = gw; m4 < T / 4; m4 += NGW) { const float* xr[4]; bf16_t* orw[4];
#pragma unroll
            for (int r = 0; r < 4; ++r) { const int m = 4 * m4 + r; xr[r] = m < TP ? a.xp + (size_t)m * D : a.xs + (size_t)(m - TP) * D; orw[r] = hb + (size_t)m * D; }
            rms_rows4_to_bf16(xr, a.g_norm, orw, lane); }
        for (int m = gw; m < NMEMROWS; m += NGW) rms_row_to_bf16(m < 2048 ? a.memp + (size_t)m * D : a.mems + (size_t)(m - 2048) * D, a.g_mem, memn + (size_t)m * D, lane);
        const int gt = blk * NTHREADS + tid, NT = G * NTHREADS;
        for (int i = gt; i < 64 * 64; i += NT) { const int k = i >> 6, n = i & 63; const float f = (float)((k * n) & 63) * (1.0f / 64.0f); const float c = cosrev(f), s = sinrev(f);
            tab64[i] = f2bf(c); tab64[4096 + i] = f2bf(-s); tab64[8192 + i] = f2bf(s); }
        for (int i = gt; i < 128 * 128; i += NT) { const int k = i >> 7, n = i & 127; const float f = (float)((k * n) & 127) * (1.0f / 128.0f); const float c = cosrev(f), s = sinrev(f);
            tab128[i] = f2bf(c); tab128[16384 + i] = f2bf(-s); tab128[32768 + i] = f2bf(s); }
        for (int i = gt; i < 1024; i += NT) ((unsigned*)(ws + WS_CNT))[64 * (i >> 1) + 16 * (i & 1)] = 0u;
        for (int i = gt; i < 96 * 96; i += NT) { const int l = i / 96, kap = i % 96; const int s = kap >> 5, g = (kap & 31) >> 3, j = kap & 7; const int m = 32 * s + 16 * (j >> 2) + 4 * g + (j & 3);
            const float f = (float)((m * l) % 96) * (1.0f / 96.0f); tabC[i] = f2bf(cosrev(f)); tabC[9216 + i] = f2bf(sinrev(f)); }
    }
    SEAM(0);

    if (IN(1)) {
        { PlainStream S; S.so.init(T, NZ, G, blk, REPS(1)); S.A = (const char*)hb; S.B = (const char*)WinT; S.lda = D * 2; S.ldb = D * 2; S.nt = 16;
          EpiStoreBf16 E{z1, NZ}; pg8::gemm_stream<1>(lds, S, E); }
        { PlainStream S; S.so.init(NMEMROWS, 512, G, blk); S.A = (const char*)memn; S.B = (const char*)WkvT; S.lda = D * 2; S.ldb = D * 2; S.nt = 16;
          EpiStoreBf16 E{kvmem, 512}; pg8::gemm_stream<1>(lds, S, E); }
    }
    SEAM(1);

    if (IN(2)) {
        PHASE_LANES;
        {
            LAS unsigned char* Kimg = lds; LAS unsigned char* Vimg = lds + 576 * 128; LAS float* rpbs = (LAS float*)(lds + 2 * 576 * 128);
            constexpr int NITEMS = 768;
            for (int it = blk; it < NITEMS; it += G) {
                int q, chunk, h, R;
                if (it < 384) { h = it % 6; const int t2 = it / 6; chunk = t2 & 7; q = t2 >> 3; R = 128; }
                else { const int i2 = it - 384; h = i2 % 6; const int t2 = i2 / 6; chunk = t2 & 3; q = 8 + (t2 >> 2); R = 64; }
                const int sb = seq_base(q), rowbase = 16 * chunk;
                const bf16_t* kvbase = z1 + (size_t)sb * NZ + h * 64;
                int rb = min(max(rowbase - 4, 0), R - 8), hi = min(rb + 8, R - 1);
                __syncthreads();
                for (int c = tid; c < (hi - rb + 1) * 512; c += NTHREADS) { const int row = rb + (c >> 9), col = (c >> 3) & 63, ch = c & 7, key = (row % 9) * 64 + col;
                    const bf16_t* src = kvbase + (size_t)(row * 64 + col) * NZ + ch * 8;
                    *(LAS u32x4*)(Kimg + kv_off(key, ch)) = *(const u32x4*)(src + C_K); *(LAS u32x4*)(Vimg + kv_off(key, ch)) = *(const u32x4*)(src + C_V); }
                for (int c = tid; c < 465; c += NTHREADS) rpbs[c] = a.rpb[h * 465 + c] * 1.4426950408889634f;
                const int j = wid & 3, c0 = min(max(16 * j - 8, 0), 32), pcol = tid >> 3, pch = tid & 7;
                bf16_t* trow = z1 + (size_t)(sb + (rowbase + (wid >> 2)) * 64 + 16 * j + fr) * NZ;
                QG cur = load_qg(trow + C_Q + h * 64, trow + C_GNA + h * 64, fq);
                __syncthreads();
#pragma unroll 1
                for (int bi = 0; bi < 8; ++bi) {
                    const int r0 = rowbase + 2 * bi, r = r0 + (wid >> 2), rs = min(max(r - 4, 0), R - 8);
                    const int rb2 = min(max(r0 + 2 - 4, 0), R - 8), hi2 = (bi < 7) ? min(rb2 + 8, R - 1) : hi;
                    const int nrow0 = min(hi + 1, R - 1), nrow1 = min(hi + 2, R - 1);
                    const bf16_t* s0 = kvbase + (size_t)(nrow0 * 64 + pcol) * NZ + pch * 8; const bf16_t* s1 = kvbase + (size_t)(nrow1 * 64 + pcol) * NZ + pch * 8;
                    const u32x4 pk0 = *(const u32x4*)(s0 + C_K), pv0 = *(const u32x4*)(s0 + C_V), pk1 = *(const u32x4*)(s1 + C_K), pv1 = *(const u32x4*)(s1 + C_V);
                    bf16_t* trow2 = trow + (size_t)(bi < 7 ? 128 : 0) * NZ;
                    const QG nxt = load_qg(trow2 + C_Q + h * 64, trow2 + C_GNA + h * 64, fq);
                    int krow[8]; { const int sl0 = rs % 9;
#pragma unroll
                        for (int kr = 0; kr < 8; ++kr) { int sl = sl0 + kr; sl = sl >= 9 ? sl - 9 : sl; krow[kr] = sl * 64 + c0; } }
                    attn16<true>(Kimg, Vimg, rpbs, krow, cur, trow + C_GNA + h * 64, fr, fq, lane, 16 * j + fr, c0, rs - r + 7);
                    __syncthreads();
                    if (hi + 1 <= hi2) { const int key = ((hi + 1) % 9) * 64 + pcol; *(LAS u32x4*)(Kimg + kv_off(key, pch)) = pk0; *(LAS u32x4*)(Vimg + kv_off(key, pch)) = pv0; }
                    if (hi + 2 <= hi2) { const int key = ((hi + 2) % 9) * 64 + pcol; *(LAS u32x4*)(Kimg + kv_off(key, pch)) = pk1; *(LAS u32x4*)(Vimg + kv_off(key, pch)) = pv1; }
                    __syncthreads();
                    hi = hi2; cur = nxt; trow = trow2;
                }
            }
        }
        {
            LAS unsigned char* Kimg = lds; LAS unsigned char* Vimg = lds + 256 * 128;
            constexpr int NITEMS = 512;
            int krow[8];
#pragma unroll
            for (int kr = 0; kr < 8; ++kr) krow[kr] = kr * 32;
            for (int it = blk; it < NITEMS; it += G) {
                int q, h, ck;
                if (it < 256) { ck = it & 7; h = (it >> 3) & 3; q = it >> 5; } else { const int i2 = it - 256; ck = i2 & 3; h = (i2 >> 2) & 3; q = 8 + (i2 >> 4); }
                const int tok0 = seq_base(q) + ck * 1024;
                __syncthreads();
                for (int c = tid; c < 256 * 8; c += NTHREADS) { const int key = c >> 3, ch = c & 7; const bf16_t* src = kvmem + (size_t)(q * 256 + key) * 512 + h * 64 + ch * 8;
                    *(LAS u32x4*)(Kimg + kv_off(key, ch)) = *(const u32x4*)(src); *(LAS u32x4*)(Vimg + kv_off(key, ch)) = *(const u32x4*)(src + 256); }
                bf16_t* trow = z1 + (size_t)(tok0 + wid * 128 + fr) * NZ;
                QG cur = load_qg(trow + C_QCA + h * 64, trow + C_GCA + h * 64, fq);
                __syncthreads();
#pragma unroll 1
                for (int i = 0; i < 8; ++i) { bf16_t* trow2 = trow + (size_t)(i < 7 ? 16 : 0) * NZ;
                    const QG nxt = load_qg(trow2 + C_QCA + h * 64, trow2 + C_GCA + h * 64, fq);
                    attn16<false>(Kimg, Vimg, nullptr, krow, cur, trow + C_GCA + h * 64, fr, fq, lane, 0, 0, 0);
                    cur = nxt; trow = trow2; }
            }
        }
        for (int rep_ = 0; rep_ < REPS(7); ++rep_)
        {
            constexpr int US = 784;
            constexpr int NITEMS = 2048;
            bf16x8 af[8][2];
#pragma unroll
            for (int mb = 0; mb < 8; ++mb)
#pragma unroll
                for (int ks = 0; ks < 2; ++ks) af[mb][ks] = *(const bf16x8*)(tab64 + (mb >> 2) * 4096 + ((mb & 3) * 16 + fr) * 64 + 32 * ks + 8 * fq);
            const int q4 = (lane & 15) >> 2, p4 = lane & 3;
            for (int it = blk; it < NITEMS; it += G) {
                int q, n2, N2, S;
                if (it < 1024) { q = it >> 7; n2 = it & 127; N2 = 128; S = 8192; } else { const int i2 = it - 1024; q = 8 + (i2 >> 6); n2 = i2 & 63; N2 = 64; S = 4096; }
                const int sb = seq_base(q);
                __syncthreads();
                for (int c = tid; c < 64 * 48; c += NTHREADS) { const int n1 = c / 48, ch = c % 48;
                    *(LAS u32x4*)(lds + n1 * US + ch * 16) = *(const u32x4*)(z1 + (size_t)(sb + N2 * n1 + n2) * NZ + C_UF + ch * 8); }
                __syncthreads();
                const float invS = 1.0f / (float)S;
#pragma unroll 1
                for (int cc = 0; cc < 3; ++cc) {
                    const int c = wid * 3 + cc;
                    bf16x8 bfr[2];
#pragma unroll
                    for (int ks = 0; ks < 2; ++ks) { LAS unsigned char* p = lds + (32 * ks + 8 * fq + q4) * US + (16 * c + 4 * p4) * 2; bfr[ks] = cat4(tr_read(p), tr_read(p + 4 * US)); }
                    f32x4 acc[8];
#pragma unroll
                    for (int mb = 0; mb < 8; ++mb) { f32x4 v = (f32x4){0.f, 0.f, 0.f, 0.f}; v = mfma16(af[mb][0], bfr[0], v); v = mfma16(af[mb][1], bfr[1], v); acc[mb] = v; }
                    const int ch = 16 * c + fr, grp = ch / 96, mm = ch - grp * 96;
#pragma unroll
                    for (int mb = 0; mb < 4; ++mb)
#pragma unroll
                        for (int i = 0; i < 4; ++i) { const int k1 = mb * 16 + 4 * fq + i; const float f = (float)((n2 * k1) & (S - 1)) * invS; const float cs = cosrev(f), sn = sinrev(f);
                            const float tr = acc[mb][i], ti = acc[mb + 4][i]; bf16_t* dst = T2 + (size_t)(sb + k1 * N2 + n2) * 768 + grp * 192 + mm;
                            dst[0] = f2bf(tr * cs + ti * sn); dst[96] = f2bf(ti * cs - tr * sn); }
                }
            }
        }
    }
    SEAM(2);

    if (IN(3)) {
        PHASE_LANES;
        constexpr int TS = 400;
        constexpr int NITEMS = 4096;
        const int q4 = (lane & 15) >> 2, p4 = lane & 3;
#define FC_DECODE(IT, BIG, Q, K1, GG, SB) const bool BIG = (IT) < 2048; const int GG = BIG ? ((IT) & 3) : (((IT) - 2048) & 1), K1 = BIG ? (((IT) >> 2) & 63) : ((((IT) - 2048) >> 1) & 63), \
        Q = BIG ? ((IT) >> 8) : (8 + (((IT) - 2048) >> 7)), SB = seq_base(Q)
#define FC_LOAD_TILE(DST, BIG, K1, GG, SB) do { _Pragma("unroll") for (int i_ = 0; i_ < 6; ++i_) { const int c_ = tid + NTHREADS * i_, rr_ = c_ / 24, ch_ = c_ - rr_ * 24; \
        const size_t row_ = BIG ? (size_t)(SB + K1 * 128 + rr_) : (size_t)(SB + K1 * 64 + (rr_ & 63)); const int gcol_ = BIG ? GG * 192 : (2 * GG + (rr_ >> 6)) * 192; \
        DST[i_] = *(const u32x4*)(T2 + row_ * 768 + gcol_ + ch_ * 8); } } while (0)
#define FC_STORE_TILE(SRC) do { _Pragma("unroll") for (int i_ = 0; i_ < 6; ++i_) { const int c_ = tid + NTHREADS * i_, rr_ = c_ / 24, ch_ = c_ - rr_ * 24; *(LAS u32x4*)(lds + rr_ * TS + ch_ * 16) = SRC[i_]; } } while (0)
#define FC_GATE_ROW(BIG, K1, GG, SB) (z1 + (size_t)(SB + K1 + 64 * (16 * (BIG ? wid : (wid & 3)) + fr)) * NZ + C_GF + (BIG ? GG : 2 * GG + (wid >> 2)) * 96 + 4 * fq)
        constexpr int TC_OFF = 128 * TS;
        for (int c = tid; c < 2 * 9216 / 8; c += NTHREADS) *(LAS u32x4*)(lds + TC_OFF + c * 16) = *(const u32x4*)(tabC + c * 8);
        bf16x8 wfr[4][3];
        int wmode = -1;
        u32x4 pre[6]; u32x2 gcur[6];
        int it = blk;
        if (it < NITEMS) { FC_DECODE(it, big0, q0_, k10, g0_, sb0); FC_LOAD_TILE(pre, big0, k10, g0_, sb0); const bf16_t* gr = FC_GATE_ROW(big0, k10, g0_, sb0);
#pragma unroll
            for (int lb = 0; lb < 6; ++lb) gcur[lb] = *(const u32x2*)(gr + 16 * lb);
            __syncthreads(); FC_STORE_TILE(pre); __syncthreads(); }
        for (; it < NITEMS; it += G) {
            FC_DECODE(it, big, q, k1, gg, sb);
            const int nit = it + G; const bool hasn = nit < NITEMS; const int nit_c = hasn ? nit : it;
            FC_DECODE(nit_c, bign, qn, k1n, ggn, sbn);
            u32x2 gnx[6];
            FC_LOAD_TILE(pre, bign, k1n, ggn, sbn);
            { const bf16_t* gr = FC_GATE_ROW(bign, k1n, ggn, sbn);
#pragma unroll
              for (int lb = 0; lb < 6; ++lb) gnx[lb] = *(const u32x2*)(gr + 16 * lb); }
            const int N2 = big ? 128 : 64, S = big ? 8192 : 4096, kb2 = big ? wid : (wid & 3);
            LAS unsigned char* tile = big ? lds : lds + (wid >> 2) * 64 * TS;
            const int nks = N2 / 32;
            if (wmode != (int)big) { wmode = (int)big; const bf16_t* tab = big ? tab128 : tab64; const int tsz = N2 * N2;
#pragma unroll
                for (int ks = 0; ks < 4; ++ks) { const bf16_t* tp = tab + (16 * kb2 + fr) * N2 + 32 * (ks < nks ? ks : 0) + 8 * fq;
                    wfr[ks][0] = *(const bf16x8*)(tp); wfr[ks][1] = *(const bf16x8*)(tp + tsz); wfr[ks][2] = *(const bf16x8*)(tp + 2 * tsz); } }
            f32x4 zr[6], zi[6];
#pragma unroll
            for (int cb = 0; cb < 6; ++cb) { zr[cb] = (f32x4){0.f, 0.f, 0.f, 0.f}; zi[cb] = (f32x4){0.f, 0.f, 0.f, 0.f}; }
#pragma unroll
            for (int ks = 0; ks < 4; ++ks) if (ks < nks) {
                const bf16x8 wre = wfr[ks][0], wim = wfr[ks][1], wni = wfr[ks][2];
                LAS unsigned char* rowp = tile + (32 * ks + 8 * fq + q4) * TS + 8 * p4;
#pragma unroll
                for (int cb = 0; cb < 6; ++cb) {
                    const bf16x8 trf = cat4(tr_read(rowp + 32 * cb), tr_read(rowp + 32 * cb + 4 * TS));
                    const bf16x8 tif = cat4(tr_read(rowp + 192 + 32 * cb), tr_read(rowp + 192 + 32 * cb + 4 * TS));
                    zr[cb] = mfma16(trf, wre, zr[cb]); zr[cb] = mfma16(tif, wni, zr[cb]);
                    zi[cb] = mfma16(tif, wre, zi[cb]); zi[cb] = mfma16(trf, wim, zi[cb]);
                }
            }
            bf16x8 zfr[3], zfi[3];
#pragma unroll
            for (int s_ = 0; s_ < 3; ++s_) { zfr[s_] = pack8(zr[2 * s_], zr[2 * s_ + 1]); zfi[s_] = pack8(zi[2 * s_], zi[2 * s_ + 1]); }
            const float scale = 1.0f / sqrtf((float)S * 96.0f);
            bf16_t* trow = (bf16_t*)FC_GATE_ROW(big, k1, gg, sb);
#pragma unroll
            for (int lb = 0; lb < 6; ++lb) {
                f32x4 y = (f32x4){0.f, 0.f, 0.f, 0.f};
#pragma unroll
                for (int s_ = 0; s_ < 3; ++s_) { const LAS unsigned char* cp = lds + TC_OFF + ((16 * lb + fr) * 96 + 32 * s_ + 8 * fq) * 2;
                    y = mfma16(*(const LAS bf16x8*)cp, zfr[s_], y); y = mfma16(*(const LAS bf16x8*)(cp + 9216 * 2), zfi[s_], y); }
                const u32x2 gv = gcur[lb]; u32x2 w;
                w.x = cvt_pk_bf16(y[0] * scale * siluf_(bf_lo(gv.x)), y[1] * scale * siluf_(bf_hi(gv.x)));
                w.y = cvt_pk_bf16(y[2] * scale * siluf_(bf_lo(gv.y)), y[3] * scale * siluf_(bf_hi(gv.y)));
                *(u32x2*)(trow + 16 * lb) = w;
            }
            __syncthreads();
            if (hasn) FC_STORE_TILE(pre);
            __syncthreads();
#pragma unroll
            for (int lb = 0; lb < 6; ++lb) gcur[lb] = gnx[lb];
        }
#undef FC_DECODE
#undef FC_LOAD_TILE
#undef FC_STORE_TILE
#undef FC_GATE_ROW
    }
    SEAM(3);

    if (IN(4)) {
        MergeStream S; S.so.init(T, D, G, blk, REPS(4)); S.hb = (const char*)hb; S.z1 = (const char*)z1; S.win = (const char*)WinT; S.wfo = (const char*)WfoT; S.wna = (const char*)WnaT; S.wca = (const char*)WcaT;
        EpiMerge E{ob + OUT_T2 + (size_t)blk * (3 * 16 * 8192), merged};
        pg8::gemm_stream<6>(lds, S, E);
    }
    SEAM(4);

    if (IN(5)) {
        PlainStream S; S.so.init(T, D, G, blk, REPS(5)); S.A = (const char*)merged; S.B = (const char*)WoutT; S.lda = D * 2; S.ldb = D * 2; S.nt = 16;
        EpiResid E{a.xp, a.xs, a.out, rowss, (unsigned*)(ws + WS_CNT), a.g_final, (FUSE_NORM && G == 256 && REPS(5) == 1) ? 1 : 0};
        pg8::gemm_stream<1>(lds, S, E);
    }
    SEAM(5);

    if (IN(6) && !(FUSE_NORM && G == 256 && REPS(5) == 1)) {
        PHASE_LANES;
        const int gw = blk * 8 + wid, NGW = G * 8;
        for (int m4 = gw; m4 < T / 4; m4 += NGW) {
            f32x4 v[4][4]; float rs_[4];
#pragma unroll
            for (int r = 0; r < 4; ++r) { const int m = 4 * m4 + r; const f32x4* yr = (const f32x4*)(a.out + (size_t)m * D) + lane;
#pragma unroll
                for (int j = 0; j < 4; ++j) v[r][j] = yr[64 * j];
                rs_[r] = lane < 16 ? rowss[(size_t)m * 16 + lane] : 0.f; }
#pragma unroll
            for (int r = 0; r < 4; ++r) rs_[r] = 1.0f / sqrtf(wave_sum(rs_[r]) * (1.0f / D) + EPS);
            const f32x4* gr = (const f32x4*)a.g_final + lane;
#pragma unroll
            for (int j = 0; j < 4; ++j) { const f32x4 gv = gr[64 * j];
#pragma unroll
                for (int r = 0; r < 4; ++r) ((f32x4*)(a.out + (size_t)(4 * m4 + r) * D) + lane)[64 * j] = v[r][j] * rs_[r] * gv; }
        }
    }
}

extern "C" void kernel_launch(void* const* d_in, const int* in_sizes, int n_in, void* d_out, int out_size, void* d_ws, size_t ws_size, hipStream_t stream) {
    static int grid = 0;
    if (grid == 0) {
        if (n_in != 14 || out_size != T * D || ws_size < WS_END) { fprintf(stderr, "kernel_launch: unexpected sizes (n_in %d out %d ws %zu, need ws >= %zu)\n", n_in, out_size, ws_size, (size_t)WS_END); grid = -1; return; }
        int dev = 0, cus = 0, per_cu = 0;
        if (hipGetDevice(&dev) != hipSuccess || hipDeviceGetAttribute(&cus, hipDeviceAttributeMultiprocessorCount, dev) != hipSuccess) { grid = -1; return; }
        if (hipFuncSetAttribute((const void*)mk_fwd, hipFuncAttributeMaxDynamicSharedMemorySize, LDS_BYTES) != hipSuccess) { fprintf(stderr, "kernel_launch: hipFuncSetAttribute failed\n"); grid = -1; return; }
        if (hipOccupancyMaxActiveBlocksPerMultiprocessor(&per_cu, (const void*)mk_fwd, NTHREADS, LDS_BYTES) != hipSuccess || per_cu < 1) { fprintf(stderr, "kernel_launch: occupancy query says %d blocks per CU\n", per_cu); grid = -1; return; }
        grid = cus;
    }
    if (grid < 0) return;
    Args a{};
    a.xp = (const float*)d_in[0]; a.xs = (const float*)d_in[1]; a.memp = (const float*)d_in[2]; a.mems = (const float*)d_in[3]; a.g_norm = (const float*)d_in[4];
    a.w_in = (const float*)d_in[5]; a.rpb = (const float*)d_in[6]; a.g_mem = (const float*)d_in[7]; a.w_kv = (const float*)d_in[8]; a.w_fo = (const float*)d_in[9];
    a.w_na = (const float*)d_in[10]; a.w_ca = (const float*)d_in[11]; a.w_out = (const float*)d_in[12]; a.g_final = (const float*)d_in[13];
    a.out = (float*)d_out; a.ws = (unsigned char*)d_ws;
    if (hipMemsetAsync((char*)d_ws + WS_BAR, 0, XCD_BAR_WORDS * 4, stream) != hipSuccess) { fprintf(stderr, "kernel_launch: hipMemsetAsync of the barrier words failed\n"); return; }
#if MK_N_LAUNCHES == 1
    a.ph_lo = 0; a.ph_hi = NPHASES;
    { void* args[] = {&a}; hipError_t e = hipLaunchCooperativeKernel((const void*)mk_fwd, dim3(grid), dim3(NTHREADS), args, LDS_BYTES, stream);
      if (e != hipSuccess) fprintf(stderr, "kernel_launch: cooperative launch failed: %s\n", hipGetErrorString(e)); }
#else
    for (int p = 0; p < NPHASES; ++p) { a.ph_lo = p; a.ph_hi = p + 1; void* args[] = {&a};
        hipError_t e = hipLaunchCooperativeKernel((const void*)mk_fwd, dim3(grid), dim3(NTHREADS), args, LDS_BYTES, stream);
        if (e != hipSuccess) { fprintf(stderr, "kernel_launch: launch %d failed: %s\n", p, hipGetErrorString(e)); break; } }
#endif
}
```

```cpp
#include <hip/hip_runtime.h>
#include <hip/hip_cooperative_groups.h>
#include <cstdio>
#include <cstdint>
namespace cg = cooperative_groups;

#ifndef FUSE_NORM
#define FUSE_NORM 0
#endif
#ifndef MK_N_LAUNCHES
#define MK_N_LAUNCHES 1
#endif

#define LAS __attribute__((address_space(3)))
#define GAS __attribute__((address_space(1)))
typedef unsigned short bf16_t;
typedef short bf16x8 __attribute__((ext_vector_type(8)));
typedef short s16x4 __attribute__((ext_vector_type(4)));
typedef float f32x4 __attribute__((ext_vector_type(4)));
typedef unsigned u32x4 __attribute__((ext_vector_type(4)));
typedef unsigned u32x2 __attribute__((ext_vector_type(2)));

constexpr int D = 1024, T = 131072, TP = 65536, NZ = 2816, NIN = 5888, NMEMROWS = 6144;
constexpr int C_UF = 0, C_GF = 384, C_Q = 768, C_K = 1152, C_V = 1536, C_GNA = 1920, C_QCA = 2304, C_GCA = 2560;
constexpr float EPS = 1e-6f;
constexpr int NPHASES = 7;
constexpr int LDS_BYTES = 153600;
constexpr int NTHREADS = 512;

constexpr size_t WS_Z1 = 0;
constexpr size_t WS_MERGED = WS_Z1 + (size_t)T * NZ * 2;
constexpr size_t WS_WIN = WS_MERGED + (size_t)T * D * 2;
constexpr size_t WS_WKV = WS_WIN + (size_t)NIN * D * 2;
constexpr size_t WS_WFO = WS_WKV + (size_t)512 * D * 2;
constexpr size_t WS_WNA = WS_WFO + (size_t)D * 384 * 2;
constexpr size_t WS_WCA = WS_WNA + (size_t)D * 384 * 2;
constexpr size_t WS_WOUT = WS_WCA + (size_t)D * 256 * 2;
constexpr size_t WS_KVMEM = WS_WOUT + (size_t)D * D * 2;
constexpr size_t WS_MEMN = WS_KVMEM + (size_t)NMEMROWS * 512 * 2;
constexpr size_t WS_ROWSS = WS_MEMN + (size_t)NMEMROWS * D * 2;
constexpr size_t WS_TAB64 = WS_ROWSS + (size_t)T * 16 * 4;
constexpr size_t WS_TAB128 = WS_TAB64 + 3 * 64 * 64 * 2;
constexpr size_t WS_TABC = WS_TAB128 + 3 * 128 * 128 * 2;
constexpr size_t WS_CNT = (WS_TABC + 2 * 96 * 96 * 2 + 255) / 256 * 256;
constexpr size_t WS_BAR = WS_CNT + 512 * 256;
constexpr size_t WS_END = WS_BAR + 3456 * 4;
constexpr size_t OUT_HB = 0;
constexpr size_t OUT_T2 = (size_t)T * D * 2;
constexpr size_t OUT_END = OUT_T2 + (size_t)T * 768 * 2;
static_assert(OUT_END <= (size_t)T * D * 4, "d_out scratch");

struct Args {
    const float *xp, *xs, *memp, *mems, *g_norm, *w_in, *rpb, *g_mem, *w_kv, *w_fo, *w_na, *w_ca, *w_out, *g_final;
    float* out; unsigned char* ws; int ph_lo, ph_hi;
};

typedef __bf16 bf16v2 __attribute__((ext_vector_type(2)));
typedef float f32x2 __attribute__((ext_vector_type(2)));
__device__ __forceinline__ unsigned cvt_pk_bf16(float lo, float hi) { const f32x2 v = {lo, hi}; return __builtin_bit_cast(unsigned, __builtin_convertvector(v, bf16v2)); }
__device__ __forceinline__ float bf_lo(unsigned w) { return __uint_as_float(w << 16); }
__device__ __forceinline__ float bf_hi(unsigned w) { return __uint_as_float(w & 0xffff0000u); }
__device__ __forceinline__ float wave_sum(float v) {
#pragma unroll
    for (int o = 1; o < 64; o <<= 1) v += __shfl_xor(v, o);
    return v;
}
__device__ __forceinline__ float sigmoidf_(float x) { return __builtin_amdgcn_rcpf(1.0f + __expf(-x)); }
__device__ __forceinline__ float siluf_(float x) { return x * sigmoidf_(x); }
__device__ __forceinline__ int seq_base(int q) { return q < 8 ? q * 8192 : TP + (q - 8) * 4096; }
__device__ __forceinline__ f32x4 mfma16(bf16x8 a, bf16x8 b, f32x4 c) { return __builtin_amdgcn_mfma_f32_16x16x32_bf16(a, b, c, 0, 0, 0); }
__device__ __forceinline__ bf16x8 cat4(s16x4 a, s16x4 b) { return __builtin_shufflevector(a, b, 0, 1, 2, 3, 4, 5, 6, 7); }
__device__ __forceinline__ s16x4 tr_read(LAS unsigned char* p) { return __builtin_amdgcn_ds_read_tr16_b64_v4i16((LAS s16x4*)p); }
__device__ __forceinline__ bf16x8 pack8(f32x4 a, f32x4 b) {
    u32x4 p; p.x = cvt_pk_bf16(a[0], a[1]); p.y = cvt_pk_bf16(a[2], a[3]); p.z = cvt_pk_bf16(b[0], b[1]); p.w = cvt_pk_bf16(b[2], b[3]);
    return __builtin_bit_cast(bf16x8, p);
}

namespace pg8 {
constexpr int BM = 256, BK = 64, HALF = 128, HTB = HALF * BK * 2, STAGE_BYTES = 8 * HTB, NXCD = 8, WGM = 8;
__device__ __forceinline__ int lds_byte(int r, int c) { const int st = (r >> 4) * 2 + (c >> 5), rr = r & 15, cc = c & 31, ob = rr * 64 + cc * 2; return st * 1024 + (ob ^ (((ob >> 9) & 1) << 5)); }
__device__ __forceinline__ void stage_rc(int b, int& R, int& C) { const int st = b / 1024, sb = b % 1024, swz = sb ^ (((sb >> 9) & 1) << 5); R = (st >> 1) * 16 + swz / 64; C = (st & 1) * 32 + (swz % 64) / 2; }
__device__ __forceinline__ int perm32(int rho) { const int n = rho >> 4, i = rho & 15; return 8 * (i >> 2) + 4 * n + (i & 3); }

struct Unit { int pm, pn; };
struct StaticOrder {
    int nM, nN, nwg, G, c, rep;
    __device__ void init(int M, int N, int G_, int c_, int rep_ = 1) { nM = M / BM; nN = N / BM; nwg = nM * nN; G = G_; c = c_; rep = rep_; }
    __device__ bool next(int i, Unit& u) const {
        long L = (long)i * G + c; if (L >= (long)nwg * rep) return false;
        L %= nwg;
        int wgid = (int)L; { const int q = nwg / NXCD, r = nwg % NXCD, xcd = wgid % NXCD, off = wgid / NXCD; wgid = (xcd < r ? xcd * (q + 1) : r * (q + 1) + (xcd - r) * q) + off; }
        const int nig = WGM * nN, gid = wgid / nig, fm = gid * WGM, gsz = (nM - fm) < WGM ? (nM - fm) : WGM;
        u.pm = fm + ((wgid % nig) % gsz); u.pn = (wgid % nig) / gsz; return true;
    }
};
struct Seg { const char* A; const char* B; unsigned lda, ldb; int nt, kind, pm, pn; };

template <int NSEG, class Epi, class Stream>
__device__ __forceinline__ void gemm_stream(LAS unsigned char* lds, const Stream& S, const Epi& E) {
    const int tid = threadIdx.x, wid = __builtin_amdgcn_readfirstlane(tid >> 6), lane = tid & 63, wr = wid >> 2, wc = wid & 3, fr = lane & 15, fq = lane >> 4;
    unsigned Ra0, Rb0, Cc0;
    { int R, C; stage_rc(tid * 16, R, C); Ra0 = (unsigned)R; Rb0 = (unsigned)(Epi::PERM ? ((R & ~31) + perm32(R & 31)) : R); Cc0 = (unsigned)C * 2u; }
    const size_t kstep = (size_t)(BK * 2);
    const unsigned ldsw = (unsigned)wid * 1024u;
    const int aoff = lds_byte(wr * 64 + fr, fq * 8), boff = lds_byte(wc * 32 + fr, fq * 8);
#define PG8_SA(b, h) (((b) * 2 + (h)) * HTB)
#define PG8_SB(b, h) ((4 + (b) * 2 + (h)) * HTB)
#define PG8_STAGE(bufoff, gbase, v0, ld) do { \
        __builtin_amdgcn_global_load_lds((const unsigned*)((const char*)(gbase) + (v0)), (LAS unsigned*)(lds + (bufoff) + ldsw), 16, 0, 0); \
        __builtin_amdgcn_global_load_lds((const unsigned*)((const char*)(gbase) + (size_t)64 * (ld) + (v0)), (LAS unsigned*)(lds + (bufoff) + ldsw + 8192), 16, 0, 0); } while (0)
#define PG8_LDA(dst, b, h) do { _Pragma("unroll") for (int m = 0; m < 4; ++m) _Pragma("unroll") for (int k = 0; k < 2; ++k) dst[m][k] = *(const LAS bf16x8*)(lds + PG8_SA(b, h) + aoff + m * 2048 + k * 1024); } while (0)
#define PG8_LDB(dst, b, h) do { _Pragma("unroll") for (int n = 0; n < 2; ++n) _Pragma("unroll") for (int k = 0; k < 2; ++k) dst[n][k] = *(const LAS bf16x8*)(lds + PG8_SB(b, h) + boff + n * 2048 + k * 1024); } while (0)
#define PG8_MMA(ai, bj, At, Bt) do { __builtin_amdgcn_s_setprio(1); _Pragma("unroll") for (int m = 0; m < 4; ++m) _Pragma("unroll") for (int n = 0; n < 2; ++n) _Pragma("unroll") for (int k = 0; k < 2; ++k) \
        acc[ai][bj][m][n] = __builtin_amdgcn_mfma_f32_16x16x32_bf16(Bt[n][k], At[m][k], acc[ai][bj][m][n], 0, 0, 0); __builtin_amdgcn_s_setprio(0); } while (0)
#define PG8_WAIT_V(n) asm volatile("s_waitcnt vmcnt(" #n ")" ::: "memory")
#define PG8_WAIT_L(n) asm volatile("s_waitcnt lgkmcnt(" #n ")" ::: "memory")
#define PG8_BAR __builtin_amdgcn_s_barrier()
#define PG8_SCHED __builtin_amdgcn_sched_barrier(0)
#define PG8_ZERO() do { _Pragma("unroll") for (int a_ = 0; a_ < 2; ++a_) _Pragma("unroll") for (int b_ = 0; b_ < 2; ++b_) _Pragma("unroll") for (int m_ = 0; m_ < 4; ++m_) _Pragma("unroll") for (int n_ = 0; n_ < 2; ++n_) \
        acc[a_][b_][m_][n_] = (f32x4){0.f, 0.f, 0.f, 0.f}; } while (0)
    Seg cur, nxt; int ui = 0;
    if (!S.template seg<0>(0, cur)) return;
    f32x4 acc[2][2][4][2];
    PG8_ZERO();
    bf16x8 At[4][2], B0[2][2], B1[2][2];
    const char* cA = cur.A; const char* cB = cur.B;
    unsigned vAc0 = Ra0 * cur.lda + Cc0, vBc0 = Rb0 * cur.ldb + Cc0, ldAc = cur.lda, ldBc = cur.ldb;
    size_t hAc = (size_t)HALF * cur.lda, hBc = (size_t)HALF * cur.ldb;
    PG8_STAGE(PG8_SB(0, 0), cB, vBc0, ldBc); PG8_STAGE(PG8_SA(0, 0), cA, vAc0, ldAc); PG8_STAGE(PG8_SB(0, 1), cB + hBc, vBc0, ldBc); PG8_STAGE(PG8_SA(0, 1), cA + hAc, vAc0, ldAc);
    if (wr == 1) PG8_BAR;
    PG8_WAIT_V(4); PG8_BAR;
    PG8_STAGE(PG8_SB(1, 0), cB + kstep, vBc0, ldBc); PG8_STAGE(PG8_SA(1, 0), cA + kstep, vAc0, ldAc); PG8_STAGE(PG8_SB(1, 1), cB + hBc + kstep, vBc0, ldBc);
    PG8_WAIT_V(6); PG8_BAR;
#define PG8_SEG(KK) if constexpr (NSEG > (KK)) { \
        bool has_next; if constexpr ((KK) + 1 < NSEG) { S.template seg<((KK) + 1 < NSEG ? (KK) + 1 : 0)>(ui, nxt); has_next = true; } else has_next = S.template seg<0>(ui + 1, nxt); \
        if (!has_next) nxt = cur;     \
        const char* nA = nxt.A; const char* nB = nxt.B; \
        const unsigned vAn0 = Ra0 * nxt.lda + Cc0, vBn0 = Rb0 * nxt.ldb + Cc0, ldAn = nxt.lda, ldBn = nxt.ldb; \
        const size_t hAn = (size_t)HALF * nxt.lda, hBn = (size_t)HALF * nxt.ldb; \
        const int nt = cur.nt; \
        for (int t = 0; t < nt; t += 2) { \
            const bool last = (t == nt - 2); \
            const char* a1 = cA + (size_t)(t + 1) * kstep; \
            const char* a2 = last ? nA : cA + (size_t)(t + 2) * kstep; const char* b2 = last ? nB : cB + (size_t)(t + 2) * kstep; \
            const char* a3 = a2 + kstep; const char* b3 = b2 + kstep; \
            const unsigned vA0 = last ? vAn0 : vAc0, vB0 = last ? vBn0 : vBc0, lA2 = last ? ldAn : ldAc, lB2 = last ? ldBn : ldBc; \
            const size_t hA2 = last ? hAn : hAc, hB2 = last ? hBn : hBc; \
            PG8_LDB(B0, 0, 0); PG8_SCHED; PG8_LDA(At, 0, 0); PG8_STAGE(PG8_SA(1, 1), a1 + hAc, vAc0, ldAc); \
            PG8_WAIT_L(8); PG8_BAR; PG8_WAIT_L(0); PG8_MMA(0, 0, At, B0); PG8_BAR; PG8_SCHED; \
            PG8_LDB(B1, 0, 1); PG8_STAGE(PG8_SB(0, 0), b2, vB0, lB2); \
            PG8_BAR; PG8_WAIT_L(0); PG8_MMA(0, 1, At, B1); PG8_BAR; \
            PG8_LDA(At, 0, 1); PG8_STAGE(PG8_SA(0, 0), a2, vA0, lA2); \
            PG8_BAR; PG8_WAIT_L(0); PG8_MMA(1, 0, At, B0); PG8_BAR; PG8_SCHED; \
            PG8_STAGE(PG8_SB(0, 1), b2 + hB2, vB0, lB2); \
            PG8_WAIT_V(6); PG8_BAR; PG8_MMA(1, 1, At, B1); PG8_BAR; \
            PG8_LDB(B0, 1, 0); PG8_SCHED; PG8_LDA(At, 1, 0); PG8_STAGE(PG8_SA(0, 1), a2 + hA2, vA0, lA2); \
            PG8_WAIT_L(8); PG8_BAR; PG8_WAIT_L(0); PG8_MMA(0, 0, At, B0); PG8_BAR; PG8_SCHED; \
            PG8_LDB(B1, 1, 1); PG8_STAGE(PG8_SB(1, 0), b3, vB0, lB2); \
            PG8_BAR; PG8_WAIT_L(0); PG8_MMA(0, 1, At, B1); PG8_BAR; \
            PG8_LDA(At, 1, 1); PG8_STAGE(PG8_SA(1, 0), a3, vA0, lA2); \
            PG8_BAR; PG8_WAIT_L(0); PG8_MMA(1, 0, At, B0); PG8_BAR; PG8_SCHED; \
            PG8_STAGE(PG8_SB(1, 1), b3 + hB2, vB0, lB2); \
            PG8_WAIT_V(6); PG8_BAR; PG8_MMA(1, 1, At, B1); PG8_BAR; \
        } \
        E.template run<(KK)>(acc, cur, wr, wc, fr, fq, tid); \
        if (!has_next) break; \
        if constexpr (Epi::template zero_after<(KK)>()) PG8_ZERO(); \
        cur = nxt; cA = nA; cB = nB; vAc0 = vAn0; vBc0 = vBn0; ldAc = ldAn; ldBc = ldBn; hAc = hAn; hBc = hBn; }
    for (;;) {
        PG8_SEG(0) PG8_SEG(1) PG8_SEG(2) PG8_SEG(3) PG8_SEG(4) PG8_SEG(5)
        ++ui;
    }
    PG8_WAIT_V(0);
    if (wr == 0) PG8_BAR;
    PG8_BAR;
#undef PG8_SA
#undef PG8_SB
#undef PG8_STAGE
#undef PG8_LDA
#undef PG8_LDB
#undef PG8_MMA
#undef PG8_WAIT_V
#undef PG8_WAIT_L
#undef PG8_BAR
#undef PG8_SCHED
#undef PG8_ZERO
#undef PG8_SEG
}
}

struct PlainStream {
    pg8::StaticOrder so; const char* A; const char* B; unsigned lda, ldb; int nt;
    template <int KK> __device__ __forceinline__ bool seg(int i, pg8::Seg& s) const { pg8::Unit u; if (!so.next(i, u)) return false;
        s.A = A + (size_t)u.pm * 256 * lda; s.B = B + (size_t)u.pn * 256 * ldb; s.lda = lda; s.ldb = ldb; s.nt = nt; s.kind = 0; s.pm = u.pm; s.pn = u.pn; return true; }
};
struct EpiStoreBf16 {
    static constexpr bool PERM = true;
    bf16_t* O; int ldc;
    template <int KK> static constexpr bool zero_after() { return true; }
    template <int KK> __device__ __forceinline__ void run(f32x4 (&acc)[2][2][4][2], const pg8::Seg& u, int wr, int wc, int fr, int fq, int) const {
        const int row0 = u.pm * 256 + wr * 64 + fr, col0 = u.pn * 256 + wc * 32 + 8 * fq;
#pragma unroll
        for (int ai = 0; ai < 2; ++ai)
#pragma unroll
            for (int m = 0; m < 4; ++m) { bf16_t* rowp = O + (size_t)(row0 + ai * 128 + m * 16) * ldc + col0;
#pragma unroll
                for (int bj = 0; bj < 2; ++bj) { const f32x4 v0 = acc[ai][bj][m][0], v1 = acc[ai][bj][m][1];
                    u32x4 w; w.x = cvt_pk_bf16(v0[0], v0[1]); w.y = cvt_pk_bf16(v0[2], v0[3]); w.z = cvt_pk_bf16(v1[0], v1[1]); w.w = cvt_pk_bf16(v1[2], v1[3]);
                    *(u32x4*)(rowp + bj * 128) = w; } }
    }
};

struct MergeStream {
    pg8::StaticOrder so; const char *hb, *z1, *win, *wfo, *wna, *wca;
    template <int KK> __device__ __forceinline__ bool seg(int ui, pg8::Seg& s) const { pg8::Unit u; constexpr int k = KK; if (!so.next(ui, u)) return false;
        s.kind = k; s.pm = u.pm; s.pn = u.pn;
        if (k < 3) { s.A = hb + (size_t)u.pm * 256 * (D * 2); s.lda = D * 2; s.B = win + (size_t)(NZ + k * D + u.pn * 256) * (D * 2); s.ldb = D * 2; s.nt = 16; }
        else { s.lda = NZ * 2; const char* a = z1 + (size_t)u.pm * 256 * (NZ * 2);
            if (k == 3) { s.A = a + C_GF * 2; s.B = wfo + (size_t)u.pn * 256 * (384 * 2); s.ldb = 384 * 2; s.nt = 6; }
            else if (k == 4) { s.A = a + C_GNA * 2; s.B = wna + (size_t)u.pn * 256 * (384 * 2); s.ldb = 384 * 2; s.nt = 6; }
            else { s.A = a + C_GCA * 2; s.B = wca + (size_t)u.pn * 256 * (256 * 2); s.ldb = 256 * 2; s.nt = 4; } }
        return true; }
};
typedef _Float16 f16v2 __attribute__((ext_vector_type(2)));
__device__ __forceinline__ unsigned pk_h2(float lo, float hi) { const f32x2 v = {lo, hi}; return __builtin_bit_cast(unsigned, __builtin_convertvector(v, f16v2)); }
__device__ __forceinline__ f32x2 un_h2(unsigned w) { return __builtin_convertvector(__builtin_bit_cast(f16v2, w), f32x2); }
struct EpiMerge {
    static constexpr bool PERM = true;
    unsigned char* stash; bf16_t* O;
    template <int KK> static constexpr bool zero_after() { return KK < 3 || KK == 5; }
    template <int KK> __device__ __forceinline__ void run(f32x4 (&acc)[2][2][4][2], const pg8::Seg& u, int wr, int wc, int fr, int fq, int tid) const {
        constexpr int k = KK;
        GAS unsigned char* sbase = (GAS unsigned char*)stash + (size_t)tid * 16; asm volatile("" : "+v"(sbase));
        if constexpr (k < 3) {
            GAS u32x4* st = (GAS u32x4*)(sbase + (size_t)k * 16 * 8192);
#pragma unroll
            for (int j = 0; j < 16; ++j) { const f32x4 v0 = acc[j >> 3][(j >> 2) & 1][j & 3][0], v1 = acc[j >> 3][(j >> 2) & 1][j & 3][1]; u32x4 w;
                w.x = pk_h2(sigmoidf_(v0[0]), sigmoidf_(v0[1])); w.y = pk_h2(sigmoidf_(v0[2]), sigmoidf_(v0[3]));
                w.z = pk_h2(sigmoidf_(v1[0]), sigmoidf_(v1[1])); w.w = pk_h2(sigmoidf_(v1[2]), sigmoidf_(v1[3]));
                st[j * 512] = w; }
        } else if constexpr (k < 5) {
            const GAS u32x4* sa = (const GAS u32x4*)(sbase + (size_t)(k - 3) * 16 * 8192); const GAS u32x4* sb = (const GAS u32x4*)(sbase + (size_t)(k - 2) * 16 * 8192);
#pragma unroll
            for (int hb_ = 0; hb_ < 2; ++hb_) {
            u32x4 p[8], q[8];
#pragma unroll
            for (int j = 0; j < 8; ++j) { p[j] = sa[(hb_ * 8 + j) * 512]; q[j] = sb[(hb_ * 8 + j) * 512]; }
#pragma unroll
            for (int jj = 0; jj < 8; ++jj) { const int j = hb_ * 8 + jj; f32x4& v0 = acc[j >> 3][(j >> 2) & 1][j & 3][0]; f32x4& v1 = acc[j >> 3][(j >> 2) & 1][j & 3][1];
                const f32x2 p0 = un_h2(p[jj].x), p1 = un_h2(p[jj].y), p2 = un_h2(p[jj].z), p3 = un_h2(p[jj].w);
                const f32x2 q0 = un_h2(q[jj].x), q1 = un_h2(q[jj].y), q2 = un_h2(q[jj].z), q3 = un_h2(q[jj].w);
                v0[0] *= p0[0] * __builtin_amdgcn_rcpf(q0[0]); v0[1] *= p0[1] * __builtin_amdgcn_rcpf(q0[1]); v0[2] *= p1[0] * __builtin_amdgcn_rcpf(q1[0]); v0[3] *= p1[1] * __builtin_amdgcn_rcpf(q1[1]);
                v1[0] *= p2[0] * __builtin_amdgcn_rcpf(q2[0]); v1[1] *= p2[1] * __builtin_amdgcn_rcpf(q2[1]); v1[2] *= p3[0] * __builtin_amdgcn_rcpf(q3[0]); v1[3] *= p3[1] * __builtin_amdgcn_rcpf(q3[1]);
                asm volatile("" : "+v"(v0), "+v"(v1)); }
            asm volatile("" ::: "memory"); }
        } else {
            const GAS u32x4* sa = (const GAS u32x4*)(sbase + (size_t)2 * 16 * 8192);
            const int row0 = u.pm * 256 + wr * 64 + fr, col0 = u.pn * 256 + wc * 32 + 8 * fq;
            u32x4 p[16];
#pragma unroll
            for (int j = 0; j < 16; ++j) p[j] = sa[j * 512];
#pragma unroll
            for (int ai = 0; ai < 2; ++ai)
#pragma unroll
                for (int m = 0; m < 4; ++m) { bf16_t* rowp = O + (size_t)(row0 + ai * 128 + m * 16) * D + col0;
#pragma unroll
                    for (int bj = 0; bj < 2; ++bj) { const int j16 = (ai * 2 + bj) * 4 + m; const f32x4 v0 = acc[ai][bj][m][0], v1 = acc[ai][bj][m][1];
                        const f32x2 p0 = un_h2(p[j16].x), p1 = un_h2(p[j16].y), p2 = un_h2(p[j16].z), p3 = un_h2(p[j16].w);
                        u32x4 w; w.x = cvt_pk_bf16(v0[0] * p0[0], v0[1] * p0[1]); w.y = cvt_pk_bf16(v0[2] * p1[0], v0[3] * p1[1]);
                        w.z = cvt_pk_bf16(v1[0] * p2[0], v1[1] * p2[1]); w.w = cvt_pk_bf16(v1[2] * p3[0], v1[3] * p3[1]);
                        *(u32x4*)(rowp + bj * 128) = w; } }
        }
    }
};
struct EpiResid {
    static constexpr bool PERM = false;
    const float *xp, *xs; float* out; float* rowss; unsigned* cnt; const float* g_final; int fused;
    template <int KK> static constexpr bool zero_after() { return true; }
    template <int KK> __device__ __forceinline__ void run(f32x4 (&acc)[2][2][4][2], const pg8::Seg& u, int wr, int wc, int fr, int fq, int tid) const {
        const int row0 = u.pm * 256 + wr * 64 + fr, col0 = u.pn * 256 + wc * 32 + 4 * fq;
#pragma unroll
        for (int ai = 0; ai < 2; ++ai) {
            f32x4 xv[4][4];
#pragma unroll
            for (int m = 0; m < 4; ++m) { const int r = row0 + ai * 128 + m * 16; const float* xr = (r < TP ? xp + (size_t)r * D : xs + (size_t)(r - TP) * D) + col0;
#pragma unroll
                for (int bj = 0; bj < 2; ++bj)
#pragma unroll
                    for (int n = 0; n < 2; ++n) xv[m][bj * 2 + n] = *(const f32x4*)(xr + bj * 128 + n * 16); }
#pragma unroll
            for (int m = 0; m < 4; ++m) { const int r = row0 + ai * 128 + m * 16; float* orow = out + (size_t)r * D + col0; float ss = 0.f;
#pragma unroll
                for (int bj = 0; bj < 2; ++bj)
#pragma unroll
                    for (int n = 0; n < 2; ++n) { const f32x4 y = xv[m][bj * 2 + n] + acc[ai][bj][m][n]; acc[ai][bj][m][n] = y;
                        ss += (y[0] * y[0] + y[1] * y[1]) + (y[2] * y[2] + y[3] * y[3]); if (!fused) *(f32x4*)(orow + bj * 128 + n * 16) = y; }
                ss += __shfl_xor(ss, 16); ss += __shfl_xor(ss, 32);
                if (fq == 0) { float* slot = rowss + (size_t)r * 16 + u.pn * 4 + wc; if (fused) __hip_atomic_store(slot, ss, __ATOMIC_RELAXED, __HIP_MEMORY_SCOPE_AGENT); else *slot = ss; } }
            asm volatile("" ::: "memory"); }
        if (!fused) return;
        asm volatile("s_waitcnt vmcnt(0)" ::: "memory");
        unsigned* cw = cnt + 64 * u.pm + 16 * wr;
        if ((tid & 63) == 0) __hip_atomic_fetch_add(cw, 1u, __ATOMIC_RELAXED, __HIP_MEMORY_SCOPE_AGENT);
        { const unsigned long long t0 = __builtin_amdgcn_s_memrealtime();
          while ((unsigned)__builtin_amdgcn_readfirstlane(__hip_atomic_load(cw, __ATOMIC_RELAXED, __HIP_MEMORY_SCOPE_AGENT)) < 16u) {
              if (__builtin_amdgcn_s_memrealtime() - t0 > 2000000ull) break;
              __builtin_amdgcn_s_sleep(2); } }
        __builtin_amdgcn_fence(__ATOMIC_ACQUIRE, "agent");
        asm volatile("s_waitcnt vmcnt(0)" ::: "memory");
        unsigned long long pl[8][2];
#pragma unroll
        for (int ai = 0; ai < 2; ++ai)
#pragma unroll
            for (int m = 0; m < 4; ++m) { const int r = row0 + ai * 128 + m * 16; const unsigned long long* pp = (const unsigned long long*)(rowss + (size_t)r * 16 + fq * 4);
                pl[ai * 4 + m][0] = __hip_atomic_load(pp, __ATOMIC_RELAXED, __HIP_MEMORY_SCOPE_AGENT); pl[ai * 4 + m][1] = __hip_atomic_load(pp + 1, __ATOMIC_RELAXED, __HIP_MEMORY_SCOPE_AGENT); }
        f32x4 gf[4];
#pragma unroll
        for (int bj = 0; bj < 2; ++bj)
#pragma unroll
            for (int n = 0; n < 2; ++n) gf[bj * 2 + n] = *(const f32x4*)(g_final + col0 + bj * 128 + n * 16);
#pragma unroll
        for (int ai = 0; ai < 2; ++ai)
#pragma unroll
            for (int m = 0; m < 4; ++m) { const int r = row0 + ai * 128 + m * 16; float* orow = out + (size_t)r * D + col0;
                const unsigned long long w0 = pl[ai * 4 + m][0], w1 = pl[ai * 4 + m][1];
                float t = (__uint_as_float((unsigned)w0) + __uint_as_float((unsigned)(w0 >> 32))) + (__uint_as_float((unsigned)w1) + __uint_as_float((unsigned)(w1 >> 32)));
                t += __shfl_xor(t, 16); t += __shfl_xor(t, 32);
                const float rstd = 1.0f / sqrtf(t * (1.0f / D) + EPS);
#pragma unroll
                for (int bj = 0; bj < 2; ++bj)
#pragma unroll
                    for (int n = 0; n < 2; ++n) *(f32x4*)(orow + bj * 128 + n * 16) = acc[ai][bj][m][n] * rstd * gf[bj * 2 + n]; }
    }
};

__device__ __forceinline__ void p0_transpose_item(const float* W, int K, int N, bf16_t* WT, LAS float* scr, int item, int lane) {
    const int nblk = N / 32, kb = item / nblk, nb = item % nblk, k0 = 64 * kb, n0 = 32 * nb;
#pragma unroll 8
    for (int i = 0; i < 32; ++i) { const int kk = 2 * i + (lane >> 5); scr[kk * 33 + (lane & 31)] = W[(size_t)(k0 + kk) * N + n0 + (lane & 31)]; }
    asm volatile("s_waitcnt lgkmcnt(0)" ::: "memory");
    const int c = lane & 7;
#pragma unroll
    for (int j = 0; j < 4; ++j) { const int n = (lane >> 3) + 8 * j; const LAS float* s = scr + (8 * c) * 33 + n;
        u32x4 o; o.x = cvt_pk_bf16(s[0 * 33], s[1 * 33]); o.y = cvt_pk_bf16(s[2 * 33], s[3 * 33]); o.z = cvt_pk_bf16(s[4 * 33], s[5 * 33]); o.w = cvt_pk_bf16(s[6 * 33], s[7 * 33]);
        *(u32x4*)(WT + (size_t)(n0 + n) * K + k0 + 8 * c) = o; }
    asm volatile("s_waitcnt lgkmcnt(0)" ::: "memory");
}
__device__ __forceinline__ void rms_row_to_bf16(const float* xrow, const float* g, bf16_t* orow, int lane) {
    const f32x4* xr = (const f32x4*)xrow + lane; const f32x4* gr = (const f32x4*)g + lane;
    f32x4 v[4]; float s = 0.f;
#pragma unroll
    for (int j = 0; j < 4; ++j) { v[j] = xr[64 * j]; s += (v[j][0] * v[j][0] + v[j][1] * v[j][1]) + (v[j][2] * v[j][2] + v[j][3] * v[j][3]); }
    const float rstd = 1.0f / sqrtf(wave_sum(s) * (1.0f / D) + EPS);
    u32x2* o8 = (u32x2*)orow + lane;
#pragma unroll
    for (int j = 0; j < 4; ++j) { const f32x4 gv = gr[64 * j]; u32x2 w; w.x = cvt_pk_bf16(v[j][0] * rstd * gv[0], v[j][1] * rstd * gv[1]); w.y = cvt_pk_bf16(v[j][2] * rstd * gv[2], v[j][3] * rstd * gv[3]); o8[64 * j] = w; }
}
__device__ __forceinline__ void rms_rows4_to_bf16(const float* const (&xrow)[4], const float* g, bf16_t* const (&orow)[4], int lane) {
    f32x4 v[4][4]; float s[4];
#pragma unroll
    for (int r = 0; r < 4; ++r) { const f32x4* xr = (const f32x4*)xrow[r] + lane;
#pragma unroll
        for (int j = 0; j < 4; ++j) v[r][j] = xr[64 * j]; }
#pragma unroll
    for (int r = 0; r < 4; ++r) { float t = 0.f;
#pragma unroll
        for (int j = 0; j < 4; ++j) t += (v[r][j][0] * v[r][j][0] + v[r][j][1] * v[r][j][1]) + (v[r][j][2] * v[r][j][2] + v[r][j][3] * v[r][j][3]);
        s[r] = 1.0f / sqrtf(wave_sum(t) * (1.0f / D) + EPS); }
    const f32x4* gr = (const f32x4*)g + lane;
#pragma unroll
    for (int j = 0; j < 4; ++j) { const f32x4 gv = gr[64 * j];
#pragma unroll
        for (int r = 0; r < 4; ++r) { u32x2 w; w.x = cvt_pk_bf16(v[r][j][0] * s[r] * gv[0], v[r][j][1] * s[r] * gv[1]); w.y = cvt_pk_bf16(v[r][j][2] * s[r] * gv[2], v[r][j][3] * s[r] * gv[3]);
            ((u32x2*)orow[r] + lane)[64 * j] = w; } }
}
__device__ __forceinline__ unsigned short f2bf(float f) { return (unsigned short)(cvt_pk_bf16(f, 0.f) & 0xffffu); }
__device__ __forceinline__ float cosrev(float x) { return __builtin_amdgcn_cosf(x); }
__device__ __forceinline__ float sinrev(float x) { return __builtin_amdgcn_sinf(x); }

__device__ __forceinline__ unsigned kv_off(int key, int chunk) { return (unsigned)(key * 128 + ((chunk ^ (key & 7)) << 4)); }
struct QG { bf16x8 q0, q1; };
__device__ __forceinline__ QG load_qg(const bf16_t* qrow, const bf16_t*, int fq) {
    QG r; r.q0 = *(const bf16x8*)(qrow + 8 * fq); r.q1 = *(const bf16x8*)(qrow + 32 + 8 * fq);
    return r;
}
template <bool NA>
__device__ __forceinline__ void attn16(LAS unsigned char* Kimg, LAS unsigned char* Vimg, const LAS float* rpbs, const int (&krow)[8], const QG& in,
                                       bf16_t* gate_out  , int fr, int fq, int lane,
                                       int qcol, int c0, int drbase  ) {
    u32x2 gin[4];
#pragma unroll
    for (int db = 0; db < 4; ++db) gin[db] = *(const u32x2*)(gate_out + 16 * db + 4 * fq);
    const unsigned kl0 = (unsigned)(fr * 128 + ((fq ^ (fr & 7)) << 4)), kl1 = (unsigned)(fr * 128 + (((4 + fq) ^ (fr & 7)) << 4));
    f32x4 sacc[16];
#pragma unroll
    for (int kb = 0; kb < 16; ++kb) {
        LAS unsigned char* kp = Kimg + (krow[kb >> 1] + (kb & 1) * 16) * 128;
        f32x4 a = (f32x4){0.f, 0.f, 0.f, 0.f};
        a = mfma16(*(const LAS bf16x8*)(kp + kl0), in.q0, a);
        a = mfma16(*(const LAS bf16x8*)(kp + kl1), in.q1, a);
        sacc[kb] = a;
    }
    const float L2E = 1.4426950408889634f * 0.125f;
    float mx = -3.0e38f, sum = 0.f;
    if (NA) {
        const int cs = min(max(qcol - 8, 0), 48), relb = c0 + 4 * fq - cs;
        const LAS float* bp = rpbs + (drbase * 31 + c0 + 4 * fq - qcol + 15);
        bool valid[2][4];
#pragma unroll
        for (int hc = 0; hc < 2; ++hc)
#pragma unroll
            for (int i = 0; i < 4; ++i) valid[hc][i] = (unsigned)(relb + 16 * hc + i) < 16u;
#pragma unroll
        for (int kb = 0; kb < 16; ++kb)
#pragma unroll
            for (int i = 0; i < 4; ++i) { float sv = __builtin_fmaf(sacc[kb][i], L2E, bp[(kb >> 1) * 31 + 16 * (kb & 1) + i]); sv = valid[kb & 1][i] ? sv : -3.0e38f; sacc[kb][i] = sv; mx = fmaxf(mx, sv); }
        mx = fmaxf(mx, __shfl_xor(mx, 16)); mx = fmaxf(mx, __shfl_xor(mx, 32));
#pragma unroll
        for (int kb = 0; kb < 16; ++kb)
#pragma unroll
            for (int i = 0; i < 4; ++i) { const float p = __builtin_amdgcn_exp2f(sacc[kb][i] - mx); sacc[kb][i] = p; sum += p; }
    } else {
#pragma unroll
        for (int kb = 0; kb < 16; ++kb)
#pragma unroll
            for (int i = 0; i < 4; ++i) mx = fmaxf(mx, sacc[kb][i]);
        mx = fmaxf(mx, __shfl_xor(mx, 16)); mx = fmaxf(mx, __shfl_xor(mx, 32));
        const float mb = -mx * L2E;
#pragma unroll
        for (int kb = 0; kb < 16; ++kb)
#pragma unroll
            for (int i = 0; i < 4; ++i) { const float p = __builtin_amdgcn_exp2f(__builtin_fmaf(sacc[kb][i], L2E, mb)); sacc[kb][i] = p; sum += p; }
    }
    sum += __shfl_xor(sum, 16); sum += __shfl_xor(sum, 32);
    const float inv = 1.0f / sum;
    bf16x8 pf[8];
#pragma unroll
    for (int s = 0; s < 8; ++s) pf[s] = pack8(sacc[2 * s], sacc[2 * s + 1]);
    const int q4 = (lane & 15) >> 2, p4 = lane & 3, kl = 4 * fq + q4;
    unsigned vl[4];
#pragma unroll
    for (int db = 0; db < 4; ++db) vl[db] = (unsigned)(kl * 128 + (((2 * db + (p4 >> 1)) ^ (kl & 7)) << 4) + 8 * (p4 & 1));
    f32x4 oacc[4];
#pragma unroll
    for (int db = 0; db < 4; ++db) oacc[db] = (f32x4){0.f, 0.f, 0.f, 0.f};
#pragma unroll
    for (int s = 0; s < 8; ++s) {
        LAS unsigned char* vp = Vimg + krow[s] * 128;
#pragma unroll
        for (int db = 0; db < 4; ++db) {
            const s16x4 v0 = tr_read(vp + vl[db]);
            const s16x4 v1 = tr_read(vp + 2048 + vl[db]);
            oacc[db] = mfma16(cat4(v0, v1), pf[s], oacc[db]);
        }
        if (s & 1) __builtin_amdgcn_sched_barrier(0);
    }
#pragma unroll
    for (int db = 0; db < 4; ++db) { const u32x2 gv = gin[db]; u32x2 w;
        w.x = cvt_pk_bf16(oacc[db][0] * inv * siluf_(bf_lo(gv.x)), oacc[db][1] * inv * siluf_(bf_hi(gv.x)));
        w.y = cvt_pk_bf16(oacc[db][2] * inv * siluf_(bf_lo(gv.y)), oacc[db][3] * inv * siluf_(bf_hi(gv.y)));
        *(u32x2*)(gate_out + 16 * db + 4 * fq) = w; }
}

#define XB_TMO      128
#define XB_XCNT(j)  (256  + 64 * (j))
#define XB_XSUB(j)  (1280 + 64 * (j))
#define XB_XGEN(j)  (2304 + 64 * (j))
#define XB_TOP      3328
#define XB_TOPGEN   3392
#define XCD_BAR_WORDS 3456
#define XB_SPIN_CAP (1u << 18)
__device__ __forceinline__ unsigned xb_ld(unsigned* p)              { return __hip_atomic_load(p, __ATOMIC_RELAXED, __HIP_MEMORY_SCOPE_AGENT); }
__device__ __forceinline__ unsigned xb_add(unsigned* p, unsigned v) { return __hip_atomic_fetch_add(p, v, __ATOMIC_RELAXED, __HIP_MEMORY_SCOPE_AGENT); }
__device__ __forceinline__ unsigned xb_xcc_id() { return (unsigned)__builtin_amdgcn_s_getreg((3 << 11) | 20) & 0xFu; }
#define XB_SPIN(cond, bar) do { unsigned _sp = 0; while (cond) { __builtin_amdgcn_s_sleep(1); \
    if ((++_sp & 255u) == 0u) { if (xb_ld(&(bar)[XB_TMO])) break; if (_sp > XB_SPIN_CAP) { atomicAdd(&(bar)[XB_TMO], 1u); break; } } } } while (0)
struct XcdBarrier { unsigned* bar; unsigned x; volatile LAS unsigned* st; };
__device__ __forceinline__ XcdBarrier xcd_barrier_post(unsigned* bar, volatile LAS unsigned* st) {
    XcdBarrier b; b.bar = bar; b.x = xb_xcc_id(); b.st = st;
    if (threadIdx.x == 0) st[2] = xb_add(&bar[XB_XCNT(b.x)], 1u);
    return b;
}
__device__ __forceinline__ void xcd_barrier_complete(unsigned* bar, unsigned x, unsigned& nloc, unsigned& nx) {
    const unsigned G = gridDim.x * gridDim.y * gridDim.z;
    unsigned sum, cnt, mine, sp = 0u;
    for (;;) {
        sum = 0u; cnt = 0u; mine = 0u;
#pragma unroll
        for (unsigned j = 0; j < 16; ++j) { const unsigned c = xb_ld(&bar[XB_XCNT(j)]); sum += c; cnt += (c > 0u) ? 1u : 0u; mine = (j == x) ? c : mine; }
        if (sum == G) break;
        __builtin_amdgcn_s_sleep(1);
        if ((++sp & 255u) == 0u) { if (xb_ld(&bar[XB_TMO])) break; if (sp > XB_SPIN_CAP) { atomicAdd(&bar[XB_TMO], 1u); break; } }
    }
    nloc = mine > 0u ? mine : 1u; nx = cnt > 0u ? cnt : 1u;
}
__device__ __forceinline__ void xcd_barrier(const XcdBarrier& b) {
    asm volatile("s_waitcnt vmcnt(0)" ::: "memory");
    __syncthreads();
    if (threadIdx.x == 0) {
        unsigned* bar = b.bar;
        __builtin_amdgcn_s_waitcnt(0);
        unsigned nloc = b.st[0], nx = b.st[1];
        if (nloc == 0u) { xcd_barrier_complete(bar, b.x, nloc, nx); b.st[0] = nloc; b.st[1] = nx; }
        const unsigned old = xb_add(&bar[XB_XSUB(b.x)], 1u);
        const unsigned gen = old / nloc;
        if (old + 1u == (gen + 1u) * nloc) {
            __builtin_amdgcn_fence(__ATOMIC_RELEASE, "agent");
            asm volatile("s_waitcnt vmcnt(0)" ::: "memory");
            const unsigned og = xb_add(&bar[XB_TOP], 1u);
            const unsigned tg = og / nx;
            if (og + 1u == (tg + 1u) * nx) xb_add(&bar[XB_TOPGEN], 1u);
            else XB_SPIN(xb_ld(&bar[XB_TOPGEN]) == tg, bar);
            __builtin_amdgcn_fence(__ATOMIC_ACQUIRE, "agent");
            xb_add(&bar[XB_XGEN(b.x)], 1u);
            asm volatile("s_waitcnt vmcnt(0)" ::: "memory");
        } else {
            XB_SPIN(xb_ld(&bar[XB_XGEN(b.x)]) == gen, bar);
            __builtin_amdgcn_fence(__ATOMIC_ACQUIRE, "agent");
            asm volatile("s_waitcnt vmcnt(0)" ::: "memory");
        }
    }
    __syncthreads();
}

__global__ void __launch_bounds__(NTHREADS) mk_fwd(Args a) {
    extern __shared__ __attribute__((aligned(16))) unsigned char lds_raw[];
    LAS unsigned char* lds = (LAS unsigned char*)lds_raw;
    cg::grid_group grid = cg::this_grid();
    const int wid = __builtin_amdgcn_readfirstlane((int)threadIdx.x >> 6);
    const int G = gridDim.x, blk = blockIdx.x;
#define PHASE_LANES const int tid = threadIdx.x, lane = tid & 63, fr = lane & 15, fq = lane >> 4; (void)tid; (void)lane; (void)fr; (void)fq
    unsigned char* ws = a.ws; unsigned char* ob = (unsigned char*)a.out;
    bf16_t* z1 = (bf16_t*)(ws + WS_Z1); bf16_t* merged = (bf16_t*)(ws + WS_MERGED);
    bf16_t* WinT = (bf16_t*)(ws + WS_WIN); bf16_t* WkvT = (bf16_t*)(ws + WS_WKV); bf16_t* WfoT = (bf16_t*)(ws + WS_WFO); bf16_t* WnaT = (bf16_t*)(ws + WS_WNA);
    bf16_t* WcaT = (bf16_t*)(ws + WS_WCA); bf16_t* WoutT = (bf16_t*)(ws + WS_WOUT); bf16_t* kvmem = (bf16_t*)(ws + WS_KVMEM); bf16_t* memn = (bf16_t*)(ws + WS_MEMN);
    float* rowss = (float*)(ws + WS_ROWSS);
    bf16_t* tab64 = (bf16_t*)(ws + WS_TAB64); bf16_t* tab128 = (bf16_t*)(ws + WS_TAB128); bf16_t* tabC = (bf16_t*)(ws + WS_TABC);
    bf16_t* hb = (bf16_t*)(ob + OUT_HB); bf16_t* T2 = (bf16_t*)(ob + OUT_T2);
    const int lo = a.ph_lo, hi = a.ph_hi;
    volatile LAS unsigned* xbst = (volatile LAS unsigned*)(lds + LDS_BYTES - 16);
    if (threadIdx.x == 0) { xbst[0] = 0u; xbst[1] = 0u; xbst[2] = 0u; xbst[3] = 0u; }
    __syncthreads();
    XcdBarrier xb = xcd_barrier_post((unsigned*)(ws + WS_BAR), xbst);
    if (a.ph_hi < 0) grid.sync();
#ifndef SKIPMASK
#define SKIPMASK 0
#endif
#define IN(k) (!((SKIPMASK >> (k)) & 1) && lo <= (k) && (k) < hi)
#ifndef REPMASK
#define REPMASK 0
#endif
#define REPS(k) (1 + ((REPMASK >> (k)) & 1))
#ifndef CG_SEAMS
#define CG_SEAMS 0
#endif
#define SEAM(k) do { if (IN(k) && IN((k) + 1)) { if ((k) < CG_SEAMS) grid.sync(); else xcd_barrier(xb); } } while (0)

    if (IN(0)) for (int rep_ = 0; rep_ < REPS(0); ++rep_) {
        PHASE_LANES;
        LAS float* scr = (LAS float*)(lds + wid * 16384);
        const int gw = blk * 8 + wid, NGW = G * 8;
        constexpr int I_IN = 16 * (NIN / 32), I_KV = 16 * 16, I_FO = 6 * 32, I_NA = 6 * 32, I_CA = 4 * 32, I_OUT = 16 * 32;
        constexpr int NITEMS = I_IN + I_KV + I_FO + I_NA + I_CA + I_OUT;
        for (int it = gw; it < NITEMS; it += NGW) {
            int r = it;
            if (r < I_IN) { p0_transpose_item(a.w_in, D, NIN, WinT, scr, r, lane); continue; } r -= I_IN;
            if (r < I_KV) { p0_transpose_item(a.w_kv, D, 512, WkvT, scr, r, lane); continue; } r -= I_KV;
            if (r < I_FO) { p0_transpose_item(a.w_fo, 384, D, WfoT, scr, r, lane); continue; } r -= I_FO;
            if (r < I_NA) { p0_transpose_item(a.w_na, 384, D, WnaT, scr, r, lane); continue; } r -= I_NA;
            if (r < I_CA) { p0_transpose_item(a.w_ca, 256, D, WcaT, scr, r, lane); continue; } r -= I_CA;
            p0_transpose_item(a.w_out, D, D, WoutT, scr, r, lane);
        }
        for (int m4 = gw; m4 < T / 4; m4 += NGW) { const float* xr[4]; bf16_t* orw[4];
#pragma unroll
            for (int r = 0; r < 4; ++r) { const int m = 4 * m4 + r; xr[r] = m < TP ? a.xp + (size_t)m * D : a.xs + (size_t)(m - TP) * D; orw[r] = hb + (size_t)m * D; }
            rms_rows4_to_bf16(xr, a.g_norm, orw, lane); }
        for (int m = gw; m < NMEMROWS; m += NGW) rms_row_to_bf16(m < 2048 ? a.memp + (size_t)m * D : a.mems + (size_t)(m - 2048) * D, a.g_mem, memn + (size_t)m * D, lane);
        const int gt = blk * NTHREADS + tid, NT = G * NTHREADS;
        for (int i = gt; i < 64 * 64; i += NT) { const int k = i >> 6, n = i & 63; const float f = (float)((k * n) & 63) * (1.0f / 64.0f); const float c = cosrev(f), s = sinrev(f);
            tab64[i] = f2bf(c); tab64[4096 + i] = f2bf(-s); tab64[8192 + i] = f2bf(s); }
        for (int i = gt; i < 128 * 128; i += NT) { const int k = i >> 7, n = i & 127; const float f = (float)((k * n) & 127) * (1.0f / 128.0f); const float c = cosrev(f), s = sinrev(f);
            tab128[i] = f2bf(c); tab128[16384 + i] = f2bf(-s); tab128[32768 + i] = f2bf(s); }
        for (int i = gt; i < 1024; i += NT) ((unsigned*)(ws + WS_CNT))[64 * (i >> 1) + 16 * (i & 1)] = 0u;
        for (int i = gt; i < 96 * 96; i += NT) { const int l = i / 96, kap = i % 96; const int s = kap >> 5, g = (kap & 31) >> 3, j = kap & 7; const int m = 32 * s + 16 * (j >> 2) + 4 * g + (j & 3);
            const float f = (float)((m * l) % 96) * (1.0f / 96.0f); tabC[i] = f2bf(cosrev(f)); tabC[9216 + i] = f2bf(sinrev(f)); }
    }
    SEAM(0);
    int vblk = blk;
    if (IN(0) && IN(1)) {
        if (threadIdx.x == 0) { unsigned* bar = (unsigned*)(ws + WS_BAR); bool ok = (G % 8 == 0);
            for (int j = 0; j < 16; ++j) { const unsigned cj = xb_ld(&bar[XB_XCNT(j)]); ok = ok && (cj == (j < 8 ? (unsigned)(G / 8) : 0u)); }
            xbst[3] = ok ? (xbst[2] * 8u + xb.x) : (unsigned)blk; }
        __syncthreads();
        vblk = __builtin_amdgcn_readfirstlane((int)xbst[3]);
    }

    if (IN(1)) {
        { PlainStream S; S.so.init(T, NZ, G, vblk, REPS(1)); S.A = (const char*)hb; S.B = (const char*)WinT; S.lda = D * 2; S.ldb = D * 2; S.nt = 16;
          EpiStoreBf16 E{z1, NZ}; pg8::gemm_stream<1>(lds, S, E); }
        { PlainStream S; S.so.init(NMEMROWS, 512, G, blk); S.A = (const char*)memn; S.B = (const char*)WkvT; S.lda = D * 2; S.ldb = D * 2; S.nt = 16;
          EpiStoreBf16 E{kvmem, 512}; pg8::gemm_stream<1>(lds, S, E); }
    }
    SEAM(1);

    if (IN(2)) {
        PHASE_LANES;
        {
            LAS unsigned char* Kimg = lds; LAS unsigned char* Vimg = lds + 576 * 128; LAS float* rpbs = (LAS float*)(lds + 2 * 576 * 128);
            constexpr int NITEMS = 768;
            for (int it = blk; it < NITEMS; it += G) {
                int q, chunk, h, R;
                if (it < 384) { h = it % 6; const int t2 = it / 6; chunk = t2 & 7; q = t2 >> 3; R = 128; }
                else { const int i2 = it - 384; h = i2 % 6; const int t2 = i2 / 6; chunk = t2 & 3; q = 8 + (t2 >> 2); R = 64; }
                const int sb = seq_base(q), rowbase = 16 * chunk;
                const bf16_t* kvbase = z1 + (size_t)sb * NZ + h * 64;
                int rb = min(max(rowbase - 4, 0), R - 8), hi = min(rb + 8, R - 1);
                __syncthreads();
                for (int c = tid; c < (hi - rb + 1) * 512; c += NTHREADS) { const int row = rb + (c >> 9), col = (c >> 3) & 63, ch = c & 7, key = (row % 9) * 64 + col;
                    const bf16_t* src = kvbase + (size_t)(row * 64 + col) * NZ + ch * 8;
                    *(LAS u32x4*)(Kimg + kv_off(key, ch)) = *(const u32x4*)(src + C_K); *(LAS u32x4*)(Vimg + kv_off(key, ch)) = *(const u32x4*)(src + C_V); }
                for (int c = tid; c < 465; c += NTHREADS) rpbs[c] = a.rpb[h * 465 + c] * 1.4426950408889634f;
                const int j = wid & 3, c0 = min(max(16 * j - 8, 0), 32), pcol = tid >> 3, pch = tid & 7;
                bf16_t* trow = z1 + (size_t)(sb + (rowbase + (wid >> 2)) * 64 + 16 * j + fr) * NZ;
                QG cur = load_qg(trow + C_Q + h * 64, trow + C_GNA + h * 64, fq);
                __syncthreads();
#pragma unroll 1
                for (int bi = 0; bi < 8; ++bi) {
                    const int r0 = rowbase + 2 * bi, r = r0 + (wid >> 2), rs = min(max(r - 4, 0), R - 8);
                    const int rb2 = min(max(r0 + 2 - 4, 0), R - 8), hi2 = (bi < 7) ? min(rb2 + 8, R - 1) : hi;
                    const int nrow0 = min(hi + 1, R - 1), nrow1 = min(hi + 2, R - 1);
                    const bf16_t* s0 = kvbase + (size_t)(nrow0 * 64 + pcol) * NZ + pch * 8; const bf16_t* s1 = kvbase + (size_t)(nrow1 * 64 + pcol) * NZ + pch * 8;
                    const u32x4 pk0 = *(const u32x4*)(s0 + C_K), pv0 = *(const u32x4*)(s0 + C_V), pk1 = *(const u32x4*)(s1 + C_K), pv1 = *(const u32x4*)(s1 + C_V);
                    bf16_t* trow2 = trow + (size_t)(bi < 7 ? 128 : 0) * NZ;
                    const QG nxt = load_qg(trow2 + C_Q + h * 64, trow2 + C_GNA + h * 64, fq);
                    int krow[8]; { const int sl0 = rs % 9;
#pragma unroll
                        for (int kr = 0; kr < 8; ++kr) { int sl = sl0 + kr; sl = sl >= 9 ? sl - 9 : sl; krow[kr] = sl * 64 + c0; } }
                    attn16<true>(Kimg, Vimg, rpbs, krow, cur, trow + C_GNA + h * 64, fr, fq, lane, 16 * j + fr, c0, rs - r + 7);
                    __syncthreads();
                    if (hi + 1 <= hi2) { const int key = ((hi + 1) % 9) * 64 + pcol; *(LAS u32x4*)(Kimg + kv_off(key, pch)) = pk0; *(LAS u32x4*)(Vimg + kv_off(key, pch)) = pv0; }
                    if (hi + 2 <= hi2) { const int key = ((hi + 2) % 9) * 64 + pcol; *(LAS u32x4*)(Kimg + kv_off(key, pch)) = pk1; *(LAS u32x4*)(Vimg + kv_off(key, pch)) = pv1; }
                    __syncthreads();
                    hi = hi2; cur = nxt; trow = trow2;
                }
            }
        }
        {
            LAS unsigned char* Kimg = lds; LAS unsigned char* Vimg = lds + 256 * 128;
            constexpr int NITEMS = 512;
            int krow[8];
#pragma unroll
            for (int kr = 0; kr < 8; ++kr) krow[kr] = kr * 32;
            for (int it = blk; it < NITEMS; it += G) {
                int q, h, ck;
                if (it < 256) { ck = it & 7; h = (it >> 3) & 3; q = it >> 5; } else { const int i2 = it - 256; ck = i2 & 3; h = (i2 >> 2) & 3; q = 8 + (i2 >> 4); }
                const int tok0 = seq_base(q) + ck * 1024;
                __syncthreads();
                for (int c = tid; c < 256 * 8; c += NTHREADS) { const int key = c >> 3, ch = c & 7; const bf16_t* src = kvmem + (size_t)(q * 256 + key) * 512 + h * 64 + ch * 8;
                    *(LAS u32x4*)(Kimg + kv_off(key, ch)) = *(const u32x4*)(src); *(LAS u32x4*)(Vimg + kv_off(key, ch)) = *(const u32x4*)(src + 256); }
                bf16_t* trow = z1 + (size_t)(tok0 + wid * 128 + fr) * NZ;
                QG cur = load_qg(trow + C_QCA + h * 64, trow + C_GCA + h * 64, fq);
                __syncthreads();
#pragma unroll 1
                for (int i = 0; i < 8; ++i) { bf16_t* trow2 = trow + (size_t)(i < 7 ? 16 : 0) * NZ;
                    const QG nxt = load_qg(trow2 + C_QCA + h * 64, trow2 + C_GCA + h * 64, fq);
                    attn16<false>(Kimg, Vimg, nullptr, krow, cur, trow + C_GCA + h * 64, fr, fq, lane, 0, 0, 0);
                    cur = nxt; trow = trow2; }
            }
        }
        for (int rep_ = 0; rep_ < REPS(7); ++rep_)
        {
            constexpr int US = 784;
            constexpr int NITEMS = 2048;
            bf16x8 af[8][2];
#pragma unroll
            for (int mb = 0; mb < 8; ++mb)
#pragma unroll
                for (int ks = 0; ks < 2; ++ks) af[mb][ks] = *(const bf16x8*)(tab64 + (mb >> 2) * 4096 + ((mb & 3) * 16 + fr) * 64 + 32 * ks + 8 * fq);
            const int q4 = (lane & 15) >> 2, p4 = lane & 3;
            for (int it = blk; it < NITEMS; it += G) {
                int q, n2, N2, S;
                if (it < 1024) { q = it >> 7; n2 = it & 127; N2 = 128; S = 8192; } else { const int i2 = it - 1024; q = 8 + (i2 >> 6); n2 = i2 & 63; N2 = 64; S = 4096; }
                const int sb = seq_base(q);
                __syncthreads();
                for (int c = tid; c < 64 * 48; c += NTHREADS) { const int n1 = c / 48, ch = c % 48;
                    *(LAS u32x4*)(lds + n1 * US + ch * 16) = *(const u32x4*)(z1 + (size_t)(sb + N2 * n1 + n2) * NZ + C_UF + ch * 8); }
                __syncthreads();
                const float invS = 1.0f / (float)S;
#pragma unroll 1
                for (int cc = 0; cc < 3; ++cc) {
                    const int c = wid * 3 + cc;
                    bf16x8 bfr[2];
#pragma unroll
                    for (int ks = 0; ks < 2; ++ks) { LAS unsigned char* p = lds + (32 * ks + 8 * fq + q4) * US + (16 * c + 4 * p4) * 2; bfr[ks] = cat4(tr_read(p), tr_read(p + 4 * US)); }
                    f32x4 acc[8];
#pragma unroll
                    for (int mb = 0; mb < 8; ++mb) { f32x4 v = (f32x4){0.f, 0.f, 0.f, 0.f}; v = mfma16(af[mb][0], bfr[0], v); v = mfma16(af[mb][1], bfr[1], v); acc[mb] = v; }
                    const int ch = 16 * c + fr, grp = ch / 96, mm = ch - grp * 96;
#pragma unroll
                    for (int mb = 0; mb < 4; ++mb)
#pragma unroll
                        for (int i = 0; i < 4; ++i) { const int k1 = mb * 16 + 4 * fq + i; const float f = (float)((n2 * k1) & (S - 1)) * invS; const float cs = cosrev(f), sn = sinrev(f);
                            const float tr = acc[mb][i], ti = acc[mb + 4][i]; bf16_t* dst = T2 + (size_t)(sb + k1 * N2 + n2) * 768 + grp * 192 + mm;
                            dst[0] = f2bf(tr * cs + ti * sn); dst[96] = f2bf(ti * cs - tr * sn); }
                }
            }
        }
    }
    SEAM(2);

    if (IN(3)) {
        PHASE_LANES;
        constexpr int TS = 400;
        constexpr int NITEMS = 4096;
        const int q4 = (lane & 15) >> 2, p4 = lane & 3;
#define FC_DECODE(IT, BIG, Q, K1, GG, SB) const bool BIG = (IT) < 2048; const int GG = BIG ? ((IT) & 3) : (((IT) - 2048) & 1), K1 = BIG ? (((IT) >> 2) & 63) : ((((IT) - 2048) >> 1) & 63), \
        Q = BIG ? ((IT) >> 8) : (8 + (((IT) - 2048) >> 7)), SB = seq_base(Q)
#define FC_LOAD_TILE(DST, BIG, K1, GG, SB) do { _Pragma("unroll") for (int i_ = 0; i_ < 6; ++i_) { const int c_ = tid + NTHREADS * i_, rr_ = c_ / 24, ch_ = c_ - rr_ * 24; \
        const size_t row_ = BIG ? (size_t)(SB + K1 * 128 + rr_) : (size_t)(SB + K1 * 64 + (rr_ & 63)); const int gcol_ = BIG ? GG * 192 : (2 * GG + (rr_ >> 6)) * 192; \
        DST[i_] = *(const u32x4*)(T2 + row_ * 768 + gcol_ + ch_ * 8); } } while (0)
#define FC_STORE_TILE(SRC) do { _Pragma("unroll") for (int i_ = 0; i_ < 6; ++i_) { const int c_ = tid + NTHREADS * i_, rr_ = c_ / 24, ch_ = c_ - rr_ * 24; *(LAS u32x4*)(lds + rr_ * TS + ch_ * 16) = SRC[i_]; } } while (0)
#define FC_GATE_ROW(BIG, K1, GG, SB) (z1 + (size_t)(SB + K1 + 64 * (16 * (BIG ? wid : (wid & 3)) + fr)) * NZ + C_GF + (BIG ? GG : 2 * GG + (wid >> 2)) * 96 + 4 * fq)
        constexpr int TC_OFF = 128 * TS;
        for (int c = tid; c < 2 * 9216 / 8; c += NTHREADS) *(LAS u32x4*)(lds + TC_OFF + c * 16) = *(const u32x4*)(tabC + c * 8);
        bf16x8 wfr[4][3];
        int wmode = -1;
        u32x4 pre[6]; u32x2 gcur[6];
        int it = blk;
        if (it < NITEMS) { FC_DECODE(it, big0, q0_, k10, g0_, sb0); FC_LOAD_TILE(pre, big0, k10, g0_, sb0); const bf16_t* gr = FC_GATE_ROW(big0, k10, g0_, sb0);
#pragma unroll
            for (int lb = 0; lb < 6; ++lb) gcur[lb] = *(const u32x2*)(gr + 16 * lb);
            __syncthreads(); FC_STORE_TILE(pre); __syncthreads(); }
        for (; it < NITEMS; it += G) {
            FC_DECODE(it, big, q, k1, gg, sb);
            const int nit = it + G; const bool hasn = nit < NITEMS; const int nit_c = hasn ? nit : it;
            FC_DECODE(nit_c, bign, qn, k1n, ggn, sbn);
            u32x2 gnx[6];
            FC_LOAD_TILE(pre, bign, k1n, ggn, sbn);
            { const bf16_t* gr = FC_GATE_ROW(bign, k1n, ggn, sbn);
#pragma unroll
              for (int lb = 0; lb < 6; ++lb) gnx[lb] = *(const u32x2*)(gr + 16 * lb); }
            const int N2 = big ? 128 : 64, S = big ? 8192 : 4096, kb2 = big ? wid : (wid & 3);
            LAS unsigned char* tile = big ? lds : lds + (wid >> 2) * 64 * TS;
            const int nks = N2 / 32;
            if (wmode != (int)big) { wmode = (int)big; const bf16_t* tab = big ? tab128 : tab64; const int tsz = N2 * N2;
#pragma unroll
                for (int ks = 0; ks < 4; ++ks) { const bf16_t* tp = tab + (16 * kb2 + fr) * N2 + 32 * (ks < nks ? ks : 0) + 8 * fq;
                    wfr[ks][0] = *(const bf16x8*)(tp); wfr[ks][1] = *(const bf16x8*)(tp + tsz); wfr[ks][2] = *(const bf16x8*)(tp + 2 * tsz); } }
            f32x4 zr[6], zi[6];
#pragma unroll
            for (int cb = 0; cb < 6; ++cb) { zr[cb] = (f32x4){0.f, 0.f, 0.f, 0.f}; zi[cb] = (f32x4){0.f, 0.f, 0.f, 0.f}; }
#pragma unroll
            for (int ks = 0; ks < 4; ++ks) if (ks < nks) {
                const bf16x8 wre = wfr[ks][0], wim = wfr[ks][1], wni = wfr[ks][2];
                LAS unsigned char* rowp = tile + (32 * ks + 8 * fq + q4) * TS + 8 * p4;
#pragma unroll
                for (int cb = 0; cb < 6; ++cb) {
                    const bf16x8 trf = cat4(tr_read(rowp + 32 * cb), tr_read(rowp + 32 * cb + 4 * TS));
                    const bf16x8 tif = cat4(tr_read(rowp + 192 + 32 * cb), tr_read(rowp + 192 + 32 * cb + 4 * TS));
                    zr[cb] = mfma16(trf, wre, zr[cb]); zr[cb] = mfma16(tif, wni, zr[cb]);
                    zi[cb] = mfma16(tif, wre, zi[cb]); zi[cb] = mfma16(trf, wim, zi[cb]);
                }
            }
            bf16x8 zfr[3], zfi[3];
#pragma unroll
            for (int s_ = 0; s_ < 3; ++s_) { zfr[s_] = pack8(zr[2 * s_], zr[2 * s_ + 1]); zfi[s_] = pack8(zi[2 * s_], zi[2 * s_ + 1]); }
            const float scale = 1.0f / sqrtf((float)S * 96.0f);
            bf16_t* trow = (bf16_t*)FC_GATE_ROW(big, k1, gg, sb);
#pragma unroll
            for (int lb = 0; lb < 6; ++lb) {
                f32x4 y = (f32x4){0.f, 0.f, 0.f, 0.f};
#pragma unroll
                for (int s_ = 0; s_ < 3; ++s_) { const LAS unsigned char* cp = lds + TC_OFF + ((16 * lb + fr) * 96 + 32 * s_ + 8 * fq) * 2;
                    y = mfma16(*(const LAS bf16x8*)cp, zfr[s_], y); y = mfma16(*(const LAS bf16x8*)(cp + 9216 * 2), zfi[s_], y); }
                const u32x2 gv = gcur[lb]; u32x2 w;
                w.x = cvt_pk_bf16(y[0] * scale * siluf_(bf_lo(gv.x)), y[1] * scale * siluf_(bf_hi(gv.x)));
                w.y = cvt_pk_bf16(y[2] * scale * siluf_(bf_lo(gv.y)), y[3] * scale * siluf_(bf_hi(gv.y)));
                *(u32x2*)(trow + 16 * lb) = w;
            }
            __syncthreads();
            if (hasn) FC_STORE_TILE(pre);
            __syncthreads();
#pragma unroll
            for (int lb = 0; lb < 6; ++lb) gcur[lb] = gnx[lb];
        }
#undef FC_DECODE
#undef FC_LOAD_TILE
#undef FC_STORE_TILE
#undef FC_GATE_ROW
    }
    SEAM(3);

    if (IN(4)) {
        MergeStream S; S.so.init(T, D, G, vblk, REPS(4)); S.hb = (const char*)hb; S.z1 = (const char*)z1; S.win = (const char*)WinT; S.wfo = (const char*)WfoT; S.wna = (const char*)WnaT; S.wca = (const char*)WcaT;
        EpiMerge E{ob + OUT_T2 + (size_t)blk * (3 * 16 * 8192), merged};
        pg8::gemm_stream<6>(lds, S, E);
    }
    SEAM(4);

    if (IN(5)) {
        PlainStream S; S.so.init(T, D, G, vblk, REPS(5)); S.A = (const char*)merged; S.B = (const char*)WoutT; S.lda = D * 2; S.ldb = D * 2; S.nt = 16;
        EpiResid E{a.xp, a.xs, a.out, rowss, (unsigned*)(ws + WS_CNT), a.g_final, (FUSE_NORM && G == 256 && REPS(5) == 1) ? 1 : 0};
        pg8::gemm_stream<1>(lds, S, E);
    }
    SEAM(5);

    if (IN(6) && !(FUSE_NORM && G == 256 && REPS(5) == 1)) {
        PHASE_LANES;
        const int gw = blk * 8 + wid, NGW = G * 8;
        for (int m4 = gw; m4 < T / 4; m4 += NGW) {
            f32x4 v[4][4]; float rs_[4];
#pragma unroll
            for (int r = 0; r < 4; ++r) { const int m = 4 * m4 + r; const f32x4* yr = (const f32x4*)(a.out + (size_t)m * D) + lane;
#pragma unroll
                for (int j = 0; j < 4; ++j) v[r][j] = yr[64 * j];
                rs_[r] = lane < 16 ? rowss[(size_t)m * 16 + lane] : 0.f; }
#pragma unroll
            for (int r = 0; r < 4; ++r) rs_[r] = 1.0f / sqrtf(wave_sum(rs_[r]) * (1.0f / D) + EPS);
            const f32x4* gr = (const f32x4*)a.g_final + lane;
#pragma unroll
            for (int j = 0; j < 4; ++j) { const f32x4 gv = gr[64 * j];
#pragma unroll
                for (int r = 0; r < 4; ++r) ((f32x4*)(a.out + (size_t)(4 * m4 + r) * D) + lane)[64 * j] = v[r][j] * rs_[r] * gv; }
        }
    }
}

extern "C" void kernel_launch(void* const* d_in, const int* in_sizes, int n_in, void* d_out, int out_size, void* d_ws, size_t ws_size, hipStream_t stream) {
    static int grid = 0;
    if (grid == 0) {
        if (n_in != 14 || out_size != T * D || ws_size < WS_END) { fprintf(stderr, "kernel_launch: unexpected sizes (n_in %d out %d ws %zu, need ws >= %zu)\n", n_in, out_size, ws_size, (size_t)WS_END); grid = -1; return; }
        int dev = 0, cus = 0, per_cu = 0;
        if (hipGetDevice(&dev) != hipSuccess || hipDeviceGetAttribute(&cus, hipDeviceAttributeMultiprocessorCount, dev) != hipSuccess) { grid = -1; return; }
        if (hipFuncSetAttribute((const void*)mk_fwd, hipFuncAttributeMaxDynamicSharedMemorySize, LDS_BYTES) != hipSuccess) { fprintf(stderr, "kernel_launch: hipFuncSetAttribute failed\n"); grid = -1; return; }
        if (hipOccupancyMaxActiveBlocksPerMultiprocessor(&per_cu, (const void*)mk_fwd, NTHREADS, LDS_BYTES) != hipSuccess || per_cu < 1) { fprintf(stderr, "kernel_launch: occupancy query says %d blocks per CU\n", per_cu); grid = -1; return; }
        grid = cus;
    }
    if (grid < 0) return;
    Args a{};
    a.xp = (const float*)d_in[0]; a.xs = (const float*)d_in[1]; a.memp = (const float*)d_in[2]; a.mems = (const float*)d_in[3]; a.g_norm = (const float*)d_in[4];
    a.w_in = (const float*)d_in[5]; a.rpb = (const float*)d_in[6]; a.g_mem = (const float*)d_in[7]; a.w_kv = (const float*)d_in[8]; a.w_fo = (const float*)d_in[9];
    a.w_na = (const float*)d_in[10]; a.w_ca = (const float*)d_in[11]; a.w_out = (const float*)d_in[12]; a.g_final = (const float*)d_in[13];
    a.out = (float*)d_out; a.ws = (unsigned char*)d_ws;
    if (hipMemsetAsync((char*)d_ws + WS_BAR, 0, XCD_BAR_WORDS * 4, stream) != hipSuccess) { fprintf(stderr, "kernel_launch: hipMemsetAsync of the barrier words failed\n"); return; }
#if MK_N_LAUNCHES == 1
    a.ph_lo = 0; a.ph_hi = NPHASES;
    { void* args[] = {&a}; hipError_t e = hipLaunchCooperativeKernel((const void*)mk_fwd, dim3(grid), dim3(NTHREADS), args, LDS_BYTES, stream);
      if (e != hipSuccess) fprintf(stderr, "kernel_launch: cooperative launch failed: %s\n", hipGetErrorString(e)); }
#else
    for (int p = 0; p < NPHASES; ++p) { a.ph_lo = p; a.ph_hi = p + 1; void* args[] = {&a};
        hipError_t e = hipLaunchCooperativeKernel((const void*)mk_fwd, dim3(grid), dim3(NTHREADS), args, LDS_BYTES, stream);
        if (e != hipSuccess) { fprintf(stderr, "kernel_launch: launch %d failed: %s\n", p, hipGetErrorString(e)); break; } }
#endif
}
```

```cpp
#include <hip/hip_runtime.h>
#include <hip/hip_cooperative_groups.h>
#include <cstdio>
#include <cstdint>
namespace cg = cooperative_groups;

#ifndef FUSE_NORM
#define FUSE_NORM 0
#endif
#ifndef MK_N_LAUNCHES
#define MK_N_LAUNCHES 1
#endif

#define LAS __attribute__((address_space(3)))
#define GAS __attribute__((address_space(1)))
typedef unsigned short bf16_t;
typedef short bf16x8 __attribute__((ext_vector_type(8)));
typedef short s16x4 __attribute__((ext_vector_type(4)));
typedef float f32x4 __attribute__((ext_vector_type(4)));
typedef unsigned u32x4 __attribute__((ext_vector_type(4)));
typedef unsigned u32x2 __attribute__((ext_vector_type(2)));

constexpr int D = 1024, T = 131072, TP = 65536, NZ = 2816, NIN = 5888, NMEMROWS = 6144;
constexpr int C_UF = 0, C_GF = 384, C_Q = 768, C_K = 1152, C_V = 1536, C_GNA = 1920, C_QCA = 2304, C_GCA = 2560;
constexpr float EPS = 1e-6f;
constexpr int NPHASES = 7;
constexpr int LDS_BYTES = 153600;
constexpr int NTHREADS = 512;

constexpr size_t WS_Z1 = 0;
constexpr size_t WS_MERGED = WS_Z1 + (size_t)T * NZ * 2;
constexpr size_t WS_WIN = WS_MERGED + (size_t)T * D * 2;
constexpr size_t WS_WKV = WS_WIN + (size_t)NIN * D * 2;
constexpr size_t WS_WFO = WS_WKV + (size_t)512 * D * 2;
constexpr size_t WS_WNA = WS_WFO + (size_t)D * 384 * 2;
constexpr size_t WS_WCA = WS_WNA + (size_t)D * 384 * 2;
constexpr size_t WS_WOUT = WS_WCA + (size_t)D * 256 * 2;
constexpr size_t WS_KVMEM = WS_WOUT + (size_t)D * D * 2;
constexpr size_t WS_MEMN = WS_KVMEM + (size_t)NMEMROWS * 512 * 2;
constexpr size_t WS_ROWSS = WS_MEMN + (size_t)NMEMROWS * D * 2;
constexpr size_t WS_TAB64 = WS_ROWSS + (size_t)T * 16 * 4;
constexpr size_t WS_TAB128 = WS_TAB64 + 3 * 64 * 64 * 2;
constexpr size_t WS_TABC = WS_TAB128 + 3 * 128 * 128 * 2;
constexpr size_t WS_CNT = (WS_TABC + 2 * 96 * 96 * 2 + 255) / 256 * 256;
constexpr size_t WS_BAR = WS_CNT + 512 * 256;
constexpr size_t WS_END = WS_BAR + 3456 * 4;
constexpr size_t OUT_HB = 0;
constexpr size_t OUT_T2 = (size_t)T * D * 2;
constexpr size_t OUT_END = OUT_T2 + (size_t)T * 768 * 2;
static_assert(OUT_END <= (size_t)T * D * 4, "d_out scratch");

struct Args {
    const float *xp, *xs, *memp, *mems, *g_norm, *w_in, *rpb, *g_mem, *w_kv, *w_fo, *w_na, *w_ca, *w_out, *g_final;
    float* out; unsigned char* ws; int ph_lo, ph_hi;
};

typedef __bf16 bf16v2 __attribute__((ext_vector_type(2)));
typedef float f32x2 __attribute__((ext_vector_type(2)));
__device__ __forceinline__ unsigned cvt_pk_bf16(float lo, float hi) { const f32x2 v = {lo, hi}; return __builtin_bit_cast(unsigned, __builtin_convertvector(v, bf16v2)); }
__device__ __forceinline__ float bf_lo(unsigned w) { return __uint_as_float(w << 16); }
__device__ __forceinline__ float bf_hi(unsigned w) { return __uint_as_float(w & 0xffff0000u); }
__device__ __forceinline__ float wave_sum(float v) {
#pragma unroll
    for (int o = 1; o < 64; o <<= 1) v += __shfl_xor(v, o);
    return v;
}
__device__ __forceinline__ float sigmoidf_(float x) { return __builtin_amdgcn_rcpf(1.0f + __expf(-x)); }
__device__ __forceinline__ float siluf_(float x) { return x * sigmoidf_(x); }
__device__ __forceinline__ int seq_base(int q) { return q < 8 ? q * 8192 : TP + (q - 8) * 4096; }
__device__ __forceinline__ f32x4 mfma16(bf16x8 a, bf16x8 b, f32x4 c) { return __builtin_amdgcn_mfma_f32_16x16x32_bf16(a, b, c, 0, 0, 0); }
__device__ __forceinline__ bf16x8 cat4(s16x4 a, s16x4 b) { return __builtin_shufflevector(a, b, 0, 1, 2, 3, 4, 5, 6, 7); }
__device__ __forceinline__ s16x4 tr_read(LAS unsigned char* p) { return __builtin_amdgcn_ds_read_tr16_b64_v4i16((LAS s16x4*)p); }
__device__ __forceinline__ bf16x8 pack8(f32x4 a, f32x4 b) {
    u32x4 p; p.x = cvt_pk_bf16(a[0], a[1]); p.y = cvt_pk_bf16(a[2], a[3]); p.z = cvt_pk_bf16(b[0], b[1]); p.w = cvt_pk_bf16(b[2], b[3]);
    return __builtin_bit_cast(bf16x8, p);
}

namespace pg8 {
constexpr int BM = 256, BK = 64, HALF = 128, HTB = HALF * BK * 2, STAGE_BYTES = 8 * HTB, NXCD = 8, WGM = 8;
__device__ __forceinline__ int lds_byte(int r, int c) { const int st = (r >> 4) * 2 + (c >> 5), rr = r & 15, cc = c & 31, ob = rr * 64 + cc * 2; return st * 1024 + (ob ^ (((ob >> 9) & 1) << 5)); }
__device__ __forceinline__ void stage_rc(int b, int& R, int& C) { const int st = b / 1024, sb = b % 1024, swz = sb ^ (((sb >> 9) & 1) << 5); R = (st >> 1) * 16 + swz / 64; C = (st & 1) * 32 + (swz % 64) / 2; }
__device__ __forceinline__ int perm32(int rho) { const int n = rho >> 4, i = rho & 15; return 8 * (i >> 2) + 4 * n + (i & 3); }

struct Unit { int pm, pn; };
struct StaticOrder {
    int nM, nN, nwg, G, c, rep;
    __device__ void init(int M, int N, int G_, int c_, int rep_ = 1) { nM = M / BM; nN = N / BM; nwg = nM * nN; G = G_; c = c_; rep = rep_; }
    __device__ bool next(int i, Unit& u) const {
        long L = (long)i * G + c; if (L >= (long)nwg * rep) return false;
        L %= nwg;
        int wgid = (int)L; { const int q = nwg / NXCD, r = nwg % NXCD, xcd = wgid % NXCD, off = wgid / NXCD; wgid = (xcd < r ? xcd * (q + 1) : r * (q + 1) + (xcd - r) * q) + off; }
        const int nig = WGM * nN, gid = wgid / nig, fm = gid * WGM, gsz = (nM - fm) < WGM ? (nM - fm) : WGM;
        u.pm = fm + ((wgid % nig) % gsz); u.pn = (wgid % nig) / gsz; return true;
    }
};
struct Seg { const char* A; const char* B; unsigned lda, ldb; int nt, kind, pm, pn; };

template <int NSEG, class Epi, class Stream>
__device__ __forceinline__ void gemm_stream(LAS unsigned char* lds, const Stream& S, const Epi& E) {
    const int tid = threadIdx.x, wid = __builtin_amdgcn_readfirstlane(tid >> 6), lane = tid & 63, wr = wid >> 2, wc = wid & 3, fr = lane & 15, fq = lane >> 4;
    unsigned Ra0, Rb0, Cc0;
    { int R, C; stage_rc(tid * 16, R, C); Ra0 = (unsigned)R; Rb0 = (unsigned)(Epi::PERM ? ((R & ~31) + perm32(R & 31)) : R); Cc0 = (unsigned)C * 2u; }
    const size_t kstep = (size_t)(BK * 2);
    const unsigned ldsw = (unsigned)wid * 1024u;
    const int aoff = lds_byte(wr * 64 + fr, fq * 8), boff = lds_byte(wc * 32 + fr, fq * 8);
#define PG8_SA(b, h) (((b) * 2 + (h)) * HTB)
#define PG8_SB(b, h) ((4 + (b) * 2 + (h)) * HTB)
#define PG8_STAGE(bufoff, gbase, v0, ld) do { \
        __builtin_amdgcn_global_load_lds((const unsigned*)((const char*)(gbase) + (v0)), (LAS unsigned*)(lds + (bufoff) + ldsw), 16, 0, 0); \
        __builtin_amdgcn_global_load_lds((const unsigned*)((const char*)(gbase) + (size_t)64 * (ld) + (v0)), (LAS unsigned*)(lds + (bufoff) + ldsw + 8192), 16, 0, 0); } while (0)
#define PG8_LDA(dst, b, h) do { _Pragma("unroll") for (int m = 0; m < 4; ++m) _Pragma("unroll") for (int k = 0; k < 2; ++k) dst[m][k] = *(const LAS bf16x8*)(lds + PG8_SA(b, h) + aoff + m * 2048 + k * 1024); } while (0)
#define PG8_LDB(dst, b, h) do { _Pragma("unroll") for (int n = 0; n < 2; ++n) _Pragma("unroll") for (int k = 0; k < 2; ++k) dst[n][k] = *(const LAS bf16x8*)(lds + PG8_SB(b, h) + boff + n * 2048 + k * 1024); } while (0)
#define PG8_MMA(ai, bj, At, Bt) do { __builtin_amdgcn_s_setprio(1); _Pragma("unroll") for (int m = 0; m < 4; ++m) _Pragma("unroll") for (int n = 0; n < 2; ++n) _Pragma("unroll") for (int k = 0; k < 2; ++k) \
        acc[ai][bj][m][n] = __builtin_amdgcn_mfma_f32_16x16x32_bf16(Bt[n][k], At[m][k], acc[ai][bj][m][n], 0, 0, 0); __builtin_amdgcn_s_setprio(0); } while (0)
#define PG8_WAIT_V(n) asm volatile("s_waitcnt vmcnt(" #n ")" ::: "memory")
#define PG8_WAIT_L(n) asm volatile("s_waitcnt lgkmcnt(" #n ")" ::: "memory")
#define PG8_BAR __builtin_amdgcn_s_barrier()
#define PG8_SCHED __builtin_amdgcn_sched_barrier(0)
#define PG8_ZERO() do { _Pragma("unroll") for (int a_ = 0; a_ < 2; ++a_) _Pragma("unroll") for (int b_ = 0; b_ < 2; ++b_) _Pragma("unroll") for (int m_ = 0; m_ < 4; ++m_) _Pragma("unroll") for (int n_ = 0; n_ < 2; ++n_) \
        acc[a_][b_][m_][n_] = (f32x4){0.f, 0.f, 0.f, 0.f}; } while (0)
    Seg cur, nxt; int ui = 0;
    if (!S.template seg<0>(0, cur)) return;
    f32x4 acc[2][2][4][2];
    PG8_ZERO();
    bf16x8 At[4][2], B0[2][2], B1[2][2];
    const char* cA = cur.A; const char* cB = cur.B;
    unsigned vAc0 = Ra0 * cur.lda + Cc0, vBc0 = Rb0 * cur.ldb + Cc0, ldAc = cur.lda, ldBc = cur.ldb;
    size_t hAc = (size_t)HALF * cur.lda, hBc = (size_t)HALF * cur.ldb;
    PG8_STAGE(PG8_SB(0, 0), cB, vBc0, ldBc); PG8_STAGE(PG8_SB(0, 1), cB + hBc, vBc0, ldBc); PG8_STAGE(PG8_SA(0, 0), cA, vAc0, ldAc); PG8_STAGE(PG8_SA(0, 1), cA + hAc, vAc0, ldAc);
    if (wr == 1) PG8_BAR;
    PG8_WAIT_V(2); PG8_BAR;
    PG8_STAGE(PG8_SB(1, 0), cB + kstep, vBc0, ldBc); PG8_STAGE(PG8_SA(1, 0), cA + kstep, vAc0, ldAc); PG8_STAGE(PG8_SB(1, 1), cB + hBc + kstep, vBc0, ldBc);
    PG8_WAIT_V(6); PG8_BAR;
#define PG8_SEG(KK) if constexpr (NSEG > (KK)) { \
        bool has_next; if constexpr ((KK) + 1 < NSEG) { S.template seg<((KK) + 1 < NSEG ? (KK) + 1 : 0)>(ui, nxt); has_next = true; } else has_next = S.template seg<0>(ui + 1, nxt); \
        if (!has_next) nxt = cur;     \
        const char* nA = nxt.A; const char* nB = nxt.B; \
        const unsigned vAn0 = Ra0 * nxt.lda + Cc0, vBn0 = Rb0 * nxt.ldb + Cc0, ldAn = nxt.lda, ldBn = nxt.ldb; \
        const size_t hAn = (size_t)HALF * nxt.lda, hBn = (size_t)HALF * nxt.ldb; \
        const int nt = cur.nt; \
        for (int t = 0; t < nt; t += 2) { \
            const bool last = (t == nt - 2); \
            const char* a1 = cA + (size_t)(t + 1) * kstep; \
            const char* a2 = last ? nA : cA + (size_t)(t + 2) * kstep; const char* b2 = last ? nB : cB + (size_t)(t + 2) * kstep; \
            const char* a3 = a2 + kstep; const char* b3 = b2 + kstep; \
            const unsigned vA0 = last ? vAn0 : vAc0, vB0 = last ? vBn0 : vBc0, lA2 = last ? ldAn : ldAc, lB2 = last ? ldBn : ldBc; \
            const size_t hA2 = last ? hAn : hAc, hB2 = last ? hBn : hBc; \
              \
            PG8_LDB(B0, 0, 0); PG8_LDB(B1, 0, 1); PG8_SCHED; PG8_LDA(At, 0, 0); PG8_STAGE(PG8_SA(1, 1), a1 + hAc, vAc0, ldAc); \
            PG8_WAIT_V(8); PG8_WAIT_L(0); PG8_BAR; PG8_MMA(0, 0, At, B0); PG8_MMA(0, 1, At, B1); PG8_BAR; PG8_SCHED; \
              \
            PG8_LDA(At, 0, 1); PG8_STAGE(PG8_SB(0, 0), b2, vB0, lB2); PG8_STAGE(PG8_SB(0, 1), b2 + hB2, vB0, lB2); PG8_STAGE(PG8_SA(0, 0), a2, vA0, lA2); \
            PG8_WAIT_V(8); PG8_WAIT_L(0); PG8_BAR; PG8_MMA(1, 0, At, B0); PG8_MMA(1, 1, At, B1); PG8_BAR; PG8_SCHED; \
              \
            PG8_LDB(B0, 1, 0); PG8_LDB(B1, 1, 1); PG8_SCHED; PG8_LDA(At, 1, 0); PG8_STAGE(PG8_SA(0, 1), a2 + hA2, vA0, lA2); \
            PG8_WAIT_V(8); PG8_WAIT_L(0); PG8_BAR; PG8_MMA(0, 0, At, B0); PG8_MMA(0, 1, At, B1); PG8_BAR; PG8_SCHED; \
              \
            PG8_LDA(At, 1, 1); PG8_STAGE(PG8_SB(1, 0), b3, vB0, lB2); PG8_STAGE(PG8_SB(1, 1), b3 + hB2, vB0, lB2); PG8_STAGE(PG8_SA(1, 0), a3, vA0, lA2); \
            PG8_WAIT_V(8); PG8_WAIT_L(0); PG8_BAR; PG8_MMA(1, 0, At, B0); PG8_MMA(1, 1, At, B1); PG8_BAR; PG8_SCHED; \
        } \
        E.template run<(KK)>(acc, cur, wr, wc, fr, fq, tid); \
        if (!has_next) break; \
        if constexpr (Epi::template zero_after<(KK)>()) PG8_ZERO(); \
        cur = nxt; cA = nA; cB = nB; vAc0 = vAn0; vBc0 = vBn0; ldAc = ldAn; ldBc = ldBn; hAc = hAn; hBc = hBn; }
    for (;;) {
        PG8_SEG(0) PG8_SEG(1) PG8_SEG(2) PG8_SEG(3) PG8_SEG(4) PG8_SEG(5)
        ++ui;
    }
    PG8_WAIT_V(0);
    if (wr == 0) PG8_BAR;
    PG8_BAR;
#undef PG8_SA
#undef PG8_SB
#undef PG8_STAGE
#undef PG8_LDA
#undef PG8_LDB
#undef PG8_MMA
#undef PG8_WAIT_V
#undef PG8_WAIT_L
#undef PG8_BAR
#undef PG8_SCHED
#undef PG8_ZERO
#undef PG8_SEG
}
}

struct PlainStream {
    pg8::StaticOrder so; const char* A; const char* B; unsigned lda, ldb; int nt;
    template <int KK> __device__ __forceinline__ bool seg(int i, pg8::Seg& s) const { pg8::Unit u; if (!so.next(i, u)) return false;
        s.A = A + (size_t)u.pm * 256 * lda; s.B = B + (size_t)u.pn * 256 * ldb; s.lda = lda; s.ldb = ldb; s.nt = nt; s.kind = 0; s.pm = u.pm; s.pn = u.pn; return true; }
};
struct EpiStoreBf16 {
    static constexpr bool PERM = true;
    bf16_t* O; int ldc;
    template <int KK> static constexpr bool zero_after() { return true; }
    template <int KK> __device__ __forceinline__ void run(f32x4 (&acc)[2][2][4][2], const pg8::Seg& u, int wr, int wc, int fr, int fq, int) const {
        const int row0 = u.pm * 256 + wr * 64 + fr, col0 = u.pn * 256 + wc * 32 + 8 * fq;
#pragma unroll
        for (int ai = 0; ai < 2; ++ai)
#pragma unroll
            for (int m = 0; m < 4; ++m) { bf16_t* rowp = O + (size_t)(row0 + ai * 128 + m * 16) * ldc + col0;
#pragma unroll
                for (int bj = 0; bj < 2; ++bj) { const f32x4 v0 = acc[ai][bj][m][0], v1 = acc[ai][bj][m][1];
                    u32x4 w; w.x = cvt_pk_bf16(v0[0], v0[1]); w.y = cvt_pk_bf16(v0[2], v0[3]); w.z = cvt_pk_bf16(v1[0], v1[1]); w.w = cvt_pk_bf16(v1[2], v1[3]);
                    *(u32x4*)(rowp + bj * 128) = w; } }
    }
};

struct MergeStream {
    pg8::StaticOrder so; const char *hb, *z1, *win, *wfo, *wna, *wca;
    template <int KK> __device__ __forceinline__ bool seg(int ui, pg8::Seg& s) const { pg8::Unit u; constexpr int k = KK; if (!so.next(ui, u)) return false;
        s.kind = k; s.pm = u.pm; s.pn = u.pn;
        if (k < 3) { s.A = hb + (size_t)u.pm * 256 * (D * 2); s.lda = D * 2; s.B = win + (size_t)(NZ + k * D + u.pn * 256) * (D * 2); s.ldb = D * 2; s.nt = 16; }
        else { s.lda = NZ * 2; const char* a = z1 + (size_t)u.pm * 256 * (NZ * 2);
            if (k == 3) { s.A = a + C_GF * 2; s.B = wfo + (size_t)u.pn * 256 * (384 * 2); s.ldb = 384 * 2; s.nt = 6; }
            else if (k == 4) { s.A = a + C_GNA * 2; s.B = wna + (size_t)u.pn * 256 * (384 * 2); s.ldb = 384 * 2; s.nt = 6; }
            else { s.A = a + C_GCA * 2; s.B = wca + (size_t)u.pn * 256 * (256 * 2); s.ldb = 256 * 2; s.nt = 4; } }
        return true; }
};
typedef _Float16 f16v2 __attribute__((ext_vector_type(2)));
__device__ __forceinline__ unsigned pk_h2(float lo, float hi) { const f32x2 v = {lo, hi}; return __builtin_bit_cast(unsigned, __builtin_convertvector(v, f16v2)); }
__device__ __forceinline__ f32x2 un_h2(unsigned w) { return __builtin_convertvector(__builtin_bit_cast(f16v2, w), f32x2); }
struct EpiMerge {
    static constexpr bool PERM = true;
    unsigned char* stash; bf16_t* O;
    template <int KK> static constexpr bool zero_after() { return KK < 3 || KK == 5; }
    template <int KK> __device__ __forceinline__ void run(f32x4 (&acc)[2][2][4][2], const pg8::Seg& u, int wr, int wc, int fr, int fq, int tid) const {
        constexpr int k = KK;
        GAS unsigned char* sbase = (GAS unsigned char*)stash + (size_t)tid * 16; asm volatile("" : "+v"(sbase));
        if constexpr (k < 3) {
            GAS u32x4* st = (GAS u32x4*)(sbase + (size_t)k * 16 * 8192);
#pragma unroll
            for (int j = 0; j < 16; ++j) { const f32x4 v0 = acc[j >> 3][(j >> 2) & 1][j & 3][0], v1 = acc[j >> 3][(j >> 2) & 1][j & 3][1]; u32x4 w;
                w.x = pk_h2(sigmoidf_(v0[0]), sigmoidf_(v0[1])); w.y = pk_h2(sigmoidf_(v0[2]), sigmoidf_(v0[3]));
                w.z = pk_h2(sigmoidf_(v1[0]), sigmoidf_(v1[1])); w.w = pk_h2(sigmoidf_(v1[2]), sigmoidf_(v1[3]));
                st[j * 512] = w; }
        } else if constexpr (k < 5) {
            const GAS u32x4* sa = (const GAS u32x4*)(sbase + (size_t)(k - 3) * 16 * 8192); const GAS u32x4* sb = (const GAS u32x4*)(sbase + (size_t)(k - 2) * 16 * 8192);
#pragma unroll
            for (int hb_ = 0; hb_ < 2; ++hb_) {
            u32x4 p[8], q[8];
#pragma unroll
            for (int j = 0; j < 8; ++j) { p[j] = sa[(hb_ * 8 + j) * 512]; q[j] = sb[(hb_ * 8 + j) * 512]; }
#pragma unroll
            for (int jj = 0; jj < 8; ++jj) { const int j = hb_ * 8 + jj; f32x4& v0 = acc[j >> 3][(j >> 2) & 1][j & 3][0]; f32x4& v1 = acc[j >> 3][(j >> 2) & 1][j & 3][1];
                const f32x2 p0 = un_h2(p[jj].x), p1 = un_h2(p[jj].y), p2 = un_h2(p[jj].z), p3 = un_h2(p[jj].w);
                const f32x2 q0 = un_h2(q[jj].x), q1 = un_h2(q[jj].y), q2 = un_h2(q[jj].z), q3 = un_h2(q[jj].w);
                v0[0] *= p0[0] * __builtin_amdgcn_rcpf(q0[0]); v0[1] *= p0[1] * __builtin_amdgcn_rcpf(q0[1]); v0[2] *= p1[0] * __builtin_amdgcn_rcpf(q1[0]); v0[3] *= p1[1] * __builtin_amdgcn_rcpf(q1[1]);
                v1[0] *= p2[0] * __builtin_amdgcn_rcpf(q2[0]); v1[1] *= p2[1] * __builtin_amdgcn_rcpf(q2[1]); v1[2] *= p3[0] * __builtin_amdgcn_rcpf(q3[0]); v1[3] *= p3[1] * __builtin_amdgcn_rcpf(q3[1]);
                asm volatile("" : "+v"(v0), "+v"(v1)); }
            asm volatile("" ::: "memory"); }
        } else {
            const GAS u32x4* sa = (const GAS u32x4*)(sbase + (size_t)2 * 16 * 8192);
            const int row0 = u.pm * 256 + wr * 64 + fr, col0 = u.pn * 256 + wc * 32 + 8 * fq;
            u32x4 p[16];
#pragma unroll
            for (int j = 0; j < 16; ++j) p[j] = sa[j * 512];
#pragma unroll
            for (int ai = 0; ai < 2; ++ai)
#pragma unroll
                for (int m = 0; m < 4; ++m) { bf16_t* rowp = O + (size_t)(row0 + ai * 128 + m * 16) * D + col0;
#pragma unroll
                    for (int bj = 0; bj < 2; ++bj) { const int j16 = (ai * 2 + bj) * 4 + m; const f32x4 v0 = acc[ai][bj][m][0], v1 = acc[ai][bj][m][1];
                        const f32x2 p0 = un_h2(p[j16].x), p1 = un_h2(p[j16].y), p2 = un_h2(p[j16].z), p3 = un_h2(p[j16].w);
                        u32x4 w; w.x = cvt_pk_bf16(v0[0] * p0[0], v0[1] * p0[1]); w.y = cvt_pk_bf16(v0[2] * p1[0], v0[3] * p1[1]);
                        w.z = cvt_pk_bf16(v1[0] * p2[0], v1[1] * p2[1]); w.w = cvt_pk_bf16(v1[2] * p3[0], v1[3] * p3[1]);
                        *(u32x4*)(rowp + bj * 128) = w; } }
        }
    }
};
struct EpiResid {
    static constexpr bool PERM = false;
    const float *xp, *xs; float* out; float* rowss; unsigned* cnt; const float* g_final; int fused;
    template <int KK> static constexpr bool zero_after() { return true; }
    template <int KK> __device__ __forceinline__ void run(f32x4 (&acc)[2][2][4][2], const pg8::Seg& u, int wr, int wc, int fr, int fq, int tid) const {
        const int row0 = u.pm * 256 + wr * 64 + fr, col0 = u.pn * 256 + wc * 32 + 4 * fq;
#pragma unroll
        for (int ai = 0; ai < 2; ++ai) {
            f32x4 xv[4][4];
#pragma unroll
            for (int m = 0; m < 4; ++m) { const int r = row0 + ai * 128 + m * 16; const float* xr = (r < TP ? xp + (size_t)r * D : xs + (size_t)(r - TP) * D) + col0;
#pragma unroll
                for (int bj = 0; bj < 2; ++bj)
#pragma unroll
                    for (int n = 0; n < 2; ++n) xv[m][bj * 2 + n] = *(const f32x4*)(xr + bj * 128 + n * 16); }
#pragma unroll
            for (int m = 0; m < 4; ++m) { const int r = row0 + ai * 128 + m * 16; float* orow = out + (size_t)r * D + col0; float ss = 0.f;
#pragma unroll
                for (int bj = 0; bj < 2; ++bj)
#pragma unroll
                    for (int n = 0; n < 2; ++n) { const f32x4 y = xv[m][bj * 2 + n] + acc[ai][bj][m][n]; acc[ai][bj][m][n] = y;
                        ss += (y[0] * y[0] + y[1] * y[1]) + (y[2] * y[2] + y[3] * y[3]); if (!fused) *(f32x4*)(orow + bj * 128 + n * 16) = y; }
                ss += __shfl_xor(ss, 16); ss += __shfl_xor(ss, 32);
                if (fq == 0) { float* slot = rowss + (size_t)r * 16 + u.pn * 4 + wc; if (fused) __hip_atomic_store(slot, ss, __ATOMIC_RELAXED, __HIP_MEMORY_SCOPE_AGENT); else *slot = ss; } }
            asm volatile("" ::: "memory"); }
        if (!fused) return;
        asm volatile("s_waitcnt vmcnt(0)" ::: "memory");
        unsigned* cw = cnt + 64 * u.pm + 16 * wr;
        if ((tid & 63) == 0) __hip_atomic_fetch_add(cw, 1u, __ATOMIC_RELAXED, __HIP_MEMORY_SCOPE_AGENT);
        { const unsigned long long t0 = __builtin_amdgcn_s_memrealtime();
          while ((unsigned)__builtin_amdgcn_readfirstlane(__hip_atomic_load(cw, __ATOMIC_RELAXED, __HIP_MEMORY_SCOPE_AGENT)) < 16u) {
              if (__builtin_amdgcn_s_memrealtime() - t0 > 2000000ull) break;
              __builtin_amdgcn_s_sleep(2); } }
        __builtin_amdgcn_fence(__ATOMIC_ACQUIRE, "agent");
        asm volatile("s_waitcnt vmcnt(0)" ::: "memory");
        unsigned long long pl[8][2];
#pragma unroll
        for (int ai = 0; ai < 2; ++ai)
#pragma unroll
            for (int m = 0; m < 4; ++m) { const int r = row0 + ai * 128 + m * 16; const unsigned long long* pp = (const unsigned long long*)(rowss + (size_t)r * 16 + fq * 4);
                pl[ai * 4 + m][0] = __hip_atomic_load(pp, __ATOMIC_RELAXED, __HIP_MEMORY_SCOPE_AGENT); pl[ai * 4 + m][1] = __hip_atomic_load(pp + 1, __ATOMIC_RELAXED, __HIP_MEMORY_SCOPE_AGENT); }
        f32x4 gf[4];
#pragma unroll
        for (int bj = 0; bj < 2; ++bj)
#pragma unroll
            for (int n = 0; n < 2; ++n) gf[bj * 2 + n] = *(const f32x4*)(g_final + col0 + bj * 128 + n * 16);
#pragma unroll
        for (int ai = 0; ai < 2; ++ai)
#pragma unroll
            for (int m = 0; m < 4; ++m) { const int r = row0 + ai * 128 + m * 16; float* orow = out + (size_t)r * D + col0;
                const unsigned long long w0 = pl[ai * 4 + m][0], w1 = pl[ai * 4 + m][1];
                float t = (__uint_as_float((unsigned)w0) + __uint_as_float((unsigned)(w0 >> 32))) + (__uint_as_float((unsigned)w1) + __uint_as_float((unsigned)(w1 >> 32)));
                t += __shfl_xor(t, 16); t += __shfl_xor(t, 32);
                const float rstd = 1.0f / sqrtf(t * (1.0f / D) + EPS);
#pragma unroll
                for (int bj = 0; bj < 2; ++bj)
#pragma unroll
                    for (int n = 0; n < 2; ++n) *(f32x4*)(orow + bj * 128 + n * 16) = acc[ai][bj][m][n] * rstd * gf[bj * 2 + n]; }
    }
};

__device__ __forceinline__ void p0_transpose_item(const float* W, int K, int N, bf16_t* WT, LAS float* scr, int item, int lane) {
    const int nblk = N / 32, kb = item / nblk, nb = item % nblk, k0 = 64 * kb, n0 = 32 * nb;
#pragma unroll 8
    for (int i = 0; i < 32; ++i) { const int kk = 2 * i + (lane >> 5); scr[kk * 33 + (lane & 31)] = W[(size_t)(k0 + kk) * N + n0 + (lane & 31)]; }
    asm volatile("s_waitcnt lgkmcnt(0)" ::: "memory");
    const int c = lane & 7;
#pragma unroll
    for (int j = 0; j < 4; ++j) { const int n = (lane >> 3) + 8 * j; const LAS float* s = scr + (8 * c) * 33 + n;
        u32x4 o; o.x = cvt_pk_bf16(s[0 * 33], s[1 * 33]); o.y = cvt_pk_bf16(s[2 * 33], s[3 * 33]); o.z = cvt_pk_bf16(s[4 * 33], s[5 * 33]); o.w = cvt_pk_bf16(s[6 * 33], s[7 * 33]);
        *(u32x4*)(WT + (size_t)(n0 + n) * K + k0 + 8 * c) = o; }
    asm volatile("s_waitcnt lgkmcnt(0)" ::: "memory");
}
__device__ __forceinline__ void rms_row_to_bf16(const float* xrow, const float* g, bf16_t* orow, int lane) {
    const f32x4* xr = (const f32x4*)xrow + lane; const f32x4* gr = (const f32x4*)g + lane;
    f32x4 v[4]; float s = 0.f;
#pragma unroll
    for (int j = 0; j < 4; ++j) { v[j] = xr[64 * j]; s += (v[j][0] * v[j][0] + v[j][1] * v[j][1]) + (v[j][2] * v[j][2] + v[j][3] * v[j][3]); }
    const float rstd = 1.0f / sqrtf(wave_sum(s) * (1.0f / D) + EPS);
    u32x2* o8 = (u32x2*)orow + lane;
#pragma unroll
    for (int j = 0; j < 4; ++j) { const f32x4 gv = gr[64 * j]; u32x2 w; w.x = cvt_pk_bf16(v[j][0] * rstd * gv[0], v[j][1] * rstd * gv[1]); w.y = cvt_pk_bf16(v[j][2] * rstd * gv[2], v[j][3] * rstd * gv[3]); o8[64 * j] = w; }
}
__device__ __forceinline__ void rms_rows4_to_bf16(const float* const (&xrow)[4], const float* g, bf16_t* const (&orow)[4], int lane) {
    f32x4 v[4][4]; float s[4];
#pragma unroll
    for (int r = 0; r < 4; ++r) { const f32x4* xr = (const f32x4*)xrow[r] + lane;
#pragma unroll
        for (int j = 0; j < 4; ++j) v[r][j] = xr[64 * j]; }
#pragma unroll
    for (int r = 0; r < 4; ++r) { float t = 0.f;
#pragma unroll
        for (int j = 0; j < 4; ++j) t += (v[r][j][0] * v[r][j][0] + v[r][j][1] * v[r][j][1]) + (v[r][j][2] * v[r][j][2] + v[r][j][3] * v[r][j][3]);
        s[r] = 1.0f / sqrtf(wave_sum(t) * (1.0f / D) + EPS); }
    const f32x4* gr = (const f32x4*)g + lane;
#pragma unroll
    for (int j = 0; j < 4; ++j) { const f32x4 gv = gr[64 * j];
#pragma unroll
        for (int r = 0; r < 4; ++r) { u32x2 w; w.x = cvt_pk_bf16(v[r][j][0] * s[r] * gv[0], v[r][j][1] * s[r] * gv[1]); w.y = cvt_pk_bf16(v[r][j][2] * s[r] * gv[2], v[r][j][3] * s[r] * gv[3]);
            ((u32x2*)orow[r] + lane)[64 * j] = w; } }
}
__device__ __forceinline__ unsigned short f2bf(float f) { return (unsigned short)(cvt_pk_bf16(f, 0.f) & 0xffffu); }
__device__ __forceinline__ float cosrev(float x) { return __builtin_amdgcn_cosf(x); }
__device__ __forceinline__ float sinrev(float x) { return __builtin_amdgcn_sinf(x); }

__device__ __forceinline__ unsigned kv_off(int key, int chunk) { return (unsigned)(key * 128 + ((chunk ^ (key & 7)) << 4)); }
struct QG { bf16x8 q0, q1; };
__device__ __forceinline__ QG load_qg(const bf16_t* qrow, const bf16_t*, int fq) {
    QG r; r.q0 = *(const bf16x8*)(qrow + 8 * fq); r.q1 = *(const bf16x8*)(qrow + 32 + 8 * fq);
    return r;
}
template <bool NA>
__device__ __forceinline__ void attn16(LAS unsigned char* Kimg, LAS unsigned char* Vimg, const LAS float* rpbs, const int (&krow)[8], const QG& in,
                                       bf16_t* gate_out  , int fr, int fq, int lane,
                                       int qcol, int c0, int drbase  ) {
    u32x2 gin[4];
#pragma unroll
    for (int db = 0; db < 4; ++db) gin[db] = *(const u32x2*)(gate_out + 16 * db + 4 * fq);
    const unsigned kl0 = (unsigned)(fr * 128 + ((fq ^ (fr & 7)) << 4)), kl1 = (unsigned)(fr * 128 + (((4 + fq) ^ (fr & 7)) << 4));
    f32x4 sacc[16];
#pragma unroll
    for (int kb = 0; kb < 16; ++kb) {
        LAS unsigned char* kp = Kimg + (krow[kb >> 1] + (kb & 1) * 16) * 128;
        f32x4 a = (f32x4){0.f, 0.f, 0.f, 0.f};
        a = mfma16(*(const LAS bf16x8*)(kp + kl0), in.q0, a);
        a = mfma16(*(const LAS bf16x8*)(kp + kl1), in.q1, a);
        sacc[kb] = a;
    }
    const float L2E = 1.4426950408889634f * 0.125f;
    float mx = -3.0e38f, sum = 0.f;
    if (NA) {
        const int cs = min(max(qcol - 8, 0), 48), relb = c0 + 4 * fq - cs;
        const LAS float* bp = rpbs + (drbase * 31 + c0 + 4 * fq - qcol + 15);
        bool valid[2][4];
#pragma unroll
        for (int hc = 0; hc < 2; ++hc)
#pragma unroll
            for (int i = 0; i < 4; ++i) valid[hc][i] = (unsigned)(relb + 16 * hc + i) < 16u;
#pragma unroll
        for (int kb = 0; kb < 16; ++kb)
#pragma unroll
            for (int i = 0; i < 4; ++i) { float sv = __builtin_fmaf(sacc[kb][i], L2E, bp[(kb >> 1) * 31 + 16 * (kb & 1) + i]); sv = valid[kb & 1][i] ? sv : -3.0e38f; sacc[kb][i] = sv; mx = fmaxf(mx, sv); }
        mx = fmaxf(mx, __shfl_xor(mx, 16)); mx = fmaxf(mx, __shfl_xor(mx, 32));
#pragma unroll
        for (int kb = 0; kb < 16; ++kb)
#pragma unroll
            for (int i = 0; i < 4; ++i) { const float p = __builtin_amdgcn_exp2f(sacc[kb][i] - mx); sacc[kb][i] = p; sum += p; }
    } else {
#pragma unroll
        for (int kb = 0; kb < 16; ++kb)
#pragma unroll
            for (int i = 0; i < 4; ++i) mx = fmaxf(mx, sacc[kb][i]);
        mx = fmaxf(mx, __shfl_xor(mx, 16)); mx = fmaxf(mx, __shfl_xor(mx, 32));
        const float mb = -mx * L2E;
#pragma unroll
        for (int kb = 0; kb < 16; ++kb)
#pragma unroll
            for (int i = 0; i < 4; ++i) { const float p = __builtin_amdgcn_exp2f(__builtin_fmaf(sacc[kb][i], L2E, mb)); sacc[kb][i] = p; sum += p; }
    }
    sum += __shfl_xor(sum, 16); sum += __shfl_xor(sum, 32);
    const float inv = 1.0f / sum;
    bf16x8 pf[8];
#pragma unroll
    for (int s = 0; s < 8; ++s) pf[s] = pack8(sacc[2 * s], sacc[2 * s + 1]);
    const int q4 = (lane & 15) >> 2, p4 = lane & 3, kl = 4 * fq + q4;
    unsigned vl[4];
#pragma unroll
    for (int db = 0; db < 4; ++db) vl[db] = (unsigned)(kl * 128 + (((2 * db + (p4 >> 1)) ^ (kl & 7)) << 4) + 8 * (p4 & 1));
    f32x4 oacc[4];
#pragma unroll
    for (int db = 0; db < 4; ++db) oacc[db] = (f32x4){0.f, 0.f, 0.f, 0.f};
#pragma unroll
    for (int s = 0; s < 8; ++s) {
        LAS unsigned char* vp = Vimg + krow[s] * 128;
#pragma unroll
        for (int db = 0; db < 4; ++db) {
            const s16x4 v0 = tr_read(vp + vl[db]);
            const s16x4 v1 = tr_read(vp + 2048 + vl[db]);
            oacc[db] = mfma16(cat4(v0, v1), pf[s], oacc[db]);
        }
        if (s & 1) __builtin_amdgcn_sched_barrier(0);
    }
#pragma unroll
    for (int db = 0; db < 4; ++db) { const u32x2 gv = gin[db]; u32x2 w;
        w.x = cvt_pk_bf16(oacc[db][0] * inv * siluf_(bf_lo(gv.x)), oacc[db][1] * inv * siluf_(bf_hi(gv.x)));
        w.y = cvt_pk_bf16(oacc[db][2] * inv * siluf_(bf_lo(gv.y)), oacc[db][3] * inv * siluf_(bf_hi(gv.y)));
        *(u32x2*)(gate_out + 16 * db + 4 * fq) = w; }
}

#define XB_TMO      128
#define XB_XCNT(j)  (256  + 64 * (j))
#define XB_XSUB(j)  (1280 + 64 * (j))
#define XB_XGEN(j)  (2304 + 64 * (j))
#define XB_TOP      3328
#define XB_TOPGEN   3392
#define XCD_BAR_WORDS 3456
#define XB_SPIN_CAP (1u << 18)
__device__ __forceinline__ unsigned xb_ld(unsigned* p)              { return __hip_atomic_load(p, __ATOMIC_RELAXED, __HIP_MEMORY_SCOPE_AGENT); }
__device__ __forceinline__ unsigned xb_add(unsigned* p, unsigned v) { return __hip_atomic_fetch_add(p, v, __ATOMIC_RELAXED, __HIP_MEMORY_SCOPE_AGENT); }
__device__ __forceinline__ unsigned xb_xcc_id() { return (unsigned)__builtin_amdgcn_s_getreg((3 << 11) | 20) & 0xFu; }
#define XB_SPIN(cond, bar) do { unsigned _sp = 0; while (cond) { __builtin_amdgcn_s_sleep(1); \
    if ((++_sp & 255u) == 0u) { if (xb_ld(&(bar)[XB_TMO])) break; if (_sp > XB_SPIN_CAP) { atomicAdd(&(bar)[XB_TMO], 1u); break; } } } } while (0)
struct XcdBarrier { unsigned* bar; unsigned x; volatile LAS unsigned* st; };
__device__ __forceinline__ XcdBarrier xcd_barrier_post(unsigned* bar, volatile LAS unsigned* st) {
    XcdBarrier b; b.bar = bar; b.x = xb_xcc_id(); b.st = st;
    if (threadIdx.x == 0) st[2] = xb_add(&bar[XB_XCNT(b.x)], 1u);
    return b;
}
__device__ __forceinline__ void xcd_barrier_complete(unsigned* bar, unsigned x, unsigned& nloc, unsigned& nx) {
    const unsigned G = gridDim.x * gridDim.y * gridDim.z;
    unsigned sum, cnt, mine, sp = 0u;
    for (;;) {
        sum = 0u; cnt = 0u; mine = 0u;
#pragma unroll
        for (unsigned j = 0; j < 16; ++j) { const unsigned c = xb_ld(&bar[XB_XCNT(j)]); sum += c; cnt += (c > 0u) ? 1u : 0u; mine = (j == x) ? c : mine; }
        if (sum == G) break;
        __builtin_amdgcn_s_sleep(1);
        if ((++sp & 255u) == 0u) { if (xb_ld(&bar[XB_TMO])) break; if (sp > XB_SPIN_CAP) { atomicAdd(&bar[XB_TMO], 1u); break; } }
    }
    nloc = mine > 0u ? mine : 1u; nx = cnt > 0u ? cnt : 1u;
}
__device__ __forceinline__ void xcd_barrier(const XcdBarrier& b) {
    asm volatile("s_waitcnt vmcnt(0)" ::: "memory");
    __syncthreads();
    if (threadIdx.x == 0) {
        unsigned* bar = b.bar;
        __builtin_amdgcn_s_waitcnt(0);
        unsigned nloc = b.st[0], nx = b.st[1];
        if (nloc == 0u) { xcd_barrier_complete(bar, b.x, nloc, nx); b.st[0] = nloc; b.st[1] = nx; }
        const unsigned old = xb_add(&bar[XB_XSUB(b.x)], 1u);
        const unsigned gen = old / nloc;
        if (old + 1u == (gen + 1u) * nloc) {
            __builtin_amdgcn_fence(__ATOMIC_RELEASE, "agent");
            asm volatile("s_waitcnt vmcnt(0)" ::: "memory");
            const unsigned og = xb_add(&bar[XB_TOP], 1u);
            const unsigned tg = og / nx;
            if (og + 1u == (tg + 1u) * nx) xb_add(&bar[XB_TOPGEN], 1u);
            else XB_SPIN(xb_ld(&bar[XB_TOPGEN]) == tg, bar);
            __builtin_amdgcn_fence(__ATOMIC_ACQUIRE, "agent");
            xb_add(&bar[XB_XGEN(b.x)], 1u);
            asm volatile("s_waitcnt vmcnt(0)" ::: "memory");
        } else {
            XB_SPIN(xb_ld(&bar[XB_XGEN(b.x)]) == gen, bar);
            __builtin_amdgcn_fence(__ATOMIC_ACQUIRE, "agent");
            asm volatile("s_waitcnt vmcnt(0)" ::: "memory");
        }
    }
    __syncthreads();
}

__global__ void __launch_bounds__(NTHREADS) mk_fwd(Args a) {
    extern __shared__ __attribute__((aligned(16))) unsigned char lds_raw[];
    LAS unsigned char* lds = (LAS unsigned char*)lds_raw;
    cg::grid_group grid = cg::this_grid();
    const int wid = __builtin_amdgcn_readfirstlane((int)threadIdx.x >> 6);
    const int G = gridDim.x, blk = blockIdx.x;
#define PHASE_LANES const int tid = threadIdx.x, lane = tid & 63, fr = lane & 15, fq = lane >> 4; (void)tid; (void)lane; (void)fr; (void)fq
    unsigned char* ws = a.ws; unsigned char* ob = (unsigned char*)a.out;
    bf16_t* z1 = (bf16_t*)(ws + WS_Z1); bf16_t* merged = (bf16_t*)(ws + WS_MERGED);
    bf16_t* WinT = (bf16_t*)(ws + WS_WIN); bf16_t* WkvT = (bf16_t*)(ws + WS_WKV); bf16_t* WfoT = (bf16_t*)(ws + WS_WFO); bf16_t* WnaT = (bf16_t*)(ws + WS_WNA);
    bf16_t* WcaT = (bf16_t*)(ws + WS_WCA); bf16_t* WoutT = (bf16_t*)(ws + WS_WOUT); bf16_t* kvmem = (bf16_t*)(ws + WS_KVMEM); bf16_t* memn = (bf16_t*)(ws + WS_MEMN);
    float* rowss = (float*)(ws + WS_ROWSS);
    bf16_t* tab64 = (bf16_t*)(ws + WS_TAB64); bf16_t* tab128 = (bf16_t*)(ws + WS_TAB128); bf16_t* tabC = (bf16_t*)(ws + WS_TABC);
    bf16_t* hb = (bf16_t*)(ob + OUT_HB); bf16_t* T2 = (bf16_t*)(ob + OUT_T2);
    const int lo = a.ph_lo, hi = a.ph_hi;
    volatile LAS unsigned* xbst = (volatile LAS unsigned*)(lds + LDS_BYTES - 16);
    if (threadIdx.x == 0) { xbst[0] = 0u; xbst[1] = 0u; xbst[2] = 0u; xbst[3] = 0u; }
    __syncthreads();
    XcdBarrier xb = xcd_barrier_post((unsigned*)(ws + WS_BAR), xbst);
    if (a.ph_hi < 0) grid.sync();
#ifndef SKIPMASK
#define SKIPMASK 0
#endif
#define IN(k) (!((SKIPMASK >> (k)) & 1) && lo <= (k) && (k) < hi)
#ifndef REPMASK
#define REPMASK 0
#endif
#define REPS(k) (1 + ((REPMASK >> (k)) & 1))
#ifndef CG_SEAMS
#define CG_SEAMS 0
#endif
#define SEAM(k) do { if (IN(k) && IN((k) + 1)) { if ((k) < CG_SEAMS) grid.sync(); else xcd_barrier(xb); } } while (0)

    if (IN(0)) for (int rep_ = 0; rep_ < REPS(0); ++rep_) {
        PHASE_LANES;
        LAS float* scr = (LAS float*)(lds + wid * 16384);
        const int gw = blk * 8 + wid, NGW = G * 8;
        constexpr int I_IN = 16 * (NIN / 32), I_KV = 16 * 16, I_FO = 6 * 32, I_NA = 6 * 32, I_CA = 4 * 32, I_OUT = 16 * 32;
        constexpr int NITEMS = I_IN + I_KV + I_FO + I_NA + I_CA + I_OUT;
        for (int it = gw; it < NITEMS; it += NGW) {
            int r = it;
            if (r < I_IN) { p0_transpose_item(a.w_in, D, NIN, WinT, scr, r, lane); continue; } r -= I_IN;
            if (r < I_KV) { p0_transpose_item(a.w_kv, D, 512, WkvT, scr, r, lane); continue; } r -= I_KV;
            if (r < I_FO) { p0_transpose_item(a.w_fo, 384, D, WfoT, scr, r, lane); continue; } r -= I_FO;
            if (r < I_NA) { p0_transpose_item(a.w_na, 384, D, WnaT, scr, r, lane); continue; } r -= I_NA;
            if (r < I_CA) { p0_transpose_item(a.w_ca, 256, D, WcaT, scr, r, lane); continue; } r -= I_CA;
            p0_transpose_item(a.w_out, D, D, WoutT, scr, r, lane);
        }
        for (int m4 = gw; m4 < T / 4; m4 += NGW) { const float* xr[4]; bf16_t* orw[4];
#pragma unroll
            for (int r = 0; r < 4; ++r) { const int m = 4 * m4 + r; xr[r] = m < TP ? a.xp + (size_t)m * D : a.xs + (size_t)(m - TP) * D; orw[r] = hb + (size_t)m * D; }
            rms_rows4_to_bf16(xr, a.g_norm, orw, lane); }
        for (int m = gw; m < NMEMROWS; m += NGW) rms_row_to_bf16(m < 2048 ? a.memp + (size_t)m * D : a.mems + (size_t)(m - 2048) * D, a.g_mem, memn + (size_t)m * D, lane);
        const int gt = blk * NTHREADS + tid, NT = G * NTHREADS;
        for (int i = gt; i < 64 * 64; i += NT) { const int k = i >> 6, n = i & 63; const float f = (float)((k * n) & 63) * (1.0f / 64.0f); const float c = cosrev(f), s = sinrev(f);
            tab64[i] = f2bf(c); tab64[4096 + i] = f2bf(-s); tab64[8192 + i] = f2bf(s); }
        for (int i = gt; i < 128 * 128; i += NT) { const int k = i >> 7, n = i & 127; const float f = (float)((k * n) & 127) * (1.0f / 128.0f); const float c = cosrev(f), s = sinrev(f);
            tab128[i] = f2bf(c); tab128[16384 + i] = f2bf(-s); tab128[32768 + i] = f2bf(s); }
        for (int i = gt; i < 1024; i += NT) ((unsigned*)(ws + WS_CNT))[64 * (i >> 1) + 16 * (i & 1)] = 0u;
        for (int i = gt; i < 96 * 96; i += NT) { const int l = i / 96, kap = i % 96; const int s = kap >> 5, g = (kap & 31) >> 3, j = kap & 7; const int m = 32 * s + 16 * (j >> 2) + 4 * g + (j & 3);
            const float f = (float)((m * l) % 96) * (1.0f / 96.0f); tabC[i] = f2bf(cosrev(f)); tabC[9216 + i] = f2bf(sinrev(f)); }
    }
    SEAM(0);
    int vblk = blk;
    if (IN(0) && IN(1)) {
        if (threadIdx.x == 0) { unsigned* bar = (unsigned*)(ws + WS_BAR); bool ok = (G % 8 == 0);
            for (int j = 0; j < 16; ++j) { const unsigned cj = xb_ld(&bar[XB_XCNT(j)]); ok = ok && (cj == (j < 8 ? (unsigned)(G / 8) : 0u)); }
            xbst[3] = ok ? (xbst[2] * 8u + xb.x) : (unsigned)blk; }
        __syncthreads();
        vblk = __builtin_amdgcn_readfirstlane((int)xbst[3]);
    }

    if (IN(1)) {
        { PlainStream S; S.so.init(T, NZ, G, vblk, REPS(1)); S.A = (const char*)hb; S.B = (const char*)WinT; S.lda = D * 2; S.ldb = D * 2; S.nt = 16;
          EpiStoreBf16 E{z1, NZ}; pg8::gemm_stream<1>(lds, S, E); }
        { PlainStream S; S.so.init(NMEMROWS, 512, G, blk); S.A = (const char*)memn; S.B = (const char*)WkvT; S.lda = D * 2; S.ldb = D * 2; S.nt = 16;
          EpiStoreBf16 E{kvmem, 512}; pg8::gemm_stream<1>(lds, S, E); }
    }
    SEAM(1);

    if (IN(2)) {
        PHASE_LANES;
        {
            LAS unsigned char* Kimg = lds; LAS unsigned char* Vimg = lds + 576 * 128; LAS float* rpbs = (LAS float*)(lds + 2 * 576 * 128);
            constexpr int NITEMS = 768;
            for (int it = blk; it < NITEMS; it += G) {
                int q, chunk, h, R;
                if (it < 384) { h = it % 6; const int t2 = it / 6; chunk = t2 & 7; q = t2 >> 3; R = 128; }
                else { const int i2 = it - 384; h = i2 % 6; const int t2 = i2 / 6; chunk = t2 & 3; q = 8 + (t2 >> 2); R = 64; }
                const int sb = seq_base(q), rowbase = 16 * chunk;
                const bf16_t* kvbase = z1 + (size_t)sb * NZ + h * 64;
                int rb = min(max(rowbase - 4, 0), R - 8), hi = min(rb + 8, R - 1);
                __syncthreads();
                for (int c = tid; c < (hi - rb + 1) * 512; c += NTHREADS) { const int row = rb + (c >> 9), col = (c >> 3) & 63, ch = c & 7, key = (row % 9) * 64 + col;
                    const bf16_t* src = kvbase + (size_t)(row * 64 + col) * NZ + ch * 8;
                    *(LAS u32x4*)(Kimg + kv_off(key, ch)) = *(const u32x4*)(src + C_K); *(LAS u32x4*)(Vimg + kv_off(key, ch)) = *(const u32x4*)(src + C_V); }
                for (int c = tid; c < 465; c += NTHREADS) rpbs[c] = a.rpb[h * 465 + c] * 1.4426950408889634f;
                const int j = wid & 3, c0 = min(max(16 * j - 8, 0), 32), pcol = tid >> 3, pch = tid & 7;
                bf16_t* trow = z1 + (size_t)(sb + (rowbase + (wid >> 2)) * 64 + 16 * j + fr) * NZ;
                QG cur = load_qg(trow + C_Q + h * 64, trow + C_GNA + h * 64, fq);
                __syncthreads();
#pragma unroll 1
                for (int bi = 0; bi < 8; ++bi) {
                    const int r0 = rowbase + 2 * bi, r = r0 + (wid >> 2), rs = min(max(r - 4, 0), R - 8);
                    const int rb2 = min(max(r0 + 2 - 4, 0), R - 8), hi2 = (bi < 7) ? min(rb2 + 8, R - 1) : hi;
                    const int nrow0 = min(hi + 1, R - 1), nrow1 = min(hi + 2, R - 1);
                    const bf16_t* s0 = kvbase + (size_t)(nrow0 * 64 + pcol) * NZ + pch * 8; const bf16_t* s1 = kvbase + (size_t)(nrow1 * 64 + pcol) * NZ + pch * 8;
                    const u32x4 pk0 = *(const u32x4*)(s0 + C_K), pv0 = *(const u32x4*)(s0 + C_V), pk1 = *(const u32x4*)(s1 + C_K), pv1 = *(const u32x4*)(s1 + C_V);
                    bf16_t* trow2 = trow + (size_t)(bi < 7 ? 128 : 0) * NZ;
                    const QG nxt = load_qg(trow2 + C_Q + h * 64, trow2 + C_GNA + h * 64, fq);
                    int krow[8]; { const int sl0 = rs % 9;
#pragma unroll
                        for (int kr = 0; kr < 8; ++kr) { int sl = sl0 + kr; sl = sl >= 9 ? sl - 9 : sl; krow[kr] = sl * 64 + c0; } }
                    attn16<true>(Kimg, Vimg, rpbs, krow, cur, trow + C_GNA + h * 64, fr, fq, lane, 16 * j + fr, c0, rs - r + 7);
                    __syncthreads();
                    if (hi + 1 <= hi2) { const int key = ((hi + 1) % 9) * 64 + pcol; *(LAS u32x4*)(Kimg + kv_off(key, pch)) = pk0; *(LAS u32x4*)(Vimg + kv_off(key, pch)) = pv0; }
                    if (hi + 2 <= hi2) { const int key = ((hi + 2) % 9) * 64 + pcol; *(LAS u32x4*)(Kimg + kv_off(key, pch)) = pk1; *(LAS u32x4*)(Vimg + kv_off(key, pch)) = pv1; }
                    __syncthreads();
                    hi = hi2; cur = nxt; trow = trow2;
                }
            }
        }
        {
            LAS unsigned char* Kimg = lds; LAS unsigned char* Vimg = lds + 256 * 128;
            constexpr int NITEMS = 512;
            int krow[8];
#pragma unroll
            for (int kr = 0; kr < 8; ++kr) krow[kr] = kr * 32;
            for (int it = blk; it < NITEMS; it += G) {
                int q, h, ck;
                if (it < 256) { ck = it & 7; h = (it >> 3) & 3; q = it >> 5; } else { const int i2 = it - 256; ck = i2 & 3; h = (i2 >> 2) & 3; q = 8 + (i2 >> 4); }
                const int tok0 = seq_base(q) + ck * 1024;
                __syncthreads();
                for (int c = tid; c < 256 * 8; c += NTHREADS) { const int key = c >> 3, ch = c & 7; const bf16_t* src = kvmem + (size_t)(q * 256 + key) * 512 + h * 64 + ch * 8;
                    *(LAS u32x4*)(Kimg + kv_off(key, ch)) = *(const u32x4*)(src); *(LAS u32x4*)(Vimg + kv_off(key, ch)) = *(const u32x4*)(src + 256); }
                bf16_t* trow = z1 + (size_t)(tok0 + wid * 128 + fr) * NZ;
                QG cur = load_qg(trow + C_QCA + h * 64, trow + C_GCA + h * 64, fq);
                __syncthreads();
#pragma unroll 1
                for (int i = 0; i < 8; ++i) { bf16_t* trow2 = trow + (size_t)(i < 7 ? 16 : 0) * NZ;
                    const QG nxt = load_qg(trow2 + C_QCA + h * 64, trow2 + C_GCA + h * 64, fq);
                    attn16<false>(Kimg, Vimg, nullptr, krow, cur, trow + C_GCA + h * 64, fr, fq, lane, 0, 0, 0);
                    cur = nxt; trow = trow2; }
            }
        }
        for (int rep_ = 0; rep_ < REPS(7); ++rep_)
        {
            constexpr int US = 784;
            constexpr int NITEMS = 2048;
            bf16x8 af[8][2];
#pragma unroll
            for (int mb = 0; mb < 8; ++mb)
#pragma unroll
                for (int ks = 0; ks < 2; ++ks) af[mb][ks] = *(const bf16x8*)(tab64 + (mb >> 2) * 4096 + ((mb & 3) * 16 + fr) * 64 + 32 * ks + 8 * fq);
            const int q4 = (lane & 15) >> 2, p4 = lane & 3;
            for (int it = blk; it < NITEMS; it += G) {
                int q, n2, N2, S;
                if (it < 1024) { q = it >> 7; n2 = it & 127; N2 = 128; S = 8192; } else { const int i2 = it - 1024; q = 8 + (i2 >> 6); n2 = i2 & 63; N2 = 64; S = 4096; }
                const int sb = seq_base(q);
                __syncthreads();
                for (int c = tid; c < 64 * 48; c += NTHREADS) { const int n1 = c / 48, ch = c % 48;
                    *(LAS u32x4*)(lds + n1 * US + ch * 16) = *(const u32x4*)(z1 + (size_t)(sb + N2 * n1 + n2) * NZ + C_UF + ch * 8); }
                __syncthreads();
                const float invS = 1.0f / (float)S;
#pragma unroll 1
                for (int cc = 0; cc < 3; ++cc) {
                    const int c = wid * 3 + cc;
                    bf16x8 bfr[2];
#pragma unroll
                    for (int ks = 0; ks < 2; ++ks) { LAS unsigned char* p = lds + (32 * ks + 8 * fq + q4) * US + (16 * c + 4 * p4) * 2; bfr[ks] = cat4(tr_read(p), tr_read(p + 4 * US)); }
                    f32x4 acc[8];
#pragma unroll
                    for (int mb = 0; mb < 8; ++mb) { f32x4 v = (f32x4){0.f, 0.f, 0.f, 0.f}; v = mfma16(af[mb][0], bfr[0], v); v = mfma16(af[mb][1], bfr[1], v); acc[mb] = v; }
                    const int ch = 16 * c + fr, grp = ch / 96, mm = ch - grp * 96;
#pragma unroll
                    for (int mb = 0; mb < 4; ++mb)
#pragma unroll
                        for (int i = 0; i < 4; ++i) { const int k1 = mb * 16 + 4 * fq + i; const float f = (float)((n2 * k1) & (S - 1)) * invS; const float cs = cosrev(f), sn = sinrev(f);
                            const float tr = acc[mb][i], ti = acc[mb + 4][i]; bf16_t* dst = T2 + (size_t)(sb + k1 * N2 + n2) * 768 + grp * 192 + mm;
                            dst[0] = f2bf(tr * cs + ti * sn); dst[96] = f2bf(ti * cs - tr * sn); }
                }
            }
        }
    }
    SEAM(2);

    if (IN(3)) {
        PHASE_LANES;
        constexpr int TS = 400;
        constexpr int NITEMS = 4096;
        const int q4 = (lane & 15) >> 2, p4 = lane & 3;
#define FC_DECODE(IT, BIG, Q, K1, GG, SB) const bool BIG = (IT) < 2048; const int GG = BIG ? ((IT) & 3) : (((IT) - 2048) & 1), K1 = BIG ? (((IT) >> 2) & 63) : ((((IT) - 2048) >> 1) & 63), \
        Q = BIG ? ((IT) >> 8) : (8 + (((IT) - 2048) >> 7)), SB = seq_base(Q)
#define FC_LOAD_TILE(DST, BIG, K1, GG, SB) do { _Pragma("unroll") for (int i_ = 0; i_ < 6; ++i_) { const int c_ = tid + NTHREADS * i_, rr_ = c_ / 24, ch_ = c_ - rr_ * 24; \
        const size_t row_ = BIG ? (size_t)(SB + K1 * 128 + rr_) : (size_t)(SB + K1 * 64 + (rr_ & 63)); const int gcol_ = BIG ? GG * 192 : (2 * GG + (rr_ >> 6)) * 192; \
        DST[i_] = *(const u32x4*)(T2 + row_ * 768 + gcol_ + ch_ * 8); } } while (0)
#define FC_STORE_TILE(SRC) do { _Pragma("unroll") for (int i_ = 0; i_ < 6; ++i_) { const int c_ = tid + NTHREADS * i_, rr_ = c_ / 24, ch_ = c_ - rr_ * 24; *(LAS u32x4*)(lds + rr_ * TS + ch_ * 16) = SRC[i_]; } } while (0)
#define FC_GATE_ROW(BIG, K1, GG, SB) (z1 + (size_t)(SB + K1 + 64 * (16 * (BIG ? wid : (wid & 3)) + fr)) * NZ + C_GF + (BIG ? GG : 2 * GG + (wid >> 2)) * 96 + 4 * fq)
        constexpr int TC_OFF = 128 * TS;
        for (int c = tid; c < 2 * 9216 / 8; c += NTHREADS) *(LAS u32x4*)(lds + TC_OFF + c * 16) = *(const u32x4*)(tabC + c * 8);
        bf16x8 wfr[4][3];
        int wmode = -1;
        u32x4 pre[6]; u32x2 gcur[6];
        int it = blk;
        if (it < NITEMS) { FC_DECODE(it, big0, q0_, k10, g0_, sb0); FC_LOAD_TILE(pre, big0, k10, g0_, sb0); const bf16_t* gr = FC_GATE_ROW(big0, k10, g0_, sb0);
#pragma unroll
            for (int lb = 0; lb < 6; ++lb) gcur[lb] = *(const u32x2*)(gr + 16 * lb);
            __syncthreads(); FC_STORE_TILE(pre); __syncthreads(); }
        for (; it < NITEMS; it += G) {
            FC_DECODE(it, big, q, k1, gg, sb);
            const int nit = it + G; const bool hasn = nit < NITEMS; const int nit_c = hasn ? nit : it;
            FC_DECODE(nit_c, bign, qn, k1n, ggn, sbn);
            u32x2 gnx[6];
            FC_LOAD_TILE(pre, bign, k1n, ggn, sbn);
            { const bf16_t* gr = FC_GATE_ROW(bign, k1n, ggn, sbn);
#pragma unroll
              for (int lb = 0; lb < 6; ++lb) gnx[lb] = *(const u32x2*)(gr + 16 * lb); }
            const int N2 = big ? 128 : 64, S = big ? 8192 : 4096, kb2 = big ? wid : (wid & 3);
            LAS unsigned char* tile = big ? lds : lds + (wid >> 2) * 64 * TS;
            const int nks = N2 / 32;
            if (wmode != (int)big) { wmode = (int)big; const bf16_t* tab = big ? tab128 : tab64; const int tsz = N2 * N2;
#pragma unroll
                for (int ks = 0; ks < 4; ++ks) { const bf16_t* tp = tab + (16 * kb2 + fr) * N2 + 32 * (ks < nks ? ks : 0) + 8 * fq;
                    wfr[ks][0] = *(const bf16x8*)(tp); wfr[ks][1] = *(const bf16x8*)(tp + tsz); wfr[ks][2] = *(const bf16x8*)(tp + 2 * tsz); } }
            f32x4 zr[6], zi[6];
#pragma unroll
            for (int cb = 0; cb < 6; ++cb) { zr[cb] = (f32x4){0.f, 0.f, 0.f, 0.f}; zi[cb] = (f32x4){0.f, 0.f, 0.f, 0.f}; }
#pragma unroll
            for (int ks = 0; ks < 4; ++ks) if (ks < nks) {
                const bf16x8 wre = wfr[ks][0], wim = wfr[ks][1], wni = wfr[ks][2];
                LAS unsigned char* rowp = tile + (32 * ks + 8 * fq + q4) * TS + 8 * p4;
#pragma unroll
                for (int cb = 0; cb < 6; ++cb) {
                    const bf16x8 trf = cat4(tr_read(rowp + 32 * cb), tr_read(rowp + 32 * cb + 4 * TS));
                    const bf16x8 tif = cat4(tr_read(rowp + 192 + 32 * cb), tr_read(rowp + 192 + 32 * cb + 4 * TS));
                    zr[cb] = mfma16(trf, wre, zr[cb]); zr[cb] = mfma16(tif, wni, zr[cb]);
                    zi[cb] = mfma16(tif, wre, zi[cb]); zi[cb] = mfma16(trf, wim, zi[cb]);
                }
            }
            bf16x8 zfr[3], zfi[3];
#pragma unroll
            for (int s_ = 0; s_ < 3; ++s_) { zfr[s_] = pack8(zr[2 * s_], zr[2 * s_ + 1]); zfi[s_] = pack8(zi[2 * s_], zi[2 * s_ + 1]); }
            const float scale = 1.0f / sqrtf((float)S * 96.0f);
            bf16_t* trow = (bf16_t*)FC_GATE_ROW(big, k1, gg, sb);
#pragma unroll
            for (int lb = 0; lb < 6; ++lb) {
                f32x4 y = (f32x4){0.f, 0.f, 0.f, 0.f};
#pragma unroll
                for (int s_ = 0; s_ < 3; ++s_) { const LAS unsigned char* cp = lds + TC_OFF + ((16 * lb + fr) * 96 + 32 * s_ + 8 * fq) * 2;
                    y = mfma16(*(const LAS bf16x8*)cp, zfr[s_], y); y = mfma16(*(const LAS bf16x8*)(cp + 9216 * 2), zfi[s_], y); }
                const u32x2 gv = gcur[lb]; u32x2 w;
                w.x = cvt_pk_bf16(y[0] * scale * siluf_(bf_lo(gv.x)), y[1] * scale * siluf_(bf_hi(gv.x)));
                w.y = cvt_pk_bf16(y[2] * scale * siluf_(bf_lo(gv.y)), y[3] * scale * siluf_(bf_hi(gv.y)));
                *(u32x2*)(trow + 16 * lb) = w;
            }
            __syncthreads();
            if (hasn) FC_STORE_TILE(pre);
            __syncthreads();
#pragma unroll
            for (int lb = 0; lb < 6; ++lb) gcur[lb] = gnx[lb];
        }
#undef FC_DECODE
#undef FC_LOAD_TILE
#undef FC_STORE_TILE
#undef FC_GATE_ROW
    }
    SEAM(3);

    if (IN(4)) {
        MergeStream S; S.so.init(T, D, G, vblk, REPS(4)); S.hb = (const char*)hb; S.z1 = (const char*)z1; S.win = (const char*)WinT; S.wfo = (const char*)WfoT; S.wna = (const char*)WnaT; S.wca = (const char*)WcaT;
        EpiMerge E{ob + OUT_T2 + (size_t)blk * (3 * 16 * 8192), merged};
        pg8::gemm_stream<6>(lds, S, E);
    }
    SEAM(4);

    if (IN(5)) {
        PlainStream S; S.so.init(T, D, G, vblk, REPS(5)); S.A = (const char*)merged; S.B = (const char*)WoutT; S.lda = D * 2; S.ldb = D * 2; S.nt = 16;
        EpiResid E{a.xp, a.xs, a.out, rowss, (unsigned*)(ws + WS_CNT), a.g_final, (FUSE_NORM && G == 256 && REPS(5) == 1) ? 1 : 0};
        pg8::gemm_stream<1>(lds, S, E);
    }
    SEAM(5);

    if (IN(6) && !(FUSE_NORM && G == 256 && REPS(5) == 1)) {
        PHASE_LANES;
        const int gw = blk * 8 + wid, NGW = G * 8;
        for (int m4 = gw; m4 < T / 4; m4 += NGW) {
            f32x4 v[4][4]; float rs_[4];
#pragma unroll
            for (int r = 0; r < 4; ++r) { const int m = 4 * m4 + r; const f32x4* yr = (const f32x4*)(a.out + (size_t)m * D) + lane;
#pragma unroll
                for (int j = 0; j < 4; ++j) v[r][j] = yr[64 * j];
                rs_[r] = lane < 16 ? rowss[(size_t)m * 16 + lane] : 0.f; }
#pragma unroll
            for (int r = 0; r < 4; ++r) rs_[r] = 1.0f / sqrtf(wave_sum(rs_[r]) * (1.0f / D) + EPS);
            const f32x4* gr = (const f32x4*)a.g_final + lane;
#pragma unroll
            for (int j = 0; j < 4; ++j) { const f32x4 gv = gr[64 * j];
#pragma unroll
                for (int r = 0; r < 4; ++r) ((f32x4*)(a.out + (size_t)(4 * m4 + r) * D) + lane)[64 * j] = v[r][j] * rs_[r] * gv; }
        }
    }
}

extern "C" void kernel_launch(void* const* d_in, const int* in_sizes, int n_in, void* d_out, int out_size, void* d_ws, size_t ws_size, hipStream_t stream) {
    static int grid = 0;
    if (grid == 0) {
        if (n_in != 14 || out_size != T * D || ws_size < WS_END) { fprintf(stderr, "kernel_launch: unexpected sizes (n_in %d out %d ws %zu, need ws >= %zu)\n", n_in, out_size, ws_size, (size_t)WS_END); grid = -1; return; }
        int dev = 0, cus = 0, per_cu = 0;
        if (hipGetDevice(&dev) != hipSuccess || hipDeviceGetAttribute(&cus, hipDeviceAttributeMultiprocessorCount, dev) != hipSuccess) { grid = -1; return; }
        if (hipFuncSetAttribute((const void*)mk_fwd, hipFuncAttributeMaxDynamicSharedMemorySize, LDS_BYTES) != hipSuccess) { fprintf(stderr, "kernel_launch: hipFuncSetAttribute failed\n"); grid = -1; return; }
        if (hipOccupancyMaxActiveBlocksPerMultiprocessor(&per_cu, (const void*)mk_fwd, NTHREADS, LDS_BYTES) != hipSuccess || per_cu < 1) { fprintf(stderr, "kernel_launch: occupancy query says %d blocks per CU\n", per_cu); grid = -1; return; }
        grid = cus;
    }
    if (grid < 0) return;
    Args a{};
    a.xp = (const float*)d_in[0]; a.xs = (const float*)d_in[1]; a.memp = (const float*)d_in[2]; a.mems = (const float*)d_in[3]; a.g_norm = (const float*)d_in[4];
    a.w_in = (const float*)d_in[5]; a.rpb = (const float*)d_in[6]; a.g_mem = (const float*)d_in[7]; a.w_kv = (const float*)d_in[8]; a.w_fo = (const float*)d_in[9];
    a.w_na = (const float*)d_in[10]; a.w_ca = (const float*)d_in[11]; a.w_out = (const float*)d_in[12]; a.g_final = (const float*)d_in[13];
    a.out = (float*)d_out; a.ws = (unsigned char*)d_ws;
    if (hipMemsetAsync((char*)d_ws + WS_BAR, 0, XCD_BAR_WORDS * 4, stream) != hipSuccess) { fprintf(stderr, "kernel_launch: hipMemsetAsync of the barrier words failed\n"); return; }
#if MK_N_LAUNCHES == 1
    a.ph_lo = 0; a.ph_hi = NPHASES;
    { void* args[] = {&a}; hipError_t e = hipLaunchCooperativeKernel((const void*)mk_fwd, dim3(grid), dim3(NTHREADS), args, LDS_BYTES, stream);
      if (e != hipSuccess) fprintf(stderr, "kernel_launch: cooperative launch failed: %s\n", hipGetErrorString(e)); }
#else
    for (int p = 0; p < NPHASES; ++p) { a.ph_lo = p; a.ph_hi = p + 1; void* args[] = {&a};
        hipError_t e = hipLaunchCooperativeKernel((const void*)mk_fwd, dim3(grid), dim3(NTHREADS), args, LDS_BYTES, stream);
        if (e != hipSuccess) { fprintf(stderr, "kernel_launch: launch %d failed: %s\n", p, hipGetErrorString(e)); break; } }
#endif
}
```

```cpp
#include <hip/hip_runtime.h>
#include <hip/hip_cooperative_groups.h>
#include <cstdio>
#include <cstdint>
namespace cg = cooperative_groups;

#ifndef FUSE_NORM
#define FUSE_NORM 0
#endif
#ifndef MK_N_LAUNCHES
#define MK_N_LAUNCHES 1
#endif

#define LAS __attribute__((address_space(3)))
#define GAS __attribute__((address_space(1)))
typedef unsigned short bf16_t;
typedef short bf16x8 __attribute__((ext_vector_type(8)));
typedef short s16x4 __attribute__((ext_vector_type(4)));
typedef float f32x4 __attribute__((ext_vector_type(4)));
typedef unsigned u32x4 __attribute__((ext_vector_type(4)));
typedef unsigned u32x2 __attribute__((ext_vector_type(2)));

constexpr int D = 1024, T = 131072, TP = 65536, NZ = 2816, NIN = 5888, NMEMROWS = 6144;
constexpr int C_UF = 0, C_GF = 384, C_Q = 768, C_K = 1152, C_V = 1536, C_GNA = 1920, C_QCA = 2304, C_GCA = 2560;
constexpr float EPS = 1e-6f;
constexpr int NPHASES = 7;
constexpr int LDS_BYTES = 153600;
constexpr int NTHREADS = 512;

constexpr size_t WS_Z1 = 0;
constexpr size_t WS_MERGED = WS_Z1 + (size_t)T * NZ * 2;
constexpr size_t WS_WIN = WS_MERGED + (size_t)T * D * 2;
constexpr size_t WS_WKV = WS_WIN + (size_t)NIN * D * 2;
constexpr size_t WS_WFO = WS_WKV + (size_t)512 * D * 2;
constexpr size_t WS_WNA = WS_WFO + (size_t)D * 384 * 2;
constexpr size_t WS_WCA = WS_WNA + (size_t)D * 384 * 2;
constexpr size_t WS_WOUT = WS_WCA + (size_t)D * 256 * 2;
constexpr size_t WS_KVMEM = WS_WOUT + (size_t)D * D * 2;
constexpr size_t WS_MEMN = WS_KVMEM + (size_t)NMEMROWS * 512 * 2;
constexpr size_t WS_ROWSS = WS_MEMN + (size_t)NMEMROWS * D * 2;
constexpr size_t WS_TAB64 = WS_ROWSS + (size_t)T * 16 * 4;
constexpr size_t WS_TAB128 = WS_TAB64 + 3 * 64 * 64 * 2;
constexpr size_t WS_TABC = WS_TAB128 + 3 * 128 * 128 * 2;
constexpr size_t WS_CNT = (WS_TABC + 2 * 96 * 96 * 2 + 255) / 256 * 256;
constexpr size_t WS_BAR = WS_CNT + 512 * 256;
constexpr size_t WS_END = WS_BAR + 3456 * 4;
constexpr size_t OUT_HB = 0;
constexpr size_t OUT_T2 = (size_t)T * D * 2;
constexpr size_t OUT_END = OUT_T2 + (size_t)T * 768 * 2;
static_assert(OUT_END <= (size_t)T * D * 4, "d_out scratch");

struct Args {
    const float *xp, *xs, *memp, *mems, *g_norm, *w_in, *rpb, *g_mem, *w_kv, *w_fo, *w_na, *w_ca, *w_out, *g_final;
    float* out; unsigned char* ws; int ph_lo, ph_hi;
};

typedef __bf16 bf16v2 __attribute__((ext_vector_type(2)));
typedef float f32x2 __attribute__((ext_vector_type(2)));
__device__ __forceinline__ unsigned cvt_pk_bf16(float lo, float hi) { const f32x2 v = {lo, hi}; return __builtin_bit_cast(unsigned, __builtin_convertvector(v, bf16v2)); }
__device__ __forceinline__ float bf_lo(unsigned w) { return __uint_as_float(w << 16); }
__device__ __forceinline__ float bf_hi(unsigned w) { return __uint_as_float(w & 0xffff0000u); }
__device__ __forceinline__ float wave_sum(float v) {
#pragma unroll
    for (int o = 1; o < 64; o <<= 1) v += __shfl_xor(v, o);
    return v;
}
__device__ __forceinline__ float sigmoidf_(float x) { return __builtin_amdgcn_rcpf(1.0f + __expf(-x)); }
__device__ __forceinline__ float siluf_(float x) { return x * sigmoidf_(x); }
__device__ __forceinline__ int seq_base(int q) { return q < 8 ? q * 8192 : TP + (q - 8) * 4096; }
__device__ __forceinline__ f32x4 mfma16(bf16x8 a, bf16x8 b, f32x4 c) { return __builtin_amdgcn_mfma_f32_16x16x32_bf16(a, b, c, 0, 0, 0); }
__device__ __forceinline__ bf16x8 cat4(s16x4 a, s16x4 b) { return __builtin_shufflevector(a, b, 0, 1, 2, 3, 4, 5, 6, 7); }
__device__ __forceinline__ s16x4 tr_read(LAS unsigned char* p) { return __builtin_amdgcn_ds_read_tr16_b64_v4i16((LAS s16x4*)p); }
__device__ __forceinline__ bf16x8 pack8(f32x4 a, f32x4 b) {
    u32x4 p; p.x = cvt_pk_bf16(a[0], a[1]); p.y = cvt_pk_bf16(a[2], a[3]); p.z = cvt_pk_bf16(b[0], b[1]); p.w = cvt_pk_bf16(b[2], b[3]);
    return __builtin_bit_cast(bf16x8, p);
}

namespace pg8 {
constexpr int BM = 256, BK = 64, HALF = 128, HTB = HALF * BK * 2, STAGE_BYTES = 8 * HTB, NXCD = 8, WGM = 8;
__device__ __forceinline__ int lds_byte(int r, int c) { const int st = (r >> 4) * 2 + (c >> 5), rr = r & 15, cc = c & 31, ob = rr * 64 + cc * 2; return st * 1024 + (ob ^ (((ob >> 9) & 1) << 5)); }
__device__ __forceinline__ void stage_rc(int b, int& R, int& C) { const int st = b / 1024, sb = b % 1024, swz = sb ^ (((sb >> 9) & 1) << 5); R = (st >> 1) * 16 + swz / 64; C = (st & 1) * 32 + (swz % 64) / 2; }
__device__ __forceinline__ int perm32(int rho) { const int n = rho >> 4, i = rho & 15; return 8 * (i >> 2) + 4 * n + (i & 3); }

struct Unit { int pm, pn; };
struct StaticOrder {
    int nM, nN, nwg, G, c, rep;
    __device__ void init(int M, int N, int G_, int c_, int rep_ = 1) { nM = M / BM; nN = N / BM; nwg = nM * nN; G = G_; c = c_; rep = rep_; }
    __device__ bool next(int i, Unit& u) const {
        long L = (long)i * G + c; if (L >= (long)nwg * rep) return false;
        L %= nwg;
        int wgid = (int)L; { const int q = nwg / NXCD, r = nwg % NXCD, xcd = wgid % NXCD, off = wgid / NXCD; wgid = (xcd < r ? xcd * (q + 1) : r * (q + 1) + (xcd - r) * q) + off; }
        const int nig = WGM * nN, gid = wgid / nig, fm = gid * WGM, gsz = (nM - fm) < WGM ? (nM - fm) : WGM;
        u.pm = fm + ((wgid % nig) % gsz); u.pn = (wgid % nig) / gsz; return true;
    }
};
struct Seg { const char* A; const char* B; unsigned lda, ldb; int nt, kind, pm, pn; };

template <int NSEG, class Epi, class Stream>
__device__ __forceinline__ void gemm_stream(LAS unsigned char* lds, const Stream& S, const Epi& E) {
    const int tid = threadIdx.x, wid = __builtin_amdgcn_readfirstlane(tid >> 6), lane = tid & 63, wr = wid >> 2, wc = wid & 3, fr = lane & 15, fq = lane >> 4;
    unsigned Ra0, Rb0, Cc0;
    { int R, C; stage_rc(tid * 16, R, C); Ra0 = (unsigned)R; Rb0 = (unsigned)(Epi::PERM ? ((R & ~31) + perm32(R & 31)) : R); Cc0 = (unsigned)C * 2u; }
    const size_t kstep = (size_t)(BK * 2);
    const unsigned ldsw = (unsigned)wid * 1024u;
    const int aoff = lds_byte(wr * 64 + fr, fq * 8), boff = lds_byte(wc * 32 + fr, fq * 8);
#define PG8_SA(b, h) (((b) * 2 + (h)) * HTB)
#define PG8_SB(b, h) ((4 + (b) * 2 + (h)) * HTB)
#define PG8_STAGE(bufoff, gbase, v0, ld) do { \
        __builtin_amdgcn_global_load_lds((const unsigned*)((const char*)(gbase) + (v0)), (LAS unsigned*)(lds + (bufoff) + ldsw), 16, 0, 0); \
        __builtin_amdgcn_global_load_lds((const unsigned*)((const char*)(gbase) + (size_t)64 * (ld) + (v0)), (LAS unsigned*)(lds + (bufoff) + ldsw + 8192), 16, 0, 0); } while (0)
#define PG8_LDA(dst, b, h) do { _Pragma("unroll") for (int m = 0; m < 4; ++m) _Pragma("unroll") for (int k = 0; k < 2; ++k) dst[m][k] = *(const LAS bf16x8*)(lds + PG8_SA(b, h) + aoff + m * 2048 + k * 1024); } while (0)
#define PG8_LDB(dst, b, h) do { _Pragma("unroll") for (int n = 0; n < 2; ++n) _Pragma("unroll") for (int k = 0; k < 2; ++k) dst[n][k] = *(const LAS bf16x8*)(lds + PG8_SB(b, h) + boff + n * 2048 + k * 1024); } while (0)
#define PG8_MMA(ai, bj, At, Bt) do { __builtin_amdgcn_s_setprio(1); _Pragma("unroll") for (int m = 0; m < 4; ++m) _Pragma("unroll") for (int n = 0; n < 2; ++n) _Pragma("unroll") for (int k = 0; k < 2; ++k) \
        acc[ai][bj][m][n] = __builtin_amdgcn_mfma_f32_16x16x32_bf16(Bt[n][k], At[m][k], acc[ai][bj][m][n], 0, 0, 0); __builtin_amdgcn_s_setprio(0); } while (0)
#define PG8_WAIT_V(n) asm volatile("s_waitcnt vmcnt(" #n ")" ::: "memory")
#define PG8_WAIT_L(n) asm volatile("s_waitcnt lgkmcnt(" #n ")" ::: "memory")
#define PG8_BAR __builtin_amdgcn_s_barrier()
#define PG8_SCHED __builtin_amdgcn_sched_barrier(0)
#define PG8_ZERO() do { _Pragma("unroll") for (int a_ = 0; a_ < 2; ++a_) _Pragma("unroll") for (int b_ = 0; b_ < 2; ++b_) _Pragma("unroll") for (int m_ = 0; m_ < 4; ++m_) _Pragma("unroll") for (int n_ = 0; n_ < 2; ++n_) \
        acc[a_][b_][m_][n_] = (f32x4){0.f, 0.f, 0.f, 0.f}; } while (0)
    Seg cur, nxt; int ui = 0;
    if (!S.template seg<0>(0, cur)) return;
    f32x4 acc[2][2][4][2];
    PG8_ZERO();
    bf16x8 At[4][2], B0[2][2], B1[2][2];
    const char* cA = cur.A; const char* cB = cur.B;
    unsigned vAc0 = Ra0 * cur.lda + Cc0, vBc0 = Rb0 * cur.ldb + Cc0, ldAc = cur.lda, ldBc = cur.ldb;
    size_t hAc = (size_t)HALF * cur.lda, hBc = (size_t)HALF * cur.ldb;
    PG8_STAGE(PG8_SB(0, 0), cB, vBc0, ldBc); PG8_STAGE(PG8_SB(0, 1), cB + hBc, vBc0, ldBc); PG8_STAGE(PG8_SA(0, 0), cA, vAc0, ldAc); PG8_STAGE(PG8_SA(0, 1), cA + hAc, vAc0, ldAc);
    if (wr == 1) PG8_BAR;
    PG8_WAIT_V(2); PG8_BAR;
    PG8_STAGE(PG8_SB(1, 0), cB + kstep, vBc0, ldBc); PG8_STAGE(PG8_SA(1, 0), cA + kstep, vAc0, ldAc); PG8_STAGE(PG8_SB(1, 1), cB + hBc + kstep, vBc0, ldBc);
    PG8_WAIT_V(6); PG8_BAR;
#define PG8_SEG(KK) if constexpr (NSEG > (KK)) { \
        bool has_next; if constexpr ((KK) + 1 < NSEG) { S.template seg<((KK) + 1 < NSEG ? (KK) + 1 : 0)>(ui, nxt); has_next = true; } else has_next = S.template seg<0>(ui + 1, nxt); \
        if (!has_next) nxt = cur;     \
        const char* nA = nxt.A; const char* nB = nxt.B; \
        const unsigned vAn0 = Ra0 * nxt.lda + Cc0, vBn0 = Rb0 * nxt.ldb + Cc0, ldAn = nxt.lda, ldBn = nxt.ldb; \
        const size_t hAn = (size_t)HALF * nxt.lda, hBn = (size_t)HALF * nxt.ldb; \
        const int nt = cur.nt; \
        for (int t = 0; t < nt; t += 2) { \
            const bool last = (t == nt - 2); \
            const char* a1 = cA + (size_t)(t + 1) * kstep; \
            const char* a2 = last ? nA : cA + (size_t)(t + 2) * kstep; const char* b2 = last ? nB : cB + (size_t)(t + 2) * kstep; \
            const char* a3 = a2 + kstep; const char* b3 = b2 + kstep; \
            const unsigned vA0 = last ? vAn0 : vAc0, vB0 = last ? vBn0 : vBc0, lA2 = last ? ldAn : ldAc, lB2 = last ? ldBn : ldBc; \
            const size_t hA2 = last ? hAn : hAc, hB2 = last ? hBn : hBc; \
              \
            PG8_LDB(B0, 0, 0); PG8_LDB(B1, 0, 1); PG8_SCHED; PG8_LDA(At, 0, 0); PG8_STAGE(PG8_SA(1, 1), a1 + hAc, vAc0, ldAc); \
            PG8_WAIT_V(8); PG8_WAIT_L(0); PG8_BAR; PG8_MMA(0, 0, At, B0); PG8_MMA(0, 1, At, B1); PG8_BAR; PG8_SCHED; \
              \
            PG8_LDA(At, 0, 1); PG8_STAGE(PG8_SB(0, 0), b2, vB0, lB2); PG8_STAGE(PG8_SB(0, 1), b2 + hB2, vB0, lB2); PG8_STAGE(PG8_SA(0, 0), a2, vA0, lA2); \
            PG8_WAIT_V(8); PG8_WAIT_L(0); PG8_BAR; PG8_MMA(1, 0, At, B0); PG8_MMA(1, 1, At, B1); PG8_BAR; PG8_SCHED; \
              \
            PG8_LDB(B0, 1, 0); PG8_LDB(B1, 1, 1); PG8_SCHED; PG8_LDA(At, 1, 0); PG8_STAGE(PG8_SA(0, 1), a2 + hA2, vA0, lA2); \
            PG8_WAIT_V(8); PG8_WAIT_L(0); PG8_BAR; PG8_MMA(0, 0, At, B0); PG8_MMA(0, 1, At, B1); PG8_BAR; PG8_SCHED; \
              \
            PG8_LDA(At, 1, 1); PG8_STAGE(PG8_SB(1, 0), b3, vB0, lB2); PG8_STAGE(PG8_SB(1, 1), b3 + hB2, vB0, lB2); PG8_STAGE(PG8_SA(1, 0), a3, vA0, lA2); \
            PG8_WAIT_V(8); PG8_WAIT_L(0); PG8_BAR; PG8_MMA(1, 0, At, B0); PG8_MMA(1, 1, At, B1); PG8_BAR; PG8_SCHED; \
        } \
        if (wr == 0) PG8_BAR;     \
        E.template run<(KK)>(acc, cur, wr, wc, fr, fq, tid); \
        if (!has_next) break; \
        if constexpr (Epi::template zero_after<(KK)>()) PG8_ZERO(); \
        cur = nxt; cA = nA; cB = nB; vAc0 = vAn0; vBc0 = vBn0; ldAc = ldAn; ldBc = ldBn; hAc = hAn; hBc = hBn; \
        if (wr == 1) PG8_BAR;     }
    for (;;) {
        PG8_SEG(0) PG8_SEG(1) PG8_SEG(2) PG8_SEG(3) PG8_SEG(4) PG8_SEG(5)
        ++ui;
    }
    PG8_WAIT_V(0);
    PG8_BAR;
#undef PG8_SA
#undef PG8_SB
#undef PG8_STAGE
#undef PG8_LDA
#undef PG8_LDB
#undef PG8_MMA
#undef PG8_WAIT_V
#undef PG8_WAIT_L
#undef PG8_BAR
#undef PG8_SCHED
#undef PG8_ZERO
#undef PG8_SEG
}
}

struct PlainStream {
    pg8::StaticOrder so; const char* A; const char* B; unsigned lda, ldb; int nt;
    template <int KK> __device__ __forceinline__ bool seg(int i, pg8::Seg& s) const { pg8::Unit u; if (!so.next(i, u)) return false;
        s.A = A + (size_t)u.pm * 256 * lda; s.B = B + (size_t)u.pn * 256 * ldb; s.lda = lda; s.ldb = ldb; s.nt = nt; s.kind = 0; s.pm = u.pm; s.pn = u.pn; return true; }
};
struct EpiStoreBf16 {
    static constexpr bool PERM = true;
    bf16_t* O; int ldc;
    template <int KK> static constexpr bool zero_after() { return true; }
    template <int KK> __device__ __forceinline__ void run(f32x4 (&acc)[2][2][4][2], const pg8::Seg& u, int wr, int wc, int fr, int fq, int) const {
        const int row0 = u.pm * 256 + wr * 64 + fr, col0 = u.pn * 256 + wc * 32 + 8 * fq;
#pragma unroll
        for (int ai = 0; ai < 2; ++ai)
#pragma unroll
            for (int m = 0; m < 4; ++m) { bf16_t* rowp = O + (size_t)(row0 + ai * 128 + m * 16) * ldc + col0;
#pragma unroll
                for (int bj = 0; bj < 2; ++bj) { const f32x4 v0 = acc[ai][bj][m][0], v1 = acc[ai][bj][m][1];
                    u32x4 w; w.x = cvt_pk_bf16(v0[0], v0[1]); w.y = cvt_pk_bf16(v0[2], v0[3]); w.z = cvt_pk_bf16(v1[0], v1[1]); w.w = cvt_pk_bf16(v1[2], v1[3]);
                    *(u32x4*)(rowp + bj * 128) = w; } }
    }
};

struct MergeStream {
    pg8::StaticOrder so; const char *hb, *z1, *win, *wfo, *wna, *wca;
    template <int KK> __device__ __forceinline__ bool seg(int ui, pg8::Seg& s) const { pg8::Unit u; constexpr int k = KK; if (!so.next(ui, u)) return false;
        s.kind = k; s.pm = u.pm; s.pn = u.pn;
        if (k < 3) { s.A = hb + (size_t)u.pm * 256 * (D * 2); s.lda = D * 2; s.B = win + (size_t)(NZ + k * D + u.pn * 256) * (D * 2); s.ldb = D * 2; s.nt = 16; }
        else { s.lda = NZ * 2; const char* a = z1 + (size_t)u.pm * 256 * (NZ * 2);
            if (k == 3) { s.A = a + C_GF * 2; s.B = wfo + (size_t)u.pn * 256 * (384 * 2); s.ldb = 384 * 2; s.nt = 6; }
            else if (k == 4) { s.A = a + C_GNA * 2; s.B = wna + (size_t)u.pn * 256 * (384 * 2); s.ldb = 384 * 2; s.nt = 6; }
            else { s.A = a + C_GCA * 2; s.B = wca + (size_t)u.pn * 256 * (256 * 2); s.ldb = 256 * 2; s.nt = 4; } }
        return true; }
};
typedef _Float16 f16v2 __attribute__((ext_vector_type(2)));
__device__ __forceinline__ unsigned pk_h2(float lo, float hi) { const f32x2 v = {lo, hi}; return __builtin_bit_cast(unsigned, __builtin_convertvector(v, f16v2)); }
__device__ __forceinline__ f32x2 un_h2(unsigned w) { return __builtin_convertvector(__builtin_bit_cast(f16v2, w), f32x2); }
struct EpiMerge {
    static constexpr bool PERM = true;
    unsigned char* stash; bf16_t* O;
    template <int KK> static constexpr bool zero_after() { return KK < 3 || KK == 5; }
    template <int KK> __device__ __forceinline__ void run(f32x4 (&acc)[2][2][4][2], const pg8::Seg& u, int wr, int wc, int fr, int fq, int tid) const {
        constexpr int k = KK;
        GAS unsigned char* sbase = (GAS unsigned char*)stash + (size_t)tid * 16; asm volatile("" : "+v"(sbase));
        if constexpr (k < 3) {
            GAS u32x4* st = (GAS u32x4*)(sbase + (size_t)k * 16 * 8192);
#pragma unroll
            for (int j = 0; j < 16; ++j) { const f32x4 v0 = acc[j >> 3][(j >> 2) & 1][j & 3][0], v1 = acc[j >> 3][(j >> 2) & 1][j & 3][1]; u32x4 w;
                w.x = pk_h2(sigmoidf_(v0[0]), sigmoidf_(v0[1])); w.y = pk_h2(sigmoidf_(v0[2]), sigmoidf_(v0[3]));
                w.z = pk_h2(sigmoidf_(v1[0]), sigmoidf_(v1[1])); w.w = pk_h2(sigmoidf_(v1[2]), sigmoidf_(v1[3]));
                st[j * 512] = w; }
        } else if constexpr (k < 5) {
            const GAS u32x4* sa = (const GAS u32x4*)(sbase + (size_t)(k - 3) * 16 * 8192); const GAS u32x4* sb = (const GAS u32x4*)(sbase + (size_t)(k - 2) * 16 * 8192);
#pragma unroll
            for (int hb_ = 0; hb_ < 2; ++hb_) {
            u32x4 p[8], q[8];
#pragma unroll
            for (int j = 0; j < 8; ++j) { p[j] = sa[(hb_ * 8 + j) * 512]; q[j] = sb[(hb_ * 8 + j) * 512]; }
#pragma unroll
            for (int jj = 0; jj < 8; ++jj) { const int j = hb_ * 8 + jj; f32x4& v0 = acc[j >> 3][(j >> 2) & 1][j & 3][0]; f32x4& v1 = acc[j >> 3][(j >> 2) & 1][j & 3][1];
                const f32x2 p0 = un_h2(p[jj].x), p1 = un_h2(p[jj].y), p2 = un_h2(p[jj].z), p3 = un_h2(p[jj].w);
                const f32x2 q0 = un_h2(q[jj].x), q1 = un_h2(q[jj].y), q2 = un_h2(q[jj].z), q3 = un_h2(q[jj].w);
                v0[0] *= p0[0] * __builtin_amdgcn_rcpf(q0[0]); v0[1] *= p0[1] * __builtin_amdgcn_rcpf(q0[1]); v0[2] *= p1[0] * __builtin_amdgcn_rcpf(q1[0]); v0[3] *= p1[1] * __builtin_amdgcn_rcpf(q1[1]);
                v1[0] *= p2[0] * __builtin_amdgcn_rcpf(q2[0]); v1[1] *= p2[1] * __builtin_amdgcn_rcpf(q2[1]); v1[2] *= p3[0] * __builtin_amdgcn_rcpf(q3[0]); v1[3] *= p3[1] * __builtin_amdgcn_rcpf(q3[1]);
                asm volatile("" : "+v"(v0), "+v"(v1)); }
            asm volatile("" ::: "memory"); }
        } else {
            const GAS u32x4* sa = (const GAS u32x4*)(sbase + (size_t)2 * 16 * 8192);
            const int row0 = u.pm * 256 + wr * 64 + fr, col0 = u.pn * 256 + wc * 32 + 8 * fq;
            u32x4 p[16];
#pragma unroll
            for (int j = 0; j < 16; ++j) p[j] = sa[j * 512];
#pragma unroll
            for (int ai = 0; ai < 2; ++ai)
#pragma unroll
                for (int m = 0; m < 4; ++m) { bf16_t* rowp = O + (size_t)(row0 + ai * 128 + m * 16) * D + col0;
#pragma unroll
                    for (int bj = 0; bj < 2; ++bj) { const int j16 = (ai * 2 + bj) * 4 + m; const f32x4 v0 = acc[ai][bj][m][0], v1 = acc[ai][bj][m][1];
                        const f32x2 p0 = un_h2(p[j16].x), p1 = un_h2(p[j16].y), p2 = un_h2(p[j16].z), p3 = un_h2(p[j16].w);
                        u32x4 w; w.x = cvt_pk_bf16(v0[0] * p0[0], v0[1] * p0[1]); w.y = cvt_pk_bf16(v0[2] * p1[0], v0[3] * p1[1]);
                        w.z = cvt_pk_bf16(v1[0] * p2[0], v1[1] * p2[1]); w.w = cvt_pk_bf16(v1[2] * p3[0], v1[3] * p3[1]);
                        *(u32x4*)(rowp + bj * 128) = w; } }
        }
    }
};
struct EpiResid {
    static constexpr bool PERM = false;
    const float *xp, *xs; float* out; float* rowss; unsigned* cnt; const float* g_final; int fused;
    template <int KK> static constexpr bool zero_after() { return true; }
    template <int KK> __device__ __forceinline__ void run(f32x4 (&acc)[2][2][4][2], const pg8::Seg& u, int wr, int wc, int fr, int fq, int tid) const {
        const int row0 = u.pm * 256 + wr * 64 + fr, col0 = u.pn * 256 + wc * 32 + 4 * fq;
#pragma unroll
        for (int ai = 0; ai < 2; ++ai) {
            f32x4 xv[4][4];
#pragma unroll
            for (int m = 0; m < 4; ++m) { const int r = row0 + ai * 128 + m * 16; const float* xr = (r < TP ? xp + (size_t)r * D : xs + (size_t)(r - TP) * D) + col0;
#pragma unroll
                for (int bj = 0; bj < 2; ++bj)
#pragma unroll
                    for (int n = 0; n < 2; ++n) xv[m][bj * 2 + n] = *(const f32x4*)(xr + bj * 128 + n * 16); }
#pragma unroll
            for (int m = 0; m < 4; ++m) { const int r = row0 + ai * 128 + m * 16; float* orow = out + (size_t)r * D + col0; float ss = 0.f;
#pragma unroll
                for (int bj = 0; bj < 2; ++bj)
#pragma unroll
                    for (int n = 0; n < 2; ++n) { const f32x4 y = xv[m][bj * 2 + n] + acc[ai][bj][m][n]; acc[ai][bj][m][n] = y;
                        ss += (y[0] * y[0] + y[1] * y[1]) + (y[2] * y[2] + y[3] * y[3]); if (!fused) *(f32x4*)(orow + bj * 128 + n * 16) = y; }
                ss += __shfl_xor(ss, 16); ss += __shfl_xor(ss, 32);
                if (fq == 0) { float* slot = rowss + (size_t)r * 16 + u.pn * 4 + wc; if (fused) __hip_atomic_store(slot, ss, __ATOMIC_RELAXED, __HIP_MEMORY_SCOPE_AGENT); else *slot = ss; } }
            asm volatile("" ::: "memory"); }
        if (!fused) return;
        asm volatile("s_waitcnt vmcnt(0)" ::: "memory");
        unsigned* cw = cnt + 64 * u.pm + 16 * wr;
        if ((tid & 63) == 0) __hip_atomic_fetch_add(cw, 1u, __ATOMIC_RELAXED, __HIP_MEMORY_SCOPE_AGENT);
        { const unsigned long long t0 = __builtin_amdgcn_s_memrealtime();
          while ((unsigned)__builtin_amdgcn_readfirstlane(__hip_atomic_load(cw, __ATOMIC_RELAXED, __HIP_MEMORY_SCOPE_AGENT)) < 16u) {
              if (__builtin_amdgcn_s_memrealtime() - t0 > 2000000ull) break;
              __builtin_amdgcn_s_sleep(2); } }
        __builtin_amdgcn_fence(__ATOMIC_ACQUIRE, "agent");
        asm volatile("s_waitcnt vmcnt(0)" ::: "memory");
        unsigned long long pl[8][2];
#pragma unroll
        for (int ai = 0; ai < 2; ++ai)
#pragma unroll
            for (int m = 0; m < 4; ++m) { const int r = row0 + ai * 128 + m * 16; const unsigned long long* pp = (const unsigned long long*)(rowss + (size_t)r * 16 + fq * 4);
                pl[ai * 4 + m][0] = __hip_atomic_load(pp, __ATOMIC_RELAXED, __HIP_MEMORY_SCOPE_AGENT); pl[ai * 4 + m][1] = __hip_atomic_load(pp + 1, __ATOMIC_RELAXED, __HIP_MEMORY_SCOPE_AGENT); }
        f32x4 gf[4];
#pragma unroll
        for (int bj = 0; bj < 2; ++bj)
#pragma unroll
            for (int n = 0; n < 2; ++n) gf[bj * 2 + n] = *(const f32x4*)(g_final + col0 + bj * 128 + n * 16);
#pragma unroll
        for (int ai = 0; ai < 2; ++ai)
#pragma unroll
            for (int m = 0; m < 4; ++m) { const int r = row0 + ai * 128 + m * 16; float* orow = out + (size_t)r * D + col0;
                const unsigned long long w0 = pl[ai * 4 + m][0], w1 = pl[ai * 4 + m][1];
                float t = (__uint_as_float((unsigned)w0) + __uint_as_float((unsigned)(w0 >> 32))) + (__uint_as_float((unsigned)w1) + __uint_as_float((unsigned)(w1 >> 32)));
                t += __shfl_xor(t, 16); t += __shfl_xor(t, 32);
                const float rstd = 1.0f / sqrtf(t * (1.0f / D) + EPS);
#pragma unroll
                for (int bj = 0; bj < 2; ++bj)
#pragma unroll
                    for (int n = 0; n < 2; ++n) *(f32x4*)(orow + bj * 128 + n * 16) = acc[ai][bj][m][n] * rstd * gf[bj * 2 + n]; }
    }
};

__device__ __forceinline__ void p0_transpose_item(const float* W, int K, int N, bf16_t* WT, LAS float* scr, int item, int lane) {
    const int nblk = N / 32, kb = item / nblk, nb = item % nblk, k0 = 64 * kb, n0 = 32 * nb;
#pragma unroll 8
    for (int i = 0; i < 32; ++i) { const int kk = 2 * i + (lane >> 5); scr[kk * 33 + (lane & 31)] = W[(size_t)(k0 + kk) * N + n0 + (lane & 31)]; }
    asm volatile("s_waitcnt lgkmcnt(0)" ::: "memory");
    const int c = lane & 7;
#pragma unroll
    for (int j = 0; j < 4; ++j) { const int n = (lane >> 3) + 8 * j; const LAS float* s = scr + (8 * c) * 33 + n;
        u32x4 o; o.x = cvt_pk_bf16(s[0 * 33], s[1 * 33]); o.y = cvt_pk_bf16(s[2 * 33], s[3 * 33]); o.z = cvt_pk_bf16(s[4 * 33], s[5 * 33]); o.w = cvt_pk_bf16(s[6 * 33], s[7 * 33]);
        *(u32x4*)(WT + (size_t)(n0 + n) * K + k0 + 8 * c) = o; }
    asm volatile("s_waitcnt lgkmcnt(0)" ::: "memory");
}
__device__ __forceinline__ void rms_row_to_bf16(const float* xrow, const float* g, bf16_t* orow, int lane) {
    const f32x4* xr = (const f32x4*)xrow + lane; const f32x4* gr = (const f32x4*)g + lane;
    f32x4 v[4]; float s = 0.f;
#pragma unroll
    for (int j = 0; j < 4; ++j) { v[j] = xr[64 * j]; s += (v[j][0] * v[j][0] + v[j][1] * v[j][1]) + (v[j][2] * v[j][2] + v[j][3] * v[j][3]); }
    const float rstd = 1.0f / sqrtf(wave_sum(s) * (1.0f / D) + EPS);
    u32x2* o8 = (u32x2*)orow + lane;
#pragma unroll
    for (int j = 0; j < 4; ++j) { const f32x4 gv = gr[64 * j]; u32x2 w; w.x = cvt_pk_bf16(v[j][0] * rstd * gv[0], v[j][1] * rstd * gv[1]); w.y = cvt_pk_bf16(v[j][2] * rstd * gv[2], v[j][3] * rstd * gv[3]); o8[64 * j] = w; }
}
__device__ __forceinline__ void rms_rows4_to_bf16(const float* const (&xrow)[4], const float* g, bf16_t* const (&orow)[4], int lane) {
    f32x4 v[4][4]; float s[4];
#pragma unroll
    for (int r = 0; r < 4; ++r) { const f32x4* xr = (const f32x4*)xrow[r] + lane;
#pragma unroll
        for (int j = 0; j < 4; ++j) v[r][j] = xr[64 * j]; }
#pragma unroll
    for (int r = 0; r < 4; ++r) { float t = 0.f;
#pragma unroll
        for (int j = 0; j < 4; ++j) t += (v[r][j][0] * v[r][j][0] + v[r][j][1] * v[r][j][1]) + (v[r][j][2] * v[r][j][2] + v[r][j][3] * v[r][j][3]);
        s[r] = 1.0f / sqrtf(wave_sum(t) * (1.0f / D) + EPS); }
    const f32x4* gr = (const f32x4*)g + lane;
#pragma unroll
    for (int j = 0; j < 4; ++j) { const f32x4 gv = gr[64 * j];
#pragma unroll
        for (int r = 0; r < 4; ++r) { u32x2 w; w.x = cvt_pk_bf16(v[r][j][0] * s[r] * gv[0], v[r][j][1] * s[r] * gv[1]); w.y = cvt_pk_bf16(v[r][j][2] * s[r] * gv[2], v[r][j][3] * s[r] * gv[3]);
            ((u32x2*)orow[r] + lane)[64 * j] = w; } }
}
__device__ __forceinline__ unsigned short f2bf(float f) { return (unsigned short)(cvt_pk_bf16(f, 0.f) & 0xffffu); }
__device__ __forceinline__ float cosrev(float x) { return __builtin_amdgcn_cosf(x); }
__device__ __forceinline__ float sinrev(float x) { return __builtin_amdgcn_sinf(x); }

__device__ __forceinline__ unsigned kv_off(int key, int chunk) { return (unsigned)(key * 128 + ((chunk ^ (key & 7)) << 4)); }
struct QG { bf16x8 q0, q1; };
__device__ __forceinline__ QG load_qg(const bf16_t* qrow, const bf16_t*, int fq) {
    QG r; r.q0 = *(const bf16x8*)(qrow + 8 * fq); r.q1 = *(const bf16x8*)(qrow + 32 + 8 * fq);
    return r;
}
template <bool NA>
__device__ __forceinline__ void attn16(LAS unsigned char* Kimg, LAS unsigned char* Vimg, const LAS float* rpbs, const int (&krow)[8], const QG& in,
                                       bf16_t* gate_out  , int fr, int fq, int lane,
                                       int qcol, int c0, int drbase  ) {
    u32x2 gin[4];
#pragma unroll
    for (int db = 0; db < 4; ++db) gin[db] = *(const u32x2*)(gate_out + 16 * db + 4 * fq);
    const unsigned kl0 = (unsigned)(fr * 128 + ((fq ^ (fr & 7)) << 4)), kl1 = (unsigned)(fr * 128 + (((4 + fq) ^ (fr & 7)) << 4));
    f32x4 sacc[16];
#pragma unroll
    for (int kb = 0; kb < 16; ++kb) {
        LAS unsigned char* kp = Kimg + (krow[kb >> 1] + (kb & 1) * 16) * 128;
        f32x4 a = (f32x4){0.f, 0.f, 0.f, 0.f};
        a = mfma16(*(const LAS bf16x8*)(kp + kl0), in.q0, a);
        a = mfma16(*(const LAS bf16x8*)(kp + kl1), in.q1, a);
        sacc[kb] = a;
    }
    const float L2E = 1.4426950408889634f * 0.125f;
    float mx = -3.0e38f, sum = 0.f;
    if (NA) {
        const int cs = min(max(qcol - 8, 0), 48), relb = c0 + 4 * fq - cs;
        const LAS float* bp = rpbs + (drbase * 31 + c0 + 4 * fq - qcol + 15);
        bool valid[2][4];
#pragma unroll
        for (int hc = 0; hc < 2; ++hc)
#pragma unroll
            for (int i = 0; i < 4; ++i) valid[hc][i] = (unsigned)(relb + 16 * hc + i) < 16u;
#pragma unroll
        for (int kb = 0; kb < 16; ++kb)
#pragma unroll
            for (int i = 0; i < 4; ++i) { float sv = __builtin_fmaf(sacc[kb][i], L2E, bp[(kb >> 1) * 31 + 16 * (kb & 1) + i]); sv = valid[kb & 1][i] ? sv : -3.0e38f; sacc[kb][i] = sv; mx = fmaxf(mx, sv); }
        mx = fmaxf(mx, __shfl_xor(mx, 16)); mx = fmaxf(mx, __shfl_xor(mx, 32));
#pragma unroll
        for (int kb = 0; kb < 16; ++kb)
#pragma unroll
            for (int i = 0; i < 4; ++i) { const float p = __builtin_amdgcn_exp2f(sacc[kb][i] - mx); sacc[kb][i] = p; sum += p; }
    } else {
#pragma unroll
        for (int kb = 0; kb < 16; ++kb)
#pragma unroll
            for (int i = 0; i < 4; ++i) mx = fmaxf(mx, sacc[kb][i]);
        mx = fmaxf(mx, __shfl_xor(mx, 16)); mx = fmaxf(mx, __shfl_xor(mx, 32));
        const float mb = -mx * L2E;
#pragma unroll
        for (int kb = 0; kb < 16; ++kb)
#pragma unroll
            for (int i = 0; i < 4; ++i) { const float p = __builtin_amdgcn_exp2f(__builtin_fmaf(sacc[kb][i], L2E, mb)); sacc[kb][i] = p; sum += p; }
    }
    sum += __shfl_xor(sum, 16); sum += __shfl_xor(sum, 32);
    const float inv = 1.0f / sum;
    bf16x8 pf[8];
#pragma unroll
    for (int s = 0; s < 8; ++s) pf[s] = pack8(sacc[2 * s], sacc[2 * s + 1]);
    const int q4 = (lane & 15) >> 2, p4 = lane & 3, kl = 4 * fq + q4;
    unsigned vl[4];
#pragma unroll
    for (int db = 0; db < 4; ++db) vl[db] = (unsigned)(kl * 128 + (((2 * db + (p4 >> 1)) ^ (kl & 7)) << 4) + 8 * (p4 & 1));
    f32x4 oacc[4];
#pragma unroll
    for (int db = 0; db < 4; ++db) oacc[db] = (f32x4){0.f, 0.f, 0.f, 0.f};
#pragma unroll
    for (int s = 0; s < 8; ++s) {
        LAS unsigned char* vp = Vimg + krow[s] * 128;
#pragma unroll
        for (int db = 0; db < 4; ++db) {
            const s16x4 v0 = tr_read(vp + vl[db]);
            const s16x4 v1 = tr_read(vp + 2048 + vl[db]);
            oacc[db] = mfma16(cat4(v0, v1), pf[s], oacc[db]);
        }
        if (s & 1) __builtin_amdgcn_sched_barrier(0);
    }
#pragma unroll
    for (int db = 0; db < 4; ++db) { const u32x2 gv = gin[db]; u32x2 w;
        w.x = cvt_pk_bf16(oacc[db][0] * inv * siluf_(bf_lo(gv.x)), oacc[db][1] * inv * siluf_(bf_hi(gv.x)));
        w.y = cvt_pk_bf16(oacc[db][2] * inv * siluf_(bf_lo(gv.y)), oacc[db][3] * inv * siluf_(bf_hi(gv.y)));
        *(u32x2*)(gate_out + 16 * db + 4 * fq) = w; }
}

#define XB_TMO      128
#define XB_XCNT(j)  (256  + 64 * (j))
#define XB_XSUB(j)  (1280 + 64 * (j))
#define XB_XGEN(j)  (2304 + 64 * (j))
#define XB_TOP      3328
#define XB_TOPGEN   3392
#define XCD_BAR_WORDS 3456
#define XB_SPIN_CAP (1u << 18)
__device__ __forceinline__ unsigned xb_ld(unsigned* p)              { return __hip_atomic_load(p, __ATOMIC_RELAXED, __HIP_MEMORY_SCOPE_AGENT); }
__device__ __forceinline__ unsigned xb_add(unsigned* p, unsigned v) { return __hip_atomic_fetch_add(p, v, __ATOMIC_RELAXED, __HIP_MEMORY_SCOPE_AGENT); }
__device__ __forceinline__ unsigned xb_xcc_id() { return (unsigned)__builtin_amdgcn_s_getreg((3 << 11) | 20) & 0xFu; }
#define XB_SPIN(cond, bar) do { unsigned _sp = 0; while (cond) { __builtin_amdgcn_s_sleep(1); \
    if ((++_sp & 255u) == 0u) { if (xb_ld(&(bar)[XB_TMO])) break; if (_sp > XB_SPIN_CAP) { atomicAdd(&(bar)[XB_TMO], 1u); break; } } } } while (0)
struct XcdBarrier { unsigned* bar; unsigned x; volatile LAS unsigned* st; };
__device__ __forceinline__ XcdBarrier xcd_barrier_post(unsigned* bar, volatile LAS unsigned* st) {
    XcdBarrier b; b.bar = bar; b.x = xb_xcc_id(); b.st = st;
    if (threadIdx.x == 0) st[2] = xb_add(&bar[XB_XCNT(b.x)], 1u);
    return b;
}
__device__ __forceinline__ void xcd_barrier_complete(unsigned* bar, unsigned x, unsigned& nloc, unsigned& nx) {
    const unsigned G = gridDim.x * gridDim.y * gridDim.z;
    unsigned sum, cnt, mine, sp = 0u;
    for (;;) {
        sum = 0u; cnt = 0u; mine = 0u;
#pragma unroll
        for (unsigned j = 0; j < 16; ++j) { const unsigned c = xb_ld(&bar[XB_XCNT(j)]); sum += c; cnt += (c > 0u) ? 1u : 0u; mine = (j == x) ? c : mine; }
        if (sum == G) break;
        __builtin_amdgcn_s_sleep(1);
        if ((++sp & 255u) == 0u) { if (xb_ld(&bar[XB_TMO])) break; if (sp > XB_SPIN_CAP) { atomicAdd(&bar[XB_TMO], 1u); break; } }
    }
    nloc = mine > 0u ? mine : 1u; nx = cnt > 0u ? cnt : 1u;
}
__device__ __forceinline__ void xcd_barrier(const XcdBarrier& b) {
    asm volatile("s_waitcnt vmcnt(0)" ::: "memory");
    __syncthreads();
    if (threadIdx.x == 0) {
        unsigned* bar = b.bar;
        __builtin_amdgcn_s_waitcnt(0);
        unsigned nloc = b.st[0], nx = b.st[1];
        if (nloc == 0u) { xcd_barrier_complete(bar, b.x, nloc, nx); b.st[0] = nloc; b.st[1] = nx; }
        const unsigned old = xb_add(&bar[XB_XSUB(b.x)], 1u);
        const unsigned gen = old / nloc;
        if (old + 1u == (gen + 1u) * nloc) {
            __builtin_amdgcn_fence(__ATOMIC_RELEASE, "agent");
            asm volatile("s_waitcnt vmcnt(0)" ::: "memory");
            const unsigned og = xb_add(&bar[XB_TOP], 1u);
            const unsigned tg = og / nx;
            if (og + 1u == (tg + 1u) * nx) xb_add(&bar[XB_TOPGEN], 1u);
            else XB_SPIN(xb_ld(&bar[XB_TOPGEN]) == tg, bar);
            __builtin_amdgcn_fence(__ATOMIC_ACQUIRE, "agent");
            xb_add(&bar[XB_XGEN(b.x)], 1u);
            asm volatile("s_waitcnt vmcnt(0)" ::: "memory");
        } else {
            XB_SPIN(xb_ld(&bar[XB_XGEN(b.x)]) == gen, bar);
            __builtin_amdgcn_fence(__ATOMIC_ACQUIRE, "agent");
            asm volatile("s_waitcnt vmcnt(0)" ::: "memory");
        }
    }
    __syncthreads();
}

__global__ void __launch_bounds__(NTHREADS) mk_fwd(Args a) {
    extern __shared__ __attribute__((aligned(16))) unsigned char lds_raw[];
    LAS unsigned char* lds = (LAS unsigned char*)lds_raw;
    cg::grid_group grid = cg::this_grid();
    const int wid = __builtin_amdgcn_readfirstlane((int)threadIdx.x >> 6);
    const int G = gridDim.x, blk = blockIdx.x;
#define PHASE_LANES const int tid = threadIdx.x, lane = tid & 63, fr = lane & 15, fq = lane >> 4; (void)tid; (void)lane; (void)fr; (void)fq
    unsigned char* ws = a.ws; unsigned char* ob = (unsigned char*)a.out;
    bf16_t* z1 = (bf16_t*)(ws + WS_Z1); bf16_t* merged = (bf16_t*)(ws + WS_MERGED);
    bf16_t* WinT = (bf16_t*)(ws + WS_WIN); bf16_t* WkvT = (bf16_t*)(ws + WS_WKV); bf16_t* WfoT = (bf16_t*)(ws + WS_WFO); bf16_t* WnaT = (bf16_t*)(ws + WS_WNA);
    bf16_t* WcaT = (bf16_t*)(ws + WS_WCA); bf16_t* WoutT = (bf16_t*)(ws + WS_WOUT); bf16_t* kvmem = (bf16_t*)(ws + WS_KVMEM); bf16_t* memn = (bf16_t*)(ws + WS_MEMN);
    float* rowss = (float*)(ws + WS_ROWSS);
    bf16_t* tab64 = (bf16_t*)(ws + WS_TAB64); bf16_t* tab128 = (bf16_t*)(ws + WS_TAB128); bf16_t* tabC = (bf16_t*)(ws + WS_TABC);
    bf16_t* hb = (bf16_t*)(ob + OUT_HB); bf16_t* T2 = (bf16_t*)(ob + OUT_T2);
    const int lo = a.ph_lo, hi = a.ph_hi;
    volatile LAS unsigned* xbst = (volatile LAS unsigned*)(lds + LDS_BYTES - 16);
    if (threadIdx.x == 0) { xbst[0] = 0u; xbst[1] = 0u; xbst[2] = 0u; xbst[3] = 0u; }
    __syncthreads();
    XcdBarrier xb = xcd_barrier_post((unsigned*)(ws + WS_BAR), xbst);
    if (a.ph_hi < 0) grid.sync();
#ifndef SKIPMASK
#define SKIPMASK 0
#endif
#define IN(k) (!((SKIPMASK >> (k)) & 1) && lo <= (k) && (k) < hi)
#ifndef REPMASK
#define REPMASK 0
#endif
#define REPS(k) (1 + ((REPMASK >> (k)) & 1))
#ifndef CG_SEAMS
#define CG_SEAMS 0
#endif
#define SEAM(k) do { if (IN(k) && IN((k) + 1)) { if ((k) < CG_SEAMS) grid.sync(); else xcd_barrier(xb); } } while (0)

    if (IN(0)) for (int rep_ = 0; rep_ < REPS(0); ++rep_) {
        PHASE_LANES;
        LAS float* scr = (LAS float*)(lds + wid * 16384);
        const int gw = blk * 8 + wid, NGW = G * 8;
        constexpr int I_IN = 16 * (NIN / 32), I_KV = 16 * 16, I_FO = 6 * 32, I_NA = 6 * 32, I_CA = 4 * 32, I_OUT = 16 * 32;
        constexpr int NITEMS = I_IN + I_KV + I_FO + I_NA + I_CA + I_OUT;
        for (int it = gw; it < NITEMS; it += NGW) {
            int r = it;
            if (r < I_IN) { p0_transpose_item(a.w_in, D, NIN, WinT, scr, r, lane); continue; } r -= I_IN;
            if (r < I_KV) { p0_transpose_item(a.w_kv, D, 512, WkvT, scr, r, lane); continue; } r -= I_KV;
            if (r < I_FO) { p0_transpose_item(a.w_fo, 384, D, WfoT, scr, r, lane); continue; } r -= I_FO;
            if (r < I_NA) { p0_transpose_item(a.w_na, 384, D, WnaT, scr, r, lane); continue; } r -= I_NA;
            if (r < I_CA) { p0_transpose_item(a.w_ca, 256, D, WcaT, scr, r, lane); continue; } r -= I_CA;
            p0_transpose_item(a.w_out, D, D, WoutT, scr, r, lane);
        }
        for (int m4 = gw; m4 < T / 4; m4 += NGW) { const float* xr[4]; bf16_t* orw[4];
#pragma unroll
            for (int r = 0; r < 4; ++r) { const int m = 4 * m4 + r; xr[r] = m < TP ? a.xp + (size_t)m * D : a.xs + (size_t)(m - TP) * D; orw[r] = hb + (size_t)m * D; }
            rms_rows4_to_bf16(xr, a.g_norm, orw, lane); }
        for (int m = gw; m < NMEMROWS; m += NGW) rms_row_to_bf16(m < 2048 ? a.memp + (size_t)m * D : a.mems + (size_t)(m - 2048) * D, a.g_mem, memn + (size_t)m * D, lane);
        const int gt = blk * NTHREADS + tid, NT = G * NTHREADS;
        for (int i = gt; i < 64 * 64; i += NT) { const int k = i >> 6, n = i & 63; const float f = (float)((k * n) & 63) * (1.0f / 64.0f); const float c = cosrev(f), s = sinrev(f);
            tab64[i] = f2bf(c); tab64[4096 + i] = f2bf(-s); tab64[8192 + i] = f2bf(s); }
        for (int i = gt; i < 128 * 128; i += NT) { const int k = i >> 7, n = i & 127; const float f = (float)((k * n) & 127) * (1.0f / 128.0f); const float c = cosrev(f), s = sinrev(f);
            tab128[i] = f2bf(c); tab128[16384 + i] = f2bf(-s); tab128[32768 + i] = f2bf(s); }
        for (int i = gt; i < 1024; i += NT) ((unsigned*)(ws + WS_CNT))[64 * (i >> 1) + 16 * (i & 1)] = 0u;
        for (int i = gt; i < 96 * 96; i += NT) { const int l = i / 96, kap = i % 96; const int s = kap >> 5, g = (kap & 31) >> 3, j = kap & 7; const int m = 32 * s + 16 * (j >> 2) + 4 * g + (j & 3);
            const float f = (float)((m * l) % 96) * (1.0f / 96.0f); tabC[i] = f2bf(cosrev(f)); tabC[9216 + i] = f2bf(sinrev(f)); }
    }
    SEAM(0);
    int vblk = blk;
    if (IN(0) && IN(1)) {
        if (threadIdx.x == 0) { unsigned* bar = (unsigned*)(ws + WS_BAR); bool ok = (G % 8 == 0);
            for (int j = 0; j < 16; ++j) { const unsigned cj = xb_ld(&bar[XB_XCNT(j)]); ok = ok && (cj == (j < 8 ? (unsigned)(G / 8) : 0u)); }
            xbst[3] = ok ? (xbst[2] * 8u + xb.x) : (unsigned)blk; }
        __syncthreads();
        vblk = __builtin_amdgcn_readfirstlane((int)xbst[3]);
    }

    if (IN(1)) {
        { PlainStream S; S.so.init(T, NZ, G, vblk, REPS(1)); S.A = (const char*)hb; S.B = (const char*)WinT; S.lda = D * 2; S.ldb = D * 2; S.nt = 16;
          EpiStoreBf16 E{z1, NZ}; pg8::gemm_stream<1>(lds, S, E); }
        { PlainStream S; S.so.init(NMEMROWS, 512, G, blk); S.A = (const char*)memn; S.B = (const char*)WkvT; S.lda = D * 2; S.ldb = D * 2; S.nt = 16;
          EpiStoreBf16 E{kvmem, 512}; pg8::gemm_stream<1>(lds, S, E); }
    }
    SEAM(1);

    if (IN(2)) {
        PHASE_LANES;
        {
            LAS unsigned char* Kimg = lds; LAS unsigned char* Vimg = lds + 576 * 128; LAS float* rpbs = (LAS float*)(lds + 2 * 576 * 128);
            constexpr int NITEMS = 768;
            for (int it = blk; it < NITEMS; it += G) {
                int q, chunk, h, R;
                if (it < 384) { h = it % 6; const int t2 = it / 6; chunk = t2 & 7; q = t2 >> 3; R = 128; }
                else { const int i2 = it - 384; h = i2 % 6; const int t2 = i2 / 6; chunk = t2 & 3; q = 8 + (t2 >> 2); R = 64; }
                const int sb = seq_base(q), rowbase = 16 * chunk;
                const bf16_t* kvbase = z1 + (size_t)sb * NZ + h * 64;
                int rb = min(max(rowbase - 4, 0), R - 8), hi = min(rb + 8, R - 1);
                __syncthreads();
                for (int c = tid; c < (hi - rb + 1) * 512; c += NTHREADS) { const int row = rb + (c >> 9), col = (c >> 3) & 63, ch = c & 7, key = (row % 9) * 64 + col;
                    const bf16_t* src = kvbase + (size_t)(row * 64 + col) * NZ + ch * 8;
                    *(LAS u32x4*)(Kimg + kv_off(key, ch)) = *(const u32x4*)(src + C_K); *(LAS u32x4*)(Vimg + kv_off(key, ch)) = *(const u32x4*)(src + C_V); }
                for (int c = tid; c < 465; c += NTHREADS) rpbs[c] = a.rpb[h * 465 + c] * 1.4426950408889634f;
                const int j = wid & 3, c0 = min(max(16 * j - 8, 0), 32), pcol = tid >> 3, pch = tid & 7;
                bf16_t* trow = z1 + (size_t)(sb + (rowbase + (wid >> 2)) * 64 + 16 * j + fr) * NZ;
                QG cur = load_qg(trow + C_Q + h * 64, trow + C_GNA + h * 64, fq);
                __syncthreads();
#pragma unroll 1
                for (int bi = 0; bi < 8; ++bi) {
                    const int r0 = rowbase + 2 * bi, r = r0 + (wid >> 2), rs = min(max(r - 4, 0), R - 8);
                    const int rb2 = min(max(r0 + 2 - 4, 0), R - 8), hi2 = (bi < 7) ? min(rb2 + 8, R - 1) : hi;
                    const int nrow0 = min(hi + 1, R - 1), nrow1 = min(hi + 2, R - 1);
                    const bf16_t* s0 = kvbase + (size_t)(nrow0 * 64 + pcol) * NZ + pch * 8; const bf16_t* s1 = kvbase + (size_t)(nrow1 * 64 + pcol) * NZ + pch * 8;
                    const u32x4 pk0 = *(const u32x4*)(s0 + C_K), pv0 = *(const u32x4*)(s0 + C_V), pk1 = *(const u32x4*)(s1 + C_K), pv1 = *(const u32x4*)(s1 + C_V);
                    bf16_t* trow2 = trow + (size_t)(bi < 7 ? 128 : 0) * NZ;
                    const QG nxt = load_qg(trow2 + C_Q + h * 64, trow2 + C_GNA + h * 64, fq);
                    int krow[8]; { const int sl0 = rs % 9;
#pragma unroll
                        for (int kr = 0; kr < 8; ++kr) { int sl = sl0 + kr; sl = sl >= 9 ? sl - 9 : sl; krow[kr] = sl * 64 + c0; } }
                    attn16<true>(Kimg, Vimg, rpbs, krow, cur, trow + C_GNA + h * 64, fr, fq, lane, 16 * j + fr, c0, rs - r + 7);
                    __syncthreads();
                    if (hi + 1 <= hi2) { const int key = ((hi + 1) % 9) * 64 + pcol; *(LAS u32x4*)(Kimg + kv_off(key, pch)) = pk0; *(LAS u32x4*)(Vimg + kv_off(key, pch)) = pv0; }
                    if (hi + 2 <= hi2) { const int key = ((hi + 2) % 9) * 64 + pcol; *(LAS u32x4*)(Kimg + kv_off(key, pch)) = pk1; *(LAS u32x4*)(Vimg + kv_off(key, pch)) = pv1; }
                    __syncthreads();
                    hi = hi2; cur = nxt; trow = trow2;
                }
            }
        }
        {
            LAS unsigned char* Kimg = lds; LAS unsigned char* Vimg = lds + 256 * 128;
            constexpr int NITEMS = 512;
            int krow[8];
#pragma unroll
            for (int kr = 0; kr < 8; ++kr) krow[kr] = kr * 32;
            for (int it = blk; it < NITEMS; it += G) {
                int q, h, ck;
                if (it < 256) { ck = it & 7; h = (it >> 3) & 3; q = it >> 5; } else { const int i2 = it - 256; ck = i2 & 3; h = (i2 >> 2) & 3; q = 8 + (i2 >> 4); }
                const int tok0 = seq_base(q) + ck * 1024;
                __syncthreads();
                for (int c = tid; c < 256 * 8; c += NTHREADS) { const int key = c >> 3, ch = c & 7; const bf16_t* src = kvmem + (size_t)(q * 256 + key) * 512 + h * 64 + ch * 8;
                    *(LAS u32x4*)(Kimg + kv_off(key, ch)) = *(const u32x4*)(src); *(LAS u32x4*)(Vimg + kv_off(key, ch)) = *(const u32x4*)(src + 256); }
                bf16_t* trow = z1 + (size_t)(tok0 + wid * 128 + fr) * NZ;
                QG cur = load_qg(trow + C_QCA + h * 64, trow + C_GCA + h * 64, fq);
                __syncthreads();
#pragma unroll 1
                for (int i = 0; i < 8; ++i) { bf16_t* trow2 = trow + (size_t)(i < 7 ? 16 : 0) * NZ;
                    const QG nxt = load_qg(trow2 + C_QCA + h * 64, trow2 + C_GCA + h * 64, fq);
                    attn16<false>(Kimg, Vimg, nullptr, krow, cur, trow + C_GCA + h * 64, fr, fq, lane, 0, 0, 0);
                    cur = nxt; trow = trow2; }
            }
        }
        for (int rep_ = 0; rep_ < REPS(7); ++rep_)
        {
            constexpr int US = 784;
            constexpr int NITEMS = 2048;
            bf16x8 af[8][2];
#pragma unroll
            for (int mb = 0; mb < 8; ++mb)
#pragma unroll
                for (int ks = 0; ks < 2; ++ks) af[mb][ks] = *(const bf16x8*)(tab64 + (mb >> 2) * 4096 + ((mb & 3) * 16 + fr) * 64 + 32 * ks + 8 * fq);
            const int q4 = (lane & 15) >> 2, p4 = lane & 3;
            for (int it = blk; it < NITEMS; it += G) {
                int q, n2, N2, S;
                if (it < 1024) { q = it >> 7; n2 = it & 127; N2 = 128; S = 8192; } else { const int i2 = it - 1024; q = 8 + (i2 >> 6); n2 = i2 & 63; N2 = 64; S = 4096; }
                const int sb = seq_base(q);
                __syncthreads();
                for (int c = tid; c < 64 * 48; c += NTHREADS) { const int n1 = c / 48, ch = c % 48;
                    *(LAS u32x4*)(lds + n1 * US + ch * 16) = *(const u32x4*)(z1 + (size_t)(sb + N2 * n1 + n2) * NZ + C_UF + ch * 8); }
                __syncthreads();
                const float invS = 1.0f / (float)S;
#pragma unroll 1
                for (int cc = 0; cc < 3; ++cc) {
                    const int c = wid * 3 + cc;
                    bf16x8 bfr[2];
#pragma unroll
                    for (int ks = 0; ks < 2; ++ks) { LAS unsigned char* p = lds + (32 * ks + 8 * fq + q4) * US + (16 * c + 4 * p4) * 2; bfr[ks] = cat4(tr_read(p), tr_read(p + 4 * US)); }
                    f32x4 acc[8];
#pragma unroll
                    for (int mb = 0; mb < 8; ++mb) { f32x4 v = (f32x4){0.f, 0.f, 0.f, 0.f}; v = mfma16(af[mb][0], bfr[0], v); v = mfma16(af[mb][1], bfr[1], v); acc[mb] = v; }
                    const int ch = 16 * c + fr, grp = ch / 96, mm = ch - grp * 96;
#pragma unroll
                    for (int mb = 0; mb < 4; ++mb)
#pragma unroll
                        for (int i = 0; i < 4; ++i) { const int k1 = mb * 16 + 4 * fq + i; const float f = (float)((n2 * k1) & (S - 1)) * invS; const float cs = cosrev(f), sn = sinrev(f);
                            const float tr = acc[mb][i], ti = acc[mb + 4][i]; bf16_t* dst = T2 + (size_t)(sb + k1 * N2 + n2) * 768 + grp * 192 + mm;
                            dst[0] = f2bf(tr * cs + ti * sn); dst[96] = f2bf(ti * cs - tr * sn); }
                }
            }
        }
    }
    SEAM(2);

    if (IN(3)) {
        PHASE_LANES;
        constexpr int TS = 400;
        constexpr int NITEMS = 4096;
        const int q4 = (lane & 15) >> 2, p4 = lane & 3;
#define FC_DECODE(IT, BIG, Q, K1, GG, SB) const bool BIG = (IT) < 2048; const int GG = BIG ? ((IT) & 3) : (((IT) - 2048) & 1), K1 = BIG ? (((IT) >> 2) & 63) : ((((IT) - 2048) >> 1) & 63), \
        Q = BIG ? ((IT) >> 8) : (8 + (((IT) - 2048) >> 7)), SB = seq_base(Q)
#define FC_LOAD_TILE(DST, BIG, K1, GG, SB) do { _Pragma("unroll") for (int i_ = 0; i_ < 6; ++i_) { const int c_ = tid + NTHREADS * i_, rr_ = c_ / 24, ch_ = c_ - rr_ * 24; \
        const size_t row_ = BIG ? (size_t)(SB + K1 * 128 + rr_) : (size_t)(SB + K1 * 64 + (rr_ & 63)); const int gcol_ = BIG ? GG * 192 : (2 * GG + (rr_ >> 6)) * 192; \
        DST[i_] = *(const u32x4*)(T2 + row_ * 768 + gcol_ + ch_ * 8); } } while (0)
#define FC_STORE_TILE(SRC) do { _Pragma("unroll") for (int i_ = 0; i_ < 6; ++i_) { const int c_ = tid + NTHREADS * i_, rr_ = c_ / 24, ch_ = c_ - rr_ * 24; *(LAS u32x4*)(lds + rr_ * TS + ch_ * 16) = SRC[i_]; } } while (0)
#define FC_GATE_ROW(BIG, K1, GG, SB) (z1 + (size_t)(SB + K1 + 64 * (16 * (BIG ? wid : (wid & 3)) + fr)) * NZ + C_GF + (BIG ? GG : 2 * GG + (wid >> 2)) * 96 + 4 * fq)
        constexpr int TC_OFF = 128 * TS;
        for (int c = tid; c < 2 * 9216 / 8; c += NTHREADS) *(LAS u32x4*)(lds + TC_OFF + c * 16) = *(const u32x4*)(tabC + c * 8);
        bf16x8 wfr[4][3];
        int wmode = -1;
        u32x4 pre[6]; u32x2 gcur[6];
        int it = blk;
        if (it < NITEMS) { FC_DECODE(it, big0, q0_, k10, g0_, sb0); FC_LOAD_TILE(pre, big0, k10, g0_, sb0); const bf16_t* gr = FC_GATE_ROW(big0, k10, g0_, sb0);
#pragma unroll
            for (int lb = 0; lb < 6; ++lb) gcur[lb] = *(const u32x2*)(gr + 16 * lb);
            __syncthreads(); FC_STORE_TILE(pre); __syncthreads(); }
        for (; it < NITEMS; it += G) {
            FC_DECODE(it, big, q, k1, gg, sb);
            const int nit = it + G; const bool hasn = nit < NITEMS; const int nit_c = hasn ? nit : it;
            FC_DECODE(nit_c, bign, qn, k1n, ggn, sbn);
            u32x2 gnx[6];
            FC_LOAD_TILE(pre, bign, k1n, ggn, sbn);
            { const bf16_t* gr = FC_GATE_ROW(bign, k1n, ggn, sbn);
#pragma unroll
              for (int lb = 0; lb < 6; ++lb) gnx[lb] = *(const u32x2*)(gr + 16 * lb); }
            const int N2 = big ? 128 : 64, S = big ? 8192 : 4096, kb2 = big ? wid : (wid & 3);
            LAS unsigned char* tile = big ? lds : lds + (wid >> 2) * 64 * TS;
            const int nks = N2 / 32;
            if (wmode != (int)big) { wmode = (int)big; const bf16_t* tab = big ? tab128 : tab64; const int tsz = N2 * N2;
#pragma unroll
                for (int ks = 0; ks < 4; ++ks) { const bf16_t* tp = tab + (16 * kb2 + fr) * N2 + 32 * (ks < nks ? ks : 0) + 8 * fq;
                    wfr[ks][0] = *(const bf16x8*)(tp); wfr[ks][1] = *(const bf16x8*)(tp + tsz); wfr[ks][2] = *(const bf16x8*)(tp + 2 * tsz); } }
            f32x4 zr[6], zi[6];
#pragma unroll
            for (int cb = 0; cb < 6; ++cb) { zr[cb] = (f32x4){0.f, 0.f, 0.f, 0.f}; zi[cb] = (f32x4){0.f, 0.f, 0.f, 0.f}; }
#pragma unroll
            for (int ks = 0; ks < 4; ++ks) if (ks < nks) {
                const bf16x8 wre = wfr[ks][0], wim = wfr[ks][1], wni = wfr[ks][2];
                LAS unsigned char* rowp = tile + (32 * ks + 8 * fq + q4) * TS + 8 * p4;
#pragma unroll
                for (int cb = 0; cb < 6; ++cb) {
                    const bf16x8 trf = cat4(tr_read(rowp + 32 * cb), tr_read(rowp + 32 * cb + 4 * TS));
                    const bf16x8 tif = cat4(tr_read(rowp + 192 + 32 * cb), tr_read(rowp + 192 + 32 * cb + 4 * TS));
                    zr[cb] = mfma16(trf, wre, zr[cb]); zr[cb] = mfma16(tif, wni, zr[cb]);
                    zi[cb] = mfma16(tif, wre, zi[cb]); zi[cb] = mfma16(trf, wim, zi[cb]);
                }
            }
            bf16x8 zfr[3], zfi[3];
#pragma unroll
            for (int s_ = 0; s_ < 3; ++s_) { zfr[s_] = pack8(zr[2 * s_], zr[2 * s_ + 1]); zfi[s_] = pack8(zi[2 * s_], zi[2 * s_ + 1]); }
            const float scale = 1.0f / sqrtf((float)S * 96.0f);
            bf16_t* trow = (bf16_t*)FC_GATE_ROW(big, k1, gg, sb);
#pragma unroll
            for (int lb = 0; lb < 6; ++lb) {
                f32x4 y = (f32x4){0.f, 0.f, 0.f, 0.f};
#pragma unroll
                for (int s_ = 0; s_ < 3; ++s_) { const LAS unsigned char* cp = lds + TC_OFF + ((16 * lb + fr) * 96 + 32 * s_ + 8 * fq) * 2;
                    y = mfma16(*(const LAS bf16x8*)cp, zfr[s_], y); y = mfma16(*(const LAS bf16x8*)(cp + 9216 * 2), zfi[s_], y); }
                const u32x2 gv = gcur[lb]; u32x2 w;
                w.x = cvt_pk_bf16(y[0] * scale * siluf_(bf_lo(gv.x)), y[1] * scale * siluf_(bf_hi(gv.x)));
                w.y = cvt_pk_bf16(y[2] * scale * siluf_(bf_lo(gv.y)), y[3] * scale * siluf_(bf_hi(gv.y)));
                *(u32x2*)(trow + 16 * lb) = w;
            }
            __syncthreads();
            if (hasn) FC_STORE_TILE(pre);
            __syncthreads();
#pragma unroll
            for (int lb = 0; lb < 6; ++lb) gcur[lb] = gnx[lb];
        }
#undef FC_DECODE
#undef FC_LOAD_TILE
#undef FC_STORE_TILE
#undef FC_GATE_ROW
    }
    SEAM(3);

    if (IN(4)) {
        MergeStream S; S.so.init(T, D, G, vblk, REPS(4)); S.hb = (const char*)hb; S.z1 = (const char*)z1; S.win = (const char*)WinT; S.wfo = (const char*)WfoT; S.wna = (const char*)WnaT; S.wca = (const char*)WcaT;
        EpiMerge E{ob + OUT_T2 + (size_t)blk * (3 * 16 * 8192), merged};
        pg8::gemm_stream<6>(lds, S, E);
    }
    SEAM(4);

    if (IN(5)) {
        PlainStream S; S.so.init(T, D, G, vblk, REPS(5)); S.A = (const char*)merged; S.B = (const char*)WoutT; S.lda = D * 2; S.ldb = D * 2; S.nt = 16;
        EpiResid E{a.xp, a.xs, a.out, rowss, (unsigned*)(ws + WS_CNT), a.g_final, (FUSE_NORM && G == 256 && REPS(5) == 1) ? 1 : 0};
        pg8::gemm_stream<1>(lds, S, E);
    }
    SEAM(5);

    if (IN(6) && !(FUSE_NORM && G == 256 && REPS(5) == 1)) {
        PHASE_LANES;
        const int gw = blk * 8 + wid, NGW = G * 8;
        for (int m4 = gw; m4 < T / 4; m4 += NGW) {
            f32x4 v[4][4]; float rs_[4];
#pragma unroll
            for (int r = 0; r < 4; ++r) { const int m = 4 * m4 + r; const f32x4* yr = (const f32x4*)(a.out + (size_t)m * D) + lane;
#pragma unroll
                for (int j = 0; j < 4; ++j) v[r][j] = yr[64 * j];
                rs_[r] = lane < 16 ? rowss[(size_t)m * 16 + lane] : 0.f; }
#pragma unroll
            for (int r = 0; r < 4; ++r) rs_[r] = 1.0f / sqrtf(wave_sum(rs_[r]) * (1.0f / D) + EPS);
            const f32x4* gr = (const f32x4*)a.g_final + lane;
#pragma unroll
            for (int j = 0; j < 4; ++j) { const f32x4 gv = gr[64 * j];
#pragma unroll
                for (int r = 0; r < 4; ++r) ((f32x4*)(a.out + (size_t)(4 * m4 + r) * D) + lane)[64 * j] = v[r][j] * rs_[r] * gv; }
        }
    }
}

extern "C" void kernel_launch(void* const* d_in, const int* in_sizes, int n_in, void* d_out, int out_size, void* d_ws, size_t ws_size, hipStream_t stream) {
    static int grid = 0;
    if (grid == 0) {
        if (n_in != 14 || out_size != T * D || ws_size < WS_END) { fprintf(stderr, "kernel_launch: unexpected sizes (n_in %d out %d ws %zu, need ws >= %zu)\n", n_in, out_size, ws_size, (size_t)WS_END); grid = -1; return; }
        int dev = 0, cus = 0, per_cu = 0;
        if (hipGetDevice(&dev) != hipSuccess || hipDeviceGetAttribute(&cus, hipDeviceAttributeMultiprocessorCount, dev) != hipSuccess) { grid = -1; return; }
        if (hipFuncSetAttribute((const void*)mk_fwd, hipFuncAttributeMaxDynamicSharedMemorySize, LDS_BYTES) != hipSuccess) { fprintf(stderr, "kernel_launch: hipFuncSetAttribute failed\n"); grid = -1; return; }
        if (hipOccupancyMaxActiveBlocksPerMultiprocessor(&per_cu, (const void*)mk_fwd, NTHREADS, LDS_BYTES) != hipSuccess || per_cu < 1) { fprintf(stderr, "kernel_launch: occupancy query says %d blocks per CU\n", per_cu); grid = -1; return; }
        grid = cus;
    }
    if (grid < 0) return;
    Args a{};
    a.xp = (const float*)d_in[0]; a.xs = (const float*)d_in[1]; a.memp = (const float*)d_in[2]; a.mems = (const float*)d_in[3]; a.g_norm = (const float*)d_in[4];
    a.w_in = (const float*)d_in[5]; a.rpb = (const float*)d_in[6]; a.g_mem = (const float*)d_in[7]; a.w_kv = (const float*)d_in[8]; a.w_fo = (const float*)d_in[9];
    a.w_na = (const float*)d_in[10]; a.w_ca = (const float*)d_in[11]; a.w_out = (const float*)d_in[12]; a.g_final = (const float*)d_in[13];
    a.out = (float*)d_out; a.ws = (unsigned char*)d_ws;
    if (hipMemsetAsync((char*)d_ws + WS_BAR, 0, XCD_BAR_WORDS * 4, stream) != hipSuccess) { fprintf(stderr, "kernel_launch: hipMemsetAsync of the barrier words failed\n"); return; }
#if MK_N_LAUNCHES == 1
    a.ph_lo = 0; a.ph_hi = NPHASES;
    { void* args[] = {&a}; hipError_t e = hipLaunchCooperativeKernel((const void*)mk_fwd, dim3(grid), dim3(NTHREADS), args, LDS_BYTES, stream);
      if (e != hipSuccess) fprintf(stderr, "kernel_launch: cooperative launch failed: %s\n", hipGetErrorString(e)); }
#else
    for (int p = 0; p < NPHASES; ++p) { a.ph_lo = p; a.ph_hi = p + 1; void* args[] = {&a};
        hipError_t e = hipLaunchCooperativeKernel((const void*)mk_fwd, dim3(grid), dim3(NTHREADS), args, LDS_BYTES, stream);
        if (e != hipSuccess) { fprintf(stderr, "kernel_launch: launch %d failed: %s\n", p, hipGetErrorString(e)); break; } }
#endif
}
```
